# Optimizing an MI355X kernel written in HIP

```python
import math
import numpy as np
import jax, jax.numpy as jnp
from jax import lax

D_MODEL = 2048
BATCH = 4
SEQ = 2048
DEPTH = 4

N_MIXERS = 2
NSA_HEADS = 16
NSA_KV_GROUPS = 2
NSA_HEAD_DIM = D_MODEL // NSA_HEADS
NSA_Q_PER_GROUP = NSA_HEADS // NSA_KV_GROUPS
CMP_BLOCK = 32
CMP_STRIDE = 16
SLC_BLOCK = 64
N_SELECT = 8
WINDOW = 512
Q_BLOCK = 128
ROPE_THETA = 500000.0
ROPE_DIM = NSA_HEAD_DIM // 4
NSA_IN_DIM = NSA_HEADS * NSA_HEAD_DIM + 3 * 2 * NSA_KV_GROUPS * NSA_HEAD_DIM + 3 * NSA_HEADS
MLSTM_HEADS = 8
MLSTM_QK_DIM = D_MODEL // (2 * MLSTM_HEADS)
MLSTM_V_DIM = D_MODEL // MLSTM_HEADS
MLSTM_CHUNK = 64
GATE_SOFTCAP = 15.0
MLSTM_IN_DIM = 2 * MLSTM_HEADS * MLSTM_QK_DIM + 2 * MLSTM_HEADS * MLSTM_V_DIM + 2 * MLSTM_HEADS
D_FF = 5632
CONV_WIDTH = 3
NORM_EPS = 1e-6
NEG_INF = -1e30

kernel_name = "nsa_mlstm_interleaved_hybrid"


def rms_norm(x, g):
    xf = x.astype(jnp.float32)
    y = xf * lax.rsqrt(jnp.mean(xf * xf, axis=-1, keepdims=True) + NORM_EPS)
    return (y * g).astype(x.dtype)


def partial_rope(x, positions):
    half = ROPE_DIM // 2
    inv = jnp.power(ROPE_THETA, -jnp.arange(0, ROPE_DIM, 2, dtype=jnp.float32) / ROPE_DIM)
    ang = positions.astype(jnp.float32)[..., None] * inv
    cos, sin = jnp.cos(ang)[:, :, None, :], jnp.sin(ang)[:, :, None, :]
    xr = x[..., :ROPE_DIM].astype(jnp.float32)
    x1, x2 = xr[..., :half], xr[..., half:]
    rot = jnp.concatenate([x1 * cos - x2 * sin, x2 * cos + x1 * sin], axis=-1)
    return jnp.concatenate([rot.astype(x.dtype), x[..., ROPE_DIM:]], axis=-1)


def gather_blocks(blocks, idx):
    return jax.vmap(jax.vmap(lambda kb, ix: kb[ix]))(blocks, idx)


def nsa_mixer(xn, positions, w_in, gate_b, cmp_pe, cmp_w1, cmp_w2, w_out):
    B, S, _ = xn.shape
    H, G, R, hd = NSA_HEADS, NSA_KV_GROUPS, NSA_Q_PER_GROUP, NSA_HEAD_DIM
    scale = hd ** -0.5
    proj = xn @ w_in
    o1 = H * hd
    o2 = o1 + 2 * G * hd
    o3 = o2 + 2 * G * hd
    o4 = o3 + 2 * G * hd
    q = proj[..., :o1].reshape(B, S, H, hd)
    kv_c = proj[..., o1:o2].reshape(B, S, 2, G, hd)
    kv_s = proj[..., o2:o3].reshape(B, S, 2, G, hd)
    kv_w = proj[..., o3:o4].reshape(B, S, 2, G, hd)
    gates = jax.nn.sigmoid(proj[..., o4:].reshape(B, S, 3, H) + gate_b)
    t = np.arange(S)

    n_cmp = (S - CMP_BLOCK) // CMP_STRIDE + 1
    cmp_idx = np.arange(n_cmp)[:, None] * CMP_STRIDE + np.arange(CMP_BLOCK)[None, :]
    blocks = kv_c[:, cmp_idx] + cmp_pe.transpose(1, 0, 2)[:, :, None, :]
    hid = jax.nn.gelu(jnp.einsum('bjlcgd,cldh->bjcgh', blocks, cmp_w1))
    kv_cmp = jnp.einsum('bjcgh,che->bjcge', hid, cmp_w2)
    k_cmp, v_cmp = kv_cmp[:, :, 0], kv_cmp[:, :, 1]
    qg = q.reshape(B, S, G, R, hd)
    cmp_mask = cmp_idx[:, -1][None, :] <= t[:, None]
    s_c = jnp.einsum('bsgrd,bjgd->bgrsj', qg, k_cmp, preferred_element_type=jnp.float32) * scale
    p_c = jax.nn.softmax(jnp.where(cmp_mask, s_c, NEG_INF), axis=-1) * cmp_mask
    o_cmp = jnp.einsum('bgrsj,bjgd->bsgrd', p_c.astype(v_cmp.dtype), v_cmp).reshape(B, S, H, hd)

    n_slc = S // SLC_BLOCK
    jj = np.arange(n_cmp)[:, None]
    ss = np.arange(n_slc)[None, :]
    lo = np.maximum(jj * CMP_STRIDE, ss * SLC_BLOCK)
    hi = np.minimum(jj * CMP_STRIDE + CMP_BLOCK, ss * SLC_BLOCK + SLC_BLOCK)
    overlap = jnp.asarray(np.clip(hi - lo, 0, None).astype(np.float32) / CMP_BLOCK)
    imp = jnp.einsum('bgrsj,jn->bgsn', p_c, overlap)
    q_blk_id = t // SLC_BLOCK
    sid = np.arange(n_slc)
    forced = (sid[None, :] == 0) | (sid[None, :] == q_blk_id[:, None])
    valid = sid[None, :] <= q_blk_id[:, None]
    score = jnp.where(forced, jnp.inf, jnp.where(valid, imp, -jnp.inf))
    n_sel = min(N_SELECT, n_slc)
    _, sel_idx = lax.top_k(score, n_sel)

    q_r = partial_rope(q, positions).reshape(B, S, G, R, hd)
    k_s = partial_rope(kv_s[:, :, 0], positions).transpose(0, 2, 1, 3)
    v_s = kv_s[:, :, 1].transpose(0, 2, 1, 3)
    ks_blocks = k_s.reshape(B, G, n_slc, SLC_BLOCK, hd)
    vs_blocks = v_s.reshape(B, G, n_slc, SLC_BLOCK, hd)
    pad = ((0, 0), (0, 0), (WINDOW, 0), (0, 0))
    kw_pad = jnp.pad(partial_rope(kv_w[:, :, 0], positions).transpose(0, 2, 1, 3), pad)
    vw_pad = jnp.pad(kv_w[:, :, 1].transpose(0, 2, 1, 3), pad)

    nqb = S // Q_BLOCK
    q_blocks = q_r.reshape(B, nqb, Q_BLOCK, G, R, hd).transpose(1, 0, 3, 4, 2, 5)
    idx_blocks = sel_idx.reshape(B, G, nqb, Q_BLOCK, n_sel).transpose(2, 0, 1, 3, 4)

    def block_step(args):
        q_b, idx_b, qb = args
        tq = qb * Q_BLOCK + jnp.arange(Q_BLOCK)
        k_g = gather_blocks(ks_blocks, idx_b).reshape(B, G, Q_BLOCK, n_sel * SLC_BLOCK, hd)
        v_g = gather_blocks(vs_blocks, idx_b).reshape(B, G, Q_BLOCK, n_sel * SLC_BLOCK, hd)
        kpos = (idx_b[..., None] * SLC_BLOCK + jnp.arange(SLC_BLOCK)).reshape(B, G, Q_BLOCK, n_sel * SLC_BLOCK)
        m_s = (kpos <= tq[:, None])[:, :, None]
        s_s = jnp.einsum('bgrqd,bgqkd->bgrqk', q_b, k_g, preferred_element_type=jnp.float32) * scale
        p_s = jax.nn.softmax(jnp.where(m_s, s_s, NEG_INF), axis=-1)
        o_s = jnp.einsum('bgrqk,bgqkd->bgrqd', p_s.astype(v_g.dtype), v_g)
        kw = lax.dynamic_slice_in_dim(kw_pad, qb * Q_BLOCK, Q_BLOCK + WINDOW, axis=2)
        vw = lax.dynamic_slice_in_dim(vw_pad, qb * Q_BLOCK, Q_BLOCK + WINDOW, axis=2)
        wpos = qb * Q_BLOCK - WINDOW + jnp.arange(Q_BLOCK + WINDOW)
        dist = tq[:, None] - wpos[None, :]
        m_w = (wpos[None, :] >= 0) & (dist >= 0) & (dist < WINDOW)
        s_w = jnp.einsum('bgrqd,bgkd->bgrqk', q_b, kw, preferred_element_type=jnp.float32) * scale
        p_w = jax.nn.softmax(jnp.where(m_w, s_w, NEG_INF), axis=-1)
        o_w = jnp.einsum('bgrqk,bgkd->bgrqd', p_w.astype(vw.dtype), vw)
        return o_s, o_w

    o_sel, o_win = lax.map(block_step, (q_blocks, idx_blocks, jnp.arange(nqb)))
    o_sel = o_sel.transpose(1, 0, 4, 2, 3, 5).reshape(B, S, H, hd)
    o_win = o_win.transpose(1, 0, 4, 2, 3, 5).reshape(B, S, H, hd)
    o = (gates[:, :, 0, :, None] * o_cmp + gates[:, :, 1, :, None] * o_sel
         + gates[:, :, 2, :, None] * o_win)
    return o.reshape(B, S, H * hd) @ w_out


def mlstm_chunkwise(q, k, v, li, lf):
    B, H, S, dk = q.shape
    dv = v.shape[-1]
    L = MLSTM_CHUNK
    nc = S // L
    qc = q.reshape(B, H, nc, L, dk)
    kc = k.reshape(B, H, nc, L, dk)
    vc = v.reshape(B, H, nc, L, dv)
    lic = li.reshape(B, H, nc, L)
    F = jnp.cumsum(lf.reshape(B, H, nc, L), axis=-1)
    F_end = F[..., -1]
    a = F_end[..., None] - F + lic
    a_max = a.max(axis=-1)
    w = jnp.exp(a - a_max[..., None])
    dC = jnp.einsum('bhcl,bhclk,bhclv->bhckv', w, kc, vc)
    dn = jnp.einsum('bhcl,bhclk->bhck', w, kc)

    def step(carry, inp):
        C, n, m = carry
        f_end, am, dC_c, dn_c = inp
        m_new = jnp.maximum(f_end + m, am)
        decay = jnp.exp(f_end + m - m_new)
        inject = jnp.exp(am - m_new)
        C_new = decay[..., None, None] * C + inject[..., None, None] * dC_c
        n_new = decay[..., None] * n + inject[..., None] * dn_c
        return (C_new, n_new, m_new), (C, n, m)

    init = (jnp.zeros((B, H, dk, dv), jnp.float32), jnp.zeros((B, H, dk), jnp.float32),
            jnp.zeros((B, H), jnp.float32))
    xs = (F_end.transpose(2, 0, 1), a_max.transpose(2, 0, 1),
          dC.transpose(2, 0, 1, 3, 4), dn.transpose(2, 0, 1, 3))
    _, (C0, n0, m0) = lax.scan(step, init, xs)
    C0 = C0.transpose(1, 2, 0, 3, 4)
    n0 = n0.transpose(1, 2, 0, 3)
    m0 = m0.transpose(1, 2, 0)

    causal = np.tril(np.ones((L, L), dtype=bool))
    D = jnp.where(causal, F[..., :, None] - F[..., None, :] + lic[..., None, :], -jnp.inf)
    inter = F + m0[..., None]
    m_t = jnp.maximum(inter, D.max(axis=-1))
    Dw = jnp.exp(D - m_t[..., None])
    g_inter = jnp.exp(inter - m_t)
    Sqk = jnp.einsum('bhclk,bhcsk->bhcls', qc, kc) * Dw
    num = (jnp.einsum('bhcls,bhcsv->bhclv', Sqk, vc)
           + g_inter[..., None] * jnp.einsum('bhclk,bhckv->bhclv', qc, C0))
    den = Sqk.sum(axis=-1) + g_inter * jnp.einsum('bhclk,bhck->bhcl', qc, n0)
    h = num / jnp.maximum(jnp.abs(den), jnp.exp(-m_t))[..., None]
    return h.reshape(B, H, S, dv)


def mlstm_mixer(xn, w_in, gate_b, head_norm, w_out):
    B, S, _ = xn.shape
    H, dk, dv = MLSTM_HEADS, MLSTM_QK_DIM, MLSTM_V_DIM
    proj = xn @ w_in
    o1 = H * dk
    o2 = o1 + H * dk
    o3 = o2 + H * dv
    o4 = o3 + H * dv
    o5 = o4 + H
    to_heads = lambda z, d: z.reshape(B, S, H, d).transpose(0, 2, 1, 3).astype(jnp.float32)
    q = to_heads(proj[..., :o1], dk) * (dk ** -0.5)
    k = to_heads(proj[..., o1:o2], dk)
    v = to_heads(proj[..., o2:o3], dv)
    og = proj[..., o3:o4]
    i_pre = (proj[..., o4:o5] + gate_b[0]).astype(jnp.float32)
    f_pre = (proj[..., o5:] + gate_b[1]).astype(jnp.float32)
    li = (GATE_SOFTCAP * jnp.tanh(i_pre / GATE_SOFTCAP)).transpose(0, 2, 1)
    lf = jax.nn.log_sigmoid(GATE_SOFTCAP * jnp.tanh(f_pre / GATE_SOFTCAP)).transpose(0, 2, 1)
    h = mlstm_chunkwise(q, k, v, li, lf)
    h = h * lax.rsqrt(jnp.mean(h * h, axis=-1, keepdims=True) + NORM_EPS) * head_norm[:, None, :]
    h = h.transpose(0, 2, 1, 3).reshape(B, S, H * dv).astype(xn.dtype) * jax.nn.sigmoid(og)
    return h @ w_out


def conv_glu_ffn(xn, w_up, conv_w, conv_b, w_down):
    S = xn.shape[1]
    u = xn @ w_up
    up = jnp.pad(u, ((0, 0), (CONV_WIDTH - 1, 0), (0, 0)))
    c = conv_b + conv_w[0] * up[:, 0:S]
    for tap in range(1, CONV_WIDTH):
        c = c + conv_w[tap] * up[:, tap:tap + S]
    gate, val = c[..., :D_FF], c[..., D_FF:]
    return (jax.nn.silu(gate) * val) @ w_down


def setup_inputs(seed: int = 0) -> dict:
    key = jax.random.key(seed)
    ks = jax.random.split(key, 24)
    n_a = len(range(0, DEPTH, N_MIXERS))
    n_b = DEPTH - n_a
    nrm = lambda k, shape, s: jax.random.normal(k, shape, jnp.float32) * s
    H, G, hd = NSA_HEADS, NSA_KV_GROUPS, NSA_HEAD_DIM
    Hm = MLSTM_HEADS
    offset = jax.random.randint(ks[1], (BATCH,), 0, 1024, dtype=jnp.int32)
    positions = offset[:, None] + jnp.arange(SEQ, dtype=jnp.int32)[None, :]
    f_bias = jnp.linspace(3.0, 6.0, Hm, dtype=jnp.float32)[None, :] + nrm(ks[11], (n_b, Hm), 0.1)
    i_bias = nrm(ks[12], (n_b, Hm), 0.1)
    return {
        "x": nrm(ks[0], (BATCH, SEQ, D_MODEL), 1.0),
        "positions": positions,
        "nsa_w_in": nrm(ks[2], (n_a, D_MODEL, NSA_IN_DIM), D_MODEL ** -0.5),
        "nsa_gate_b": nrm(ks[3], (n_a, 3, H), 0.1),
        "nsa_cmp_pe": nrm(ks[4], (n_a, 2, CMP_BLOCK, hd), 0.5),
        "nsa_cmp_w1": nrm(ks[5], (n_a, 2, CMP_BLOCK, hd, hd), (CMP_BLOCK * hd) ** -0.5),
        "nsa_cmp_w2": nrm(ks[6], (n_a, 2, hd, hd), hd ** -0.5),
        "nsa_w_out": nrm(ks[7], (n_a, H * hd, D_MODEL), (H * hd) ** -0.5),
        "mlstm_w_in": nrm(ks[8], (n_b, D_MODEL, MLSTM_IN_DIM), D_MODEL ** -0.5),
        "mlstm_gate_b": jnp.stack([i_bias, f_bias], axis=1),
        "mlstm_head_norm": 1.0 + nrm(ks[9], (n_b, Hm, MLSTM_V_DIM), 0.02),
        "mlstm_w_out": nrm(ks[10], (n_b, Hm * MLSTM_V_DIM, D_MODEL), (Hm * MLSTM_V_DIM) ** -0.5),
        "norm_mix": 1.0 + nrm(ks[13], (DEPTH, D_MODEL), 0.02),
        "norm_ffn": 1.0 + nrm(ks[14], (DEPTH, D_MODEL), 0.02),
        "ffn_w_up": nrm(ks[15], (DEPTH, D_MODEL, 2 * D_FF), D_MODEL ** -0.5),
        "ffn_conv_w": nrm(ks[16], (DEPTH, CONV_WIDTH, 2 * D_FF), CONV_WIDTH ** -0.5),
        "ffn_conv_b": nrm(ks[17], (DEPTH, 2 * D_FF), 0.02),
        "ffn_w_down": nrm(ks[18], (DEPTH, D_FF, D_MODEL), D_FF ** -0.5),
        "norm_final": 1.0 + nrm(ks[19], (D_MODEL,), 0.02),
    }


def reference(x, positions, nsa_w_in, nsa_gate_b, nsa_cmp_pe, nsa_cmp_w1, nsa_cmp_w2, nsa_w_out,
              mlstm_w_in, mlstm_gate_b, mlstm_head_norm, mlstm_w_out,
              norm_mix, norm_ffn, ffn_w_up, ffn_conv_w, ffn_conv_b, ffn_w_down, norm_final):
    for i in range(DEPTH):
        xn = rms_norm(x, norm_mix[i])
        j = i // N_MIXERS
        if i % N_MIXERS == 0:
            y = nsa_mixer(xn, positions, nsa_w_in[j], nsa_gate_b[j], nsa_cmp_pe[j],
                          nsa_cmp_w1[j], nsa_cmp_w2[j], nsa_w_out[j])
        else:
            y = mlstm_mixer(xn, mlstm_w_in[j], mlstm_gate_b[j], mlstm_head_norm[j], mlstm_w_out[j])
        x = x + y
        x = x + conv_glu_ffn(rms_norm(x, norm_ffn[i]), ffn_w_up[i], ffn_conv_w[i],
                             ffn_conv_b[i], ffn_w_down[i])
    return rms_norm(x, norm_final)
```

```cpp
#include <hip/hip_runtime.h>
#include <cstdio>
#include <cstdint>
namespace pg8 {
#define PG8_LAS __attribute__((address_space(3)))
typedef unsigned short bf16_t;
typedef short bf16x8 __attribute__((ext_vector_type(8)));
typedef float f32x4 __attribute__((ext_vector_type(4)));
typedef unsigned u32x4 __attribute__((ext_vector_type(4)));
constexpr int BM = 256, BK = 64, HALF = 128, HTB = HALF * BK * 2  , STAGE_BYTES = 8 * HTB, NXCD = 8, WGM = 8;

__host__ __device__ __forceinline__ int lds_byte(int r, int c) { const int st = (r >> 4) * 2 + (c >> 5), rr = r & 15, cc = c & 31, ob = rr * 64 + cc * 2; return st * 1024 + (ob ^ (((ob >> 9) & 1) << 5)); }
__host__ __device__ __forceinline__ void stage_rc(int b, int& R, int& C) { const int st = b / 1024, sb = b % 1024, swz = sb ^ (((sb >> 9) & 1) << 5); R = (st >> 1) * 16 + swz / 64; C = (st & 1) * 32 + (swz % 64) / 2; }
__host__ __device__ __forceinline__ int perm32(int rho) { const int n = rho >> 4, i = rho & 15; return 8 * (i >> 2) + 4 * n + (i & 3); }

struct Unit { int pm, pn, idx; };
struct Gemm { const bf16_t* A; const bf16_t* Bt; int M, N, K, wv; };

struct StaticOrder {
    int nM, nN, nwg, G, c;
    __host__ __device__ void init(int M, int N, int G_, int c_) { nM = M / BM; nN = N / BM; nwg = nM * nN; G = G_; c = c_; }
    __host__ __device__ bool next(int i, Unit& u) const {
        const long L = (long)i * G + c; if (L >= nwg) return false;
        int wgid = (int)L; { const int q = nwg / NXCD, r = nwg % NXCD, xcd = wgid % NXCD, off = wgid / NXCD; wgid = (xcd < r ? xcd * (q + 1) : r * (q + 1) + (xcd - r) * q) + off; }
        const int nig = WGM * nN, gid = wgid / nig, fm = gid * WGM, gsz = (nM - fm) < WGM ? (nM - fm) : WGM;
        u.pm = fm + ((wgid % nig) % gsz); u.pn = (wgid % nig) / gsz; u.idx = i; return true;
    }
    __device__ __forceinline__ void a_ready(const Unit&) const {}
    __device__ __forceinline__ void done(const Unit&) const {}
};
__device__ __forceinline__ unsigned cvt_pk_bf16(float lo, float hi) { unsigned r; asm volatile("v_cvt_pk_bf16_f32 %0, %1, %2" : "=v"(r) : "v"(lo), "v"(hi)); return r; }
typedef float f32x2 __attribute__((ext_vector_type(2)));
constexpr int EP_ROWS = 8192;
template <class Sched> __device__ __forceinline__ void prep_rstd(const float* ssp, const Sched& S, PG8_LAS float* tab, int tid) {
    float pv[3][32]; int slot[3];
#pragma unroll
    for (int q = 0; q < 3; ++q) { const int idx = tid + 512 * q, i = idx >> 8, r = idx & 255; Unit u; slot[q] = -1;
        const bool ok = S.next(i, u); if (ok) slot[q] = idx; const float* p = ssp + (ok ? u.pm * BM + r : 0);
#pragma unroll
        for (int j = 0; j < 32; ++j) pv[q][j] = p[(size_t)j * EP_ROWS]; }
#pragma unroll
    for (int q = 0; q < 3; ++q) { float s[4] = {0.f, 0.f, 0.f, 0.f};
#pragma unroll
        for (int j = 0; j < 32; j += 4) { s[0] += pv[q][j]; s[1] += pv[q][j + 1]; s[2] += pv[q][j + 2]; s[3] += pv[q][j + 3]; }
        if (slot[q] >= 0) tab[slot[q]] = 1.0f / sqrtf(((s[0] + s[1]) + (s[2] + s[3])) * (1.0f / 2048.0f) + 1e-6f); }
    __syncthreads();
}
struct EpiProj {
    static constexpr bool PERM = true, AFTER_DRAIN = false, ROWPERM = false, PREFETCH = false;
    bf16_t* O; int ldc; const PG8_LAS float* rtab; const float* ropetab;
    __device__ __forceinline__ void operator()(const f32x4 (&acc)[2][2][4][2], const Unit& u, int wr, int wc, int fr, int fq) const {
        const int row0 = u.pm * BM + wr * 64 + fr, col0 = u.pn * BM + wc * 32 + 8 * fq;
        const bool rk = (ropetab != nullptr) && (wc == 0) && (u.pn == 10 || u.pn == 12);
#pragma unroll
        for (int ai = 0; ai < 2; ++ai) {
#pragma unroll
          for (int mp = 0; mp < 4; mp += 2) {
            f32x4 tt[2][4];
            if (rk) {
#pragma unroll
                for (int m = 0; m < 2; ++m)
#pragma unroll
                    for (int q = 0; q < 4; ++q) tt[m][q] = *(const f32x4*)(ropetab + (size_t)(row0 + ai * HALF + (mp + m) * 16) * 32 + 16 * (fq & 1) + 4 * q); }
#pragma unroll
            for (int m = mp; m < mp + 2; ++m) { const int row = row0 + ai * HALF + m * 16; bf16_t* rowp = O + (size_t)row * ldc + col0; const float s = rtab[u.idx * 256 + ai * HALF + wr * 64 + m * 16 + fr];
                f32x4 c0, s0, c1, s1;
                if (rk) { const f32x4 t0 = tt[m - mp][0], t1 = tt[m - mp][1], t2 = tt[m - mp][2], t3 = tt[m - mp][3];
                    const float sg = (fq < 2) ? -1.0f : 1.0f;
                    c0 = (f32x4){t0[0], t0[2], t1[0], t1[2]}; s0 = (f32x4){t0[1], t0[3], t1[1], t1[3]} * sg; c1 = (f32x4){t2[0], t2[2], t3[0], t3[2]}; s1 = (f32x4){t2[1], t2[3], t3[1], t3[3]} * sg; }
#pragma unroll
                for (int bj = 0; bj < 2; ++bj) { f32x4 v0 = acc[ai][bj][m][0] * s, v1 = acc[ai][bj][m][1] * s;
                    if (rk) { f32x4 p0, p1;
#pragma unroll
                        for (int j = 0; j < 4; ++j) { p0[j] = __shfl_xor(v0[j], 32); p1[j] = __shfl_xor(v1[j], 32); }
                        v0 = v0 * c0 + p0 * s0; v1 = v1 * c1 + p1 * s1; }
                    u32x4 w; w.x = cvt_pk_bf16(v0[0], v0[1]); w.y = cvt_pk_bf16(v0[2], v0[3]); w.z = cvt_pk_bf16(v1[0], v1[1]); w.w = cvt_pk_bf16(v1[2], v1[3]);
                    *(u32x4*)(rowp + bj * HALF) = w; } } } }
    }
};
struct EpiNull { static constexpr bool PERM = true, AFTER_DRAIN = false, ROWPERM = false, PREFETCH = false; float* sink;
    __device__ __forceinline__ void operator()(const f32x4 (&acc)[2][2][4][2], const Unit& u, int wr, int wc, int fr, int fq) const { if (sink) { f32x4 t = acc[0][0][0][0];
#pragma unroll
        for (int ai = 0; ai < 2; ++ai)
#pragma unroll
            for (int bj = 0; bj < 2; ++bj)
#pragma unroll
                for (int m = 0; m < 4; ++m)
#pragma unroll
                    for (int n = 0; n < 2; ++n) t += acc[ai][bj][m][n];
        *(f32x4*)(sink + (size_t)(u.pm * 32 + u.pn) * 4) = t; } } };
__device__ __forceinline__ float dpp_shr1(float x) { return __builtin_bit_cast(float, __builtin_amdgcn_update_dpp(0, __builtin_bit_cast(int, x), 0x111, 0xf, 0xf, false)); }
__device__ __forceinline__ f32x4 dpp_shr1_4(f32x4 x) { f32x4 r; r[0] = dpp_shr1(x[0]); r[1] = dpp_shr1(x[1]); r[2] = dpp_shr1(x[2]); r[3] = dpp_shr1(x[3]); return r; }
__device__ __forceinline__ f32x4 silu_mul4(f32x4 g, f32x4 v) { f32x4 e = g * (-1.4426950408889634f), d;
    d[0] = __builtin_amdgcn_exp2f(e[0]); d[1] = __builtin_amdgcn_exp2f(e[1]); d[2] = __builtin_amdgcn_exp2f(e[2]); d[3] = __builtin_amdgcn_exp2f(e[3]); d = d + 1.0f;
    f32x4 r; r[0] = __builtin_amdgcn_rcpf(d[0]); r[1] = __builtin_amdgcn_rcpf(d[1]); r[2] = __builtin_amdgcn_rcpf(d[2]); r[3] = __builtin_amdgcn_rcpf(d[3]); return (g * v) * r; }
struct EpiUp {
    static constexpr bool PERM = true, AFTER_DRAIN = false, ROWPERM = true, PREFETCH = true;
    bf16_t* ACT; float* USIDE; const float* cw; const float* cb; const PG8_LAS float* rtab;
    static constexpr int TAPS_F = 6 * 256;
    __device__ __forceinline__ void prefetch(const Unit& u, int wid, int lane) const {
        if (wid < 4) { constexpr int DFF_ = 5632, NUP_ = 11264; const int seg = 2 * wid + (lane >> 5), cg = u.pn * HALF + 4 * (lane & 31);
            const float* src = ((seg < 2) ? cb : cw + (size_t)((seg >> 1) - 1) * NUP_) + ((seg & 1) ? DFF_ : 0) + cg;
            __builtin_amdgcn_global_load_lds((const unsigned*)src, (PG8_LAS unsigned*)(rtab + TAPS_F + (u.idx & 1) * 1024 + wid * 256), 16, 0, 0); } }
    __device__ __forceinline__ void operator()(const f32x4 (&acc)[2][2][4][2], const Unit& u, int wr, int wc, int fr, int fq) const {
        constexpr int DFF_ = 5632, NUP_ = 11264;
        typedef unsigned u32x2 __attribute__((ext_vector_type(2)));
#pragma unroll
        for (int n = 0; n < 2; ++n) {
            const int cg = u.pn * HALF + wc * 32 + 8 * fq + 4 * n;
            const PG8_LAS float* tp = rtab + TAPS_F + (u.idx & 1) * 1024 + wc * 32 + 8 * fq + 4 * n;
            const f32x4 bg = *(const PG8_LAS f32x4*)(tp), bv = *(const PG8_LAS f32x4*)(tp + 128);
            const f32x4 wg0 = *(const PG8_LAS f32x4*)(tp + 256), wg1 = *(const PG8_LAS f32x4*)(tp + 512), wg2 = *(const PG8_LAS f32x4*)(tp + 768);
            const f32x4 wv0 = *(const PG8_LAS f32x4*)(tp + 384), wv1 = *(const PG8_LAS f32x4*)(tp + 640), wv2 = *(const PG8_LAS f32x4*)(tp + 896);
#pragma unroll
            for (int ai = 0; ai < 2; ++ai) {
                const int rl0 = ai * HALF + wr * 64 + 4 * fr, row0 = u.pm * BM + rl0;
                const f32x4 sc = *(const PG8_LAS f32x4*)(rtab + u.idx * 256 + rl0);
                const f32x4 g0 = acc[ai][0][0][n] * sc[0], g1 = acc[ai][0][1][n] * sc[1], g2 = acc[ai][0][2][n] * sc[2], g3 = acc[ai][0][3][n] * sc[3];
                const f32x4 v0 = acc[ai][1][0][n] * sc[0], v1 = acc[ai][1][1][n] * sc[1], v2 = acc[ai][1][2][n] * sc[2], v3 = acc[ai][1][3][n] * sc[3];
                const f32x4 gp3 = dpp_shr1_4(g3), gp2 = dpp_shr1_4(g2), vp3 = dpp_shr1_4(v3), vp2 = dpp_shr1_4(v2);
                if (fr == 15) { float* sp = USIDE + ((size_t)(row0 >> 6) * 4) * NUP_ + cg;
                    *(f32x4*)(sp) = g2; *(f32x4*)(sp + DFF_) = v2; *(f32x4*)(sp + NUP_) = g3; *(f32x4*)(sp + NUP_ + DFF_) = v3; }
                if (fr == 0) { float* sp = USIDE + ((size_t)(row0 >> 6) * 4 + 2) * NUP_ + cg;
                    *(f32x4*)(sp) = g0; *(f32x4*)(sp + DFF_) = v0; *(f32x4*)(sp + NUP_) = g1; *(f32x4*)(sp + NUP_ + DFF_) = v1; }
                const f32x4 a0 = silu_mul4(bg + wg0 * gp2 + wg1 * gp3 + wg2 * g0, bv + wv0 * vp2 + wv1 * vp3 + wv2 * v0);
                const f32x4 a1 = silu_mul4(bg + wg0 * gp3 + wg1 * g0 + wg2 * g1, bv + wv0 * vp3 + wv1 * v0 + wv2 * v1);
                const f32x4 a2 = silu_mul4(bg + wg0 * g0 + wg1 * g1 + wg2 * g2, bv + wv0 * v0 + wv1 * v1 + wv2 * v2);
                const f32x4 a3 = silu_mul4(bg + wg0 * g1 + wg1 * g2 + wg2 * g3, bv + wv0 * v1 + wv1 * v2 + wv2 * v3);
                bf16_t* op = ACT + (size_t)row0 * DFF_ + cg; u32x2 w;
                if (fr != 0) { w.x = cvt_pk_bf16(a0[0], a0[1]); w.y = cvt_pk_bf16(a0[2], a0[3]); *(u32x2*)(op) = w;
                               w.x = cvt_pk_bf16(a1[0], a1[1]); w.y = cvt_pk_bf16(a1[2], a1[3]); *(u32x2*)(op + DFF_) = w; }
                w.x = cvt_pk_bf16(a2[0], a2[1]); w.y = cvt_pk_bf16(a2[2], a2[3]); *(u32x2*)(op + 2 * DFF_) = w;
                w.x = cvt_pk_bf16(a3[0], a3[1]); w.y = cvt_pk_bf16(a3[2], a3[3]); *(u32x2*)(op + 3 * DFF_) = w;
            }
        }
    }
};
struct EpiRes {
    static constexpr bool PERM = true, AFTER_DRAIN = false, ROWPERM = false, PREFETCH = false;
    const float* basef; bf16_t* xb; float* ssp;
    __device__ __forceinline__ void operator()(const f32x4 (&acc)[2][2][4][2], const Unit& u, int wr, int wc, int fr, int fq) const {
        const int row0 = u.pm * BM + wr * 64 + fr, col0 = u.pn * BM + wc * 32 + 8 * fq;
        u32x4 pbv[2][4][2];
        if (!basef) {
#pragma unroll
            for (int ai = 0; ai < 2; ++ai)
#pragma unroll
                for (int m = 0; m < 4; ++m)
#pragma unroll
                    for (int bj = 0; bj < 2; ++bj) pbv[ai][m][bj] = *(const u32x4*)(xb + (size_t)(row0 + ai * HALF + m * 16) * 2048 + col0 + bj * HALF);
        }
#pragma unroll
        for (int ai = 0; ai < 2; ++ai)
#pragma unroll
            for (int m = 0; m < 4; ++m) { const int row = row0 + ai * HALF + m * 16; const size_t off = (size_t)row * 2048 + col0; float ss = 0.f;
#pragma unroll
                for (int bj = 0; bj < 2; ++bj) { f32x4 b0, b1;
                    if (basef) { b0 = *(const f32x4*)(basef + off + bj * HALF); b1 = *(const f32x4*)(basef + off + bj * HALF + 4); }
                    else { const u32x4 pb = pbv[ai][m][bj];
                        b0 = (f32x4){__builtin_bit_cast(float, pb.x << 16), __builtin_bit_cast(float, pb.x & 0xffff0000u), __builtin_bit_cast(float, pb.y << 16), __builtin_bit_cast(float, pb.y & 0xffff0000u)};
                        b1 = (f32x4){__builtin_bit_cast(float, pb.z << 16), __builtin_bit_cast(float, pb.z & 0xffff0000u), __builtin_bit_cast(float, pb.w << 16), __builtin_bit_cast(float, pb.w & 0xffff0000u)}; }
                    const f32x4 v0 = acc[ai][bj][m][0] + b0, v1 = acc[ai][bj][m][1] + b1;
                    ss += (v0[0] * v0[0] + v0[1] * v0[1]) + (v0[2] * v0[2] + v0[3] * v0[3]) + (v1[0] * v1[0] + v1[1] * v1[1]) + (v1[2] * v1[2] + v1[3] * v1[3]);
                    u32x4 w; w.x = cvt_pk_bf16(v0[0], v0[1]); w.y = cvt_pk_bf16(v0[2], v0[3]); w.z = cvt_pk_bf16(v1[0], v1[1]); w.w = cvt_pk_bf16(v1[2], v1[3]);
                    *(u32x4*)(xb + off + bj * HALF) = w; }
                ss += __shfl_xor(ss, 16); ss += __shfl_xor(ss, 32);
                if (fq == 0) ssp[(size_t)(u.pn * 4 + wc) * EP_ROWS + row] = ss; }
    }
};
template <class Epi, class Sched, bool ALIGN_EPI = false, bool SP2 = false>
__device__ __forceinline__ void gemm_phase(PG8_LAS unsigned char* lds, const Gemm g, const Sched& S, const Epi& E) {
    int tid_; { unsigned z_ = 0u; asm volatile("" : "+v"(z_)); tid_ = (g.wv << 6) | (int)__builtin_amdgcn_mbcnt_hi(~0u, __builtin_amdgcn_mbcnt_lo(~0u, z_)); } asm volatile("" : "+v"(tid_));
    const int tid = tid_, wid = __builtin_amdgcn_readfirstlane(tid >> 6), lane = tid & 63, wr = wid >> 2, wc = wid & 3, fr = lane & 15, fq = lane >> 4;
    const int K = g.K, nt = K / BK;
    unsigned voffA[2], voffB[2];
#pragma unroll
    for (int i = 0; i < 2; ++i) { int R, C; stage_rc(tid * 16 + i * 8192, R, C); const int Rb = Epi::PERM ? ((R & ~31) + perm32(R & 31)) : R;
        const int Ra = Epi::ROWPERM ? ((R & 64) + 4 * (R & 15) + ((R >> 4) & 3)) : R;
        voffA[i] = (unsigned)(Ra * K + C) * 2u; voffB[i] = (unsigned)(Rb * K + C) * 2u; }
    const size_t kstep = (size_t)(BK * 2);
    const size_t hstep = (size_t)HALF * K * 2;
    const size_t tstep = 2 * hstep;
    const unsigned ldsw = (unsigned)wid * 1024u;
    const int aoff = lds_byte(wr * 64 + fr, fq * 8), boff = lds_byte(wc * 32 + fr, fq * 8);
#define PG8_SA(b, h) (((b) * 2 + (h)) * HTB)
#define PG8_SB(b, h) ((4 + (b) * 2 + (h)) * HTB)
#define PG8_STAGE(bufoff, gbase, voff) do { _Pragma("unroll") for (int _i = 0; _i < 2; ++_i) \
        __builtin_amdgcn_global_load_lds((const unsigned*)((const char*)(gbase) + (voff)[_i]), (PG8_LAS unsigned*)(lds + (bufoff) + ldsw + _i * 8192), 16, 0, 0); } while (0)
#define PG8_LDA(dst, b, h) do { _Pragma("unroll") for (int m = 0; m < 4; ++m) _Pragma("unroll") for (int k = 0; k < 2; ++k) dst[m][k] = *(const PG8_LAS bf16x8*)(lds + PG8_SA(b, h) + aoff + m * 2048 + k * 1024); } while (0)
#define PG8_LDB(dst, b, h) do { _Pragma("unroll") for (int n = 0; n < 2; ++n) _Pragma("unroll") for (int k = 0; k < 2; ++k) dst[n][k] = *(const PG8_LAS bf16x8*)(lds + PG8_SB(b, h) + boff + n * 2048 + k * 1024); } while (0)
#define PG8_MMA(ai, bj, At, Bt) do { __builtin_amdgcn_s_setprio(1); _Pragma("unroll") for (int m = 0; m < 4; ++m) _Pragma("unroll") for (int n = 0; n < 2; ++n) _Pragma("unroll") for (int k = 0; k < 2; ++k) \
        acc[ai][bj][m][n] = __builtin_amdgcn_mfma_f32_16x16x32_bf16(Bt[n][k], At[m][k], acc[ai][bj][m][n], 0, 0, 0); __builtin_amdgcn_s_setprio(0); } while (0)
#define PG8_WAIT_V(n) asm volatile("s_waitcnt vmcnt(" #n ")" ::: "memory")
#define PG8_WAIT_L(n) asm volatile("s_waitcnt lgkmcnt(" #n ")" ::: "memory")
#define PG8_BAR __builtin_amdgcn_s_barrier()
#define PG8_SCHED __builtin_amdgcn_sched_barrier(0)
    Unit cur, nxt; int ui = 0;
    if (!S.next(0, cur)) return;
    f32x4 acc[2][2][4][2];
#pragma unroll
    for (int a = 0; a < 2; ++a)
#pragma unroll
        for (int b = 0; b < 2; ++b)
#pragma unroll
            for (int m = 0; m < 4; ++m)
#pragma unroll
                for (int n = 0; n < 2; ++n) acc[a][b][m][n] = (f32x4){0.f, 0.f, 0.f, 0.f};
    bf16x8 At[4][2], B0[2][2], B1[2][2];
    const char* cA = (const char*)g.A + (size_t)cur.pm * tstep; const char* cB = (const char*)g.Bt + (size_t)cur.pn * tstep;
    S.a_ready(cur);
    if constexpr (SP2) {
        PG8_STAGE(PG8_SB(0, 0), cB, voffB); PG8_STAGE(PG8_SB(0, 1), cB + hstep, voffB); PG8_STAGE(PG8_SA(0, 0), cA, voffA); PG8_STAGE(PG8_SA(0, 1), cA + hstep, voffA);
        if (wr == 1) PG8_BAR;
        PG8_WAIT_V(2); PG8_BAR;
        PG8_STAGE(PG8_SB(1, 0), cB + kstep, voffB); PG8_STAGE(PG8_SA(1, 0), cA + kstep, voffA); PG8_STAGE(PG8_SB(1, 1), cB + hstep + kstep, voffB);
        PG8_WAIT_V(6); PG8_BAR;
    } else {
        PG8_STAGE(PG8_SB(0, 0), cB, voffB); PG8_STAGE(PG8_SA(0, 0), cA, voffA); PG8_STAGE(PG8_SB(0, 1), cB + hstep, voffB); PG8_STAGE(PG8_SA(0, 1), cA + hstep, voffA);
        if (wr == 1) PG8_BAR;
        PG8_WAIT_V(4); PG8_BAR;
        PG8_STAGE(PG8_SB(1, 0), cB + kstep, voffB); PG8_STAGE(PG8_SA(1, 0), cA + kstep, voffA); PG8_STAGE(PG8_SB(1, 1), cB + hstep + kstep, voffB);
        PG8_WAIT_V(6); PG8_BAR;
    }
    for (;;) {
        const bool has_next = S.next(ui + 1, nxt);
        const char* nA = has_next ? (const char*)g.A + (size_t)nxt.pm * tstep : cA; const char* nB = has_next ? (const char*)g.Bt + (size_t)nxt.pn * tstep : cB;
        if constexpr (Epi::PREFETCH) E.prefetch(cur, wid, lane);
        for (int t = 0; t < nt; t += 2) {
            const bool last = (t == nt - 2);
            const char* a1 = cA + (size_t)(t + 1) * kstep;
            const char* a2 = last ? nA : cA + (size_t)(t + 2) * kstep; const char* b2 = last ? nB : cB + (size_t)(t + 2) * kstep;
            const char* a3 = a2 + kstep; const char* b3 = b2 + kstep;
            if (last && has_next) S.a_ready(nxt);
            if constexpr (SP2) {
            PG8_LDB(B0, 0, 0); PG8_LDB(B1, 0, 1); PG8_SCHED; PG8_LDA(At, 0, 0); PG8_STAGE(PG8_SA(1, 1), a1 + hstep, voffA);
            PG8_WAIT_V(8); PG8_WAIT_L(0); PG8_BAR; PG8_MMA(0, 0, At, B0); PG8_MMA(0, 1, At, B1); PG8_BAR; PG8_SCHED;
            PG8_LDA(At, 0, 1); PG8_STAGE(PG8_SB(0, 0), b2, voffB); PG8_STAGE(PG8_SB(0, 1), b2 + hstep, voffB); PG8_STAGE(PG8_SA(0, 0), a2, voffA);
            PG8_WAIT_V(8); PG8_WAIT_L(0); PG8_BAR; PG8_MMA(1, 0, At, B0); PG8_MMA(1, 1, At, B1); PG8_BAR; PG8_SCHED;
            PG8_LDB(B0, 1, 0); PG8_LDB(B1, 1, 1); PG8_SCHED; PG8_LDA(At, 1, 0); PG8_STAGE(PG8_SA(0, 1), a2 + hstep, voffA);
            PG8_WAIT_V(8); PG8_WAIT_L(0); PG8_BAR; PG8_MMA(0, 0, At, B0); PG8_MMA(0, 1, At, B1); PG8_BAR; PG8_SCHED;
            PG8_LDA(At, 1, 1); PG8_STAGE(PG8_SB(1, 0), b3, voffB); PG8_STAGE(PG8_SB(1, 1), b3 + hstep, voffB); PG8_STAGE(PG8_SA(1, 0), a3, voffA);
            PG8_WAIT_V(8); PG8_WAIT_L(0); PG8_BAR; PG8_MMA(1, 0, At, B0); PG8_MMA(1, 1, At, B1); PG8_BAR; PG8_SCHED;
            } else {
            PG8_LDB(B0, 0, 0); PG8_SCHED; PG8_LDA(At, 0, 0); PG8_STAGE(PG8_SA(1, 1), a1 + hstep, voffA);
            PG8_WAIT_L(8); PG8_BAR; PG8_WAIT_L(0); PG8_MMA(0, 0, At, B0); PG8_BAR; PG8_SCHED;
            PG8_LDB(B1, 0, 1); PG8_STAGE(PG8_SB(0, 0), b2, voffB);
            PG8_BAR; PG8_WAIT_L(0); PG8_MMA(0, 1, At, B1); PG8_BAR;
            PG8_LDA(At, 0, 1); PG8_STAGE(PG8_SA(0, 0), a2, voffA);
            PG8_BAR; PG8_WAIT_L(0); PG8_MMA(1, 0, At, B0); PG8_BAR; PG8_SCHED;
            PG8_STAGE(PG8_SB(0, 1), b2 + hstep, voffB);
            PG8_WAIT_V(6); PG8_BAR; PG8_MMA(1, 1, At, B1); PG8_BAR;
            PG8_LDB(B0, 1, 0); PG8_SCHED; PG8_LDA(At, 1, 0); PG8_STAGE(PG8_SA(0, 1), a2 + hstep, voffA);
            PG8_WAIT_L(8); PG8_BAR; PG8_WAIT_L(0); PG8_MMA(0, 0, At, B0); PG8_BAR; PG8_SCHED;
            PG8_LDB(B1, 1, 1); PG8_STAGE(PG8_SB(1, 0), b3, voffB);
            PG8_BAR; PG8_WAIT_L(0); PG8_MMA(0, 1, At, B1); PG8_BAR;
            PG8_LDA(At, 1, 1); PG8_STAGE(PG8_SA(1, 0), a3, voffA);
            PG8_BAR; PG8_WAIT_L(0); PG8_MMA(1, 0, At, B0); PG8_BAR; PG8_SCHED;
            PG8_STAGE(PG8_SB(1, 1), b3 + hstep, voffB);
            PG8_WAIT_V(6); PG8_BAR; PG8_MMA(1, 1, At, B1); PG8_BAR;
            }
        }
        if constexpr (ALIGN_EPI) { if (wr == 0) PG8_BAR; }
        if constexpr (!Epi::AFTER_DRAIN) { E(acc, cur, wr, wc, fr, fq); S.done(cur); }
        if (!has_next) break;
#pragma unroll
        for (int a = 0; a < 2; ++a)
#pragma unroll
            for (int b = 0; b < 2; ++b)
#pragma unroll
                for (int m = 0; m < 4; ++m)
#pragma unroll
                    for (int n = 0; n < 2; ++n) acc[a][b][m][n] = (f32x4){0.f, 0.f, 0.f, 0.f};
        cur = nxt; cA = nA; cB = nB; ++ui;
        if constexpr (ALIGN_EPI) { if (wr == 1) PG8_BAR; }
    }
    PG8_WAIT_V(0);
    if constexpr (!ALIGN_EPI) { if (wr == 0) PG8_BAR; }
    PG8_BAR;
    if constexpr (Epi::AFTER_DRAIN) { E.fused(acc, cur, wr, wc, fr, fq, lds, wid, lane); S.done(cur); }
#undef PG8_SA
#undef PG8_SB
#undef PG8_STAGE
#undef PG8_LDA
#undef PG8_LDB
#undef PG8_MMA
#undef PG8_WAIT_V
#undef PG8_WAIT_L
#undef PG8_BAR
#undef PG8_SCHED
}
}
#ifndef MK_ONE_LAUNCH
#define MK_ONE_LAUNCH 1
#endif
constexpr int NWAVES = 8, NTHREADS = 512;
constexpr int NB = 4, SEQ = 2048, DM = 2048, MROWS = NB * SEQ, DEPTH = 4;
constexpr int NSA_N = 3632, NSA_NP = 3840;
constexpr int PC_Q = 0, PC_KVC = 2048, PC_KVS = 2560, PC_KVW = 3072, PC_GATE = 3584;
constexpr int ML_N = 6160, ML_NP = 6144;
constexpr int MC_Q = 0, MC_K = 1024, MC_V = 2048, MC_OG = 4096;
constexpr int DFF = 5632, NUP = 2 * DFF;
constexpr int NCMP = 127;
constexpr float ATT_SCALE = 0.08838834764831845f;
constexpr size_t al256(size_t x) { return (x + 255) & ~(size_t)255; }
constexpr size_t WS_CTL = 0, CTL_BYTES = 1u << 20;
constexpr size_t SZ_WNSA = (size_t)NSA_NP * DM * 2, SZ_WML = (size_t)ML_NP * DM * 2, SZ_WOUT = (size_t)DM * DM * 2, SZ_WUP = (size_t)NUP * DM * 2, SZ_WDN = (size_t)DM * DFF * 2;
constexpr size_t WS_WNSA = WS_CTL + CTL_BYTES;
constexpr size_t WS_WML = WS_WNSA + 2 * SZ_WNSA;
constexpr size_t WS_WOUT = WS_WML + 2 * SZ_WML;
constexpr size_t WS_WUP = WS_WOUT + 4 * SZ_WOUT;
constexpr size_t WS_WDN = WS_WUP + 4 * SZ_WUP;
constexpr size_t WS_XR = WS_WDN + 4 * SZ_WDN;
constexpr size_t WS_XB = WS_XR + (size_t)MROWS * DM * 4;
constexpr size_t WS_SSP = WS_XB + (size_t)MROWS * DM * 2;
constexpr size_t WS_P = WS_SSP + (size_t)32 * MROWS * 4;
constexpr size_t WS_QR = WS_P + (size_t)MROWS * ML_NP * 2;
constexpr size_t WS_KC = WS_QR + (size_t)MROWS * DM * 2;
constexpr size_t WS_VC = WS_KC + (size_t)NB * 2 * 128 * 128 * 4;
constexpr size_t WS_O = WS_VC + (size_t)NB * 2 * 128 * 128 * 4;
constexpr size_t WS_U = WS_O + (size_t)MROWS * DM * 2;
constexpr size_t WS_ACT = WS_U + (size_t)MROWS * NUP * 2;
constexpr size_t WS_ROPE = WS_ACT + (size_t)MROWS * DFF * 2;
constexpr size_t WS_GATES = WS_ROPE + (size_t)MROWS * 32 * 4;
constexpr size_t WS_HRAW = WS_GATES + (size_t)MROWS * 16 * 4;
constexpr size_t WS_HSS = WS_HRAW + (size_t)MROWS * DM * 4;
constexpr size_t WS_W1T = WS_HSS + (size_t)MROWS * 64 * 4;
constexpr size_t WS_W2T = WS_W1T + (size_t)2 * 2 * 32 * 128 * 128 * 2;
constexpr size_t WS_WGT = WS_W2T + (size_t)2 * 2 * 128 * 128 * 2;
constexpr size_t WS_END = WS_WGT + (size_t)2 * 16 * DM * 2;
constexpr int CW_BAR = 4096;
constexpr int RING_BYTES = 131072, LDS_BYTES = 163840, MISC_OFF = LDS_BYTES - 256, RSTD_OFF = 135168;

#define GAS __attribute__((address_space(1)))
#define LAS __attribute__((address_space(3)))
typedef unsigned short bf16;
typedef unsigned v4u __attribute__((ext_vector_type(4)));
typedef unsigned v2u __attribute__((ext_vector_type(2)));
typedef float f32x4 __attribute__((ext_vector_type(4)));
typedef float f32x2 __attribute__((ext_vector_type(2)));
#define LDS_WAIT() asm volatile("s_waitcnt lgkmcnt(0)" ::: "memory")
__device__ __forceinline__ unsigned f2bf(float f) { unsigned u = __builtin_bit_cast(unsigned, f); return (u + 0x7fffu + ((u >> 16) & 1u)) >> 16; }
__device__ __forceinline__ unsigned pk2(float lo, float hi) { return f2bf(lo) | (f2bf(hi) << 16); }
__device__ __forceinline__ float bf2f(unsigned short b) { return __builtin_bit_cast(float, (unsigned)b << 16); }
__device__ __forceinline__ float bflo(unsigned w) { return __builtin_bit_cast(float, w << 16); }
__device__ __forceinline__ float bfhi(unsigned w) { return __builtin_bit_cast(float, w & 0xffff0000u); }
__device__ __forceinline__ int hw_lane() { unsigned z = 0u; asm volatile("" : "+v"(z)); return (int)__builtin_amdgcn_mbcnt_hi(~0u, __builtin_amdgcn_mbcnt_lo(~0u, z)); }
__device__ __forceinline__ float wave_sum(float v) {
#pragma unroll
    for (int o = 1; o < 64; o <<= 1) v += __shfl_xor(v, o);
    return v;
}
__device__ __forceinline__ float wave_max(float v) {
#pragma unroll
    for (int o = 1; o < 64; o <<= 1) v = fmaxf(v, __shfl_xor(v, o));
    return v;
}
__device__ __forceinline__ float sigmoidf_(float x) { return 1.0f / (1.0f + __expf(-x)); }
__device__ __forceinline__ float tanhf_(float y) { return 1.0f - 2.0f / (__expf(2.0f * y) + 1.0f); }
#define XB_TMO      128
#define XB_XCNT(j)  (256  + 64 * (j))
#define XB_XSUB(j)  (1280 + 64 * (j))
#define XB_XGEN(j)  (2304 + 64 * (j))
#define XB_TOP      3328
#define XB_TOPGEN   3392
#define XCD_BAR_WORDS 3456
#define XB_SPIN_CAP (1u << 18)

__device__ __forceinline__ unsigned xb_ld(unsigned* p)              { return __hip_atomic_load(p, __ATOMIC_RELAXED, __HIP_MEMORY_SCOPE_AGENT); }
__device__ __forceinline__ unsigned xb_add(unsigned* p, unsigned v) { return __hip_atomic_fetch_add(p, v, __ATOMIC_RELAXED, __HIP_MEMORY_SCOPE_AGENT); }
__device__ __forceinline__ unsigned xb_xcc_id() { return (unsigned)__builtin_amdgcn_s_getreg((3 << 11) | 20) & 0xFu; }
#define XB_SPIN(cond, bar) do { unsigned _sp = 0; while (cond) { __builtin_amdgcn_s_sleep(1); \
    if ((++_sp & 255u) == 0u) { if (xb_ld(&(bar)[XB_TMO])) break; if (_sp > XB_SPIN_CAP) { atomicAdd(&(bar)[XB_TMO], 1u); break; } } } } while (0)

struct XcdBarrier {
    unsigned* bar; unsigned x; int wv;
    volatile LAS unsigned* st;
};

__device__ __forceinline__ bool xb_thread0(int wv) { return wv == 0 && hw_lane() == 0; }
__device__ __forceinline__ XcdBarrier xcd_barrier_post(unsigned* bar, volatile LAS unsigned* st, int wv) {
    XcdBarrier b; b.bar = bar; b.x = xb_xcc_id(); b.st = st; b.wv = wv;
    if (xb_thread0(wv)) (void)xb_add(&bar[XB_XCNT(b.x)], 1u);
    return b;
}
__device__ __forceinline__ void xcd_barrier_complete(unsigned* bar, unsigned x, unsigned& nloc, unsigned& nx) {
    const unsigned G = gridDim.x * gridDim.y * gridDim.z;
    unsigned sum, cnt, mine, sp = 0u;
    for (;;) {
        sum = 0u; cnt = 0u; mine = 0u;
#pragma unroll
        for (unsigned j = 0; j < 16; ++j) { const unsigned c = xb_ld(&bar[XB_XCNT(j)]); sum += c; cnt += (c > 0u) ? 1u : 0u; mine = (j == x) ? c : mine; }
        if (sum == G) break;
        __builtin_amdgcn_s_sleep(1);
        if ((++sp & 255u) == 0u) { if (xb_ld(&bar[XB_TMO])) break; if (sp > XB_SPIN_CAP) { atomicAdd(&bar[XB_TMO], 1u); break; } }
    }
    nloc = mine > 0u ? mine : 1u; nx = cnt > 0u ? cnt : 1u;
}

__device__ __forceinline__ void xcd_barrier(const XcdBarrier& b) {
    asm volatile("s_waitcnt vmcnt(0)" ::: "memory");
    __syncthreads();
    if (xb_thread0(b.wv)) {
        unsigned* bar = b.bar;
        __builtin_amdgcn_s_waitcnt(0);
        unsigned nloc = b.st[0], nx = b.st[1];
        if (nloc == 0u) { xcd_barrier_complete(bar, b.x, nloc, nx); b.st[0] = nloc; b.st[1] = nx; }
        const unsigned old = xb_add(&bar[XB_XSUB(b.x)], 1u);
        const unsigned gen = old / nloc;
        if (old + 1u == (gen + 1u) * nloc) {
            __builtin_amdgcn_fence(__ATOMIC_RELEASE, "agent");
            asm volatile("s_waitcnt vmcnt(0)" ::: "memory");
            const unsigned og = xb_add(&bar[XB_TOP], 1u);
            const unsigned tg = og / nx;
            if (og + 1u == (tg + 1u) * nx) xb_add(&bar[XB_TOPGEN], 1u);
            else XB_SPIN(xb_ld(&bar[XB_TOPGEN]) == tg, bar);
            __builtin_amdgcn_fence(__ATOMIC_ACQUIRE, "agent");
            xb_add(&bar[XB_XGEN(b.x)], 1u);
            asm volatile("s_waitcnt vmcnt(0)" ::: "memory");
        } else {
            XB_SPIN(xb_ld(&bar[XB_XGEN(b.x)]) == gen, bar);
            __builtin_amdgcn_fence(__ATOMIC_ACQUIRE, "agent");
            asm volatile("s_waitcnt vmcnt(0)" ::: "memory");
        }
    }
    __syncthreads();
}
__constant__ double c_rope_inv[16] = {1.0, 0.44036660267178046, 0.19392274474868576, 0.08539710028576561, 0.03760603093086393, 0.016560440080994446, 0.007292664737217109, 0.003211445994752591,
    0.001414213562373095, 0.000622772421914596, 0.0002742481756762073, 0.00012076973741146504, 5.318295896944988e-05, 2.341999896140934e-05, 1.031338537721246e-05, 4.5416704806078695e-06};

__device__ __forceinline__ void cvt_item(const float* W, int ldw, int nvalid, const float* gain, bf16* WT, int K, int npad, int mode, LAS float* scr, int item, int lane) {
    const int nblk = npad / 64; int kb, nb;
    if (nblk >= 4) { const int q8 = item >> 3, r8 = item & 7, nq = nblk >> 2, kbp = q8 / nq, nbq = q8 - kbp * nq; kb = 2 * kbp + (r8 >> 2); nb = 4 * nbq + (r8 & 3); }
    else { kb = item / nblk; nb = item - kb * nblk; }
    const int k0 = 64 * kb, n0 = 64 * nb;
    const int kl = lane >> 4, nl = (lane & 15) * 4; const bool ok = (n0 + nl) < nvalid;
    f32x4 v[16]; const int c = lane & 7;
    const int ncol = ok ? n0 + nl : 0;
#pragma unroll
    for (int i = 0; i < 16; ++i) v[i] = *(const GAS f32x4*)(W + (size_t)(k0 + kl + 4 * i) * ldw + ncol);
    if (!ok) {
#pragma unroll
        for (int i = 0; i < 16; ++i) v[i] = (f32x4){0.f, 0.f, 0.f, 0.f}; }
#pragma unroll
    for (int i = 0; i < 16; ++i) { const int kk = kl + 4 * i; LAS float* d = scr + kk * 65 + nl; d[0] = v[i].x; d[1] = v[i].y; d[2] = v[i].z; d[3] = v[i].w; }
    f32x4 g0 = (f32x4){1.f, 1.f, 1.f, 1.f}, g1 = g0;
    if (gain) { g0 = *(const f32x4*)(gain + k0 + 8 * c); g1 = *(const f32x4*)(gain + k0 + 8 * c + 4); }
    LDS_WAIT(); asm volatile("" ::: "memory");
#pragma unroll
    for (int j = 0; j < 8; ++j) { const int n = (lane >> 3) + 8 * j; const LAS float* sp = scr + (8 * c) * 65 + n;
        v4u o; o.x = pk2(sp[0 * 65] * g0.x, sp[1 * 65] * g0.y); o.y = pk2(sp[2 * 65] * g0.z, sp[3 * 65] * g0.w); o.z = pk2(sp[4 * 65] * g1.x, sp[5 * 65] * g1.y); o.w = pk2(sp[6 * 65] * g1.z, sp[7 * 65] * g1.w);
        const int nn = n0 + n; int row = nn;
        if (mode == 1) { row = (nn < DFF) ? (256 * (nn >> 7) + (nn & 127)) : (256 * ((nn - DFF) >> 7) + 128 + ((nn - DFF) & 127)); }
        *(GAS v4u*)(WT + (size_t)row * K + k0 + 8 * c) = o; }
    LDS_WAIT(); asm volatile("" ::: "memory");
}

struct Ptrs {
    const float *x; const int* pos;
    const float *nsa_w_in, *nsa_gate_b, *nsa_pe, *nsa_w1, *nsa_w2, *nsa_w_out;
    const float *ml_w_in, *ml_gate_b, *ml_head_norm, *ml_w_out;
    const float *norm_mix, *norm_ffn, *w_up, *conv_w, *conv_b, *w_down, *norm_final;
    float* out; unsigned char* ws;
};

constexpr int CV_NSA_IN = 32 * (NSA_NP / 64), CV_ML_IN = 32 * (ML_NP / 64), CV_OUT = 32 * 32, CV_UP = 32 * (NUP / 64), CV_DN = (DFF / 64) * 32;
__device__ __forceinline__ int cv_layer_items(int layer) { return ((layer & 1) ? CV_ML_IN : CV_NSA_IN) + CV_OUT + CV_UP + CV_DN; }
__device__ __forceinline__ void convert_layer(const Ptrs& A, int layer, int it_lo, int it_hi, int rank, int nranks, LAS float* scr, int lane) {
    const bool ml = layer & 1; const int jl = layer >> 1; const int n_in = ml ? CV_ML_IN : CV_NSA_IN;
    for (int it = it_lo + rank; it < it_hi; it += nranks) {
        if (it < n_in) {
            if (ml) cvt_item(A.ml_w_in + (size_t)jl * DM * ML_N, ML_N, ML_NP, A.norm_mix + (size_t)layer * DM, (bf16*)(A.ws + WS_WML + jl * SZ_WML), DM, ML_NP, 0, scr, it, lane);
            else cvt_item(A.nsa_w_in + (size_t)jl * DM * NSA_N, NSA_N, NSA_N, A.norm_mix + (size_t)layer * DM, (bf16*)(A.ws + WS_WNSA + jl * SZ_WNSA), DM, NSA_NP, 0, scr, it, lane);
        } else if (it < n_in + CV_OUT) cvt_item((ml ? A.ml_w_out : A.nsa_w_out) + (size_t)jl * DM * DM, DM, DM, nullptr, (bf16*)(A.ws + WS_WOUT + layer * SZ_WOUT), DM, DM, 0, scr, it - n_in, lane);
        else if (it < n_in + CV_OUT + CV_UP) cvt_item(A.w_up + (size_t)layer * DM * NUP, NUP, NUP, A.norm_ffn + (size_t)layer * DM, (bf16*)(A.ws + WS_WUP + layer * SZ_WUP), DM, NUP, 1, scr, it - n_in - CV_OUT, lane);
        else cvt_item(A.w_down + (size_t)layer * DFF * DM, DM, DM, nullptr, (bf16*)(A.ws + WS_WDN + layer * SZ_WDN), DFF, DM, 0, scr, it - n_in - CV_OUT - CV_UP, lane);
    }
}
#ifndef CV_TAIL_PCT
#define CV_TAIL_PCT 35
#endif
__device__ __forceinline__ int cv_tail_items(int layer, int G) { const int nwg = (MROWS / 256) * (NUP / 256); const int idle = (nwg % G) ? G - nwg % G : 0; return (layer >= 1 && idle >= 64) ? (int)((long)cv_layer_items(layer) * CV_TAIL_PCT / 100) : 0; }

#ifndef CV_SLOT_ITEMS
#define CV_SLOT_ITEMS 2800
#endif
__device__ __forceinline__ int cv_slot_items(int layer, int G) { return (!(layer & 1) && G >= 128) ? CV_SLOT_ITEMS : 0; }
#ifndef CV_INSLOT_ITEMS
#define CV_INSLOT_ITEMS 2048
#endif
__device__ __forceinline__ int cv_inslot_items(int layer, int G) { return ((layer & 1) && G == 256) ? CV_INSLOT_ITEMS : 0; }

__device__ __forceinline__ void phase_prologue(const Ptrs& A, LAS unsigned char* lds, int G, int vcu, int wave, int lane, int tid) {
    LAS float* scr = (LAS float*)(lds + wave * 16640);
    const int gw = vcu * NWAVES + wave, NGW = G * NWAVES;
    for (int layer = 0; layer < DEPTH; ++layer) convert_layer(A, layer, cv_tail_items(layer, G) + cv_inslot_items(layer, G), cv_layer_items(layer) - cv_slot_items(layer, G), gw, NGW, scr, lane);
    for (int it = gw; it < 132 * 4; it += NGW) { const int m = it >> 2;
        if (m < 128) cvt_item(A.nsa_w1 + (size_t)m * 128 * 128, 128, 128, nullptr, (bf16*)(A.ws + WS_W1T) + (size_t)m * 128 * 128, 128, 128, 0, scr, it & 3, lane);
        else cvt_item(A.nsa_w2 + (size_t)(m - 128) * 128 * 128, 128, 128, nullptr, (bf16*)(A.ws + WS_W2T) + (size_t)(m - 128) * 128 * 128, 128, 128, 0, scr, it & 3, lane); }
    for (int idx = vcu * NTHREADS + tid; idx < 2 * 16 * DM; idx += G * NTHREADS) { const int k = idx & (DM - 1), c = (idx >> 11) & 15, j = idx >> 15;
        ((bf16*)(A.ws + WS_WGT))[idx] = (bf16)f2bf(A.ml_w_in[((size_t)j * DM + k) * ML_N + ML_NP + c] * A.norm_mix[(size_t)(2 * j + 1) * DM + k]); }
    bf16* XB = (bf16*)(A.ws + WS_XB); float* SSP = (float*)(A.ws + WS_SSP);
    for (int m = gw; m < MROWS; m += NGW) {
        const GAS f32x4* xr = (const GAS f32x4*)(A.x + (size_t)m * DM) + lane; float s = 0.f;
        GAS v2u* o8 = (GAS v2u*)(XB + (size_t)m * DM) + lane;
#pragma unroll
        for (int j = 0; j < 8; ++j) { const f32x4 v = xr[64 * j]; s += (v.x * v.x + v.y * v.y) + (v.z * v.z + v.w * v.w); v2u w; w.x = pk2(v.x, v.y); w.y = pk2(v.z, v.w); o8[64 * j] = w; }
        s = wave_sum(s);
        if (lane < 32) SSP[(size_t)lane * MROWS + m] = (lane == 0) ? s : 0.f;
    }
    float* ROPE = (float*)(A.ws + WS_ROPE);
    for (int idx = (vcu * NTHREADS + tid); idx < MROWS * 16; idx += G * NTHREADS) {
        const int row = idx >> 4, i = idx & 15; const double rev = (double)A.pos[row] * c_rope_inv[i] * 0.15915494309189535; const float fr = (float)(rev - floor(rev));
        ROPE[2 * idx] = __builtin_amdgcn_cosf(fr); ROPE[2 * idx + 1] = __builtin_amdgcn_sinf(fr);
    }
}

__device__ __forceinline__ void phase_ml_gates(const Ptrs& A, int j, int layer, int G, int vcu, int wave, int lane) {
    typedef short bf16x8 __attribute__((ext_vector_type(8)));
    const bf16* WG = (const bf16*)(A.ws + WS_WGT) + (size_t)j * 16 * DM; const float* gb = A.ml_gate_b + (size_t)j * 16;
    const bf16* XB = (const bf16*)(A.ws + WS_XB); const float* SSP = (const float*)(A.ws + WS_SSP); float* GT = (float*)(A.ws + WS_GATES);
    const int gw = vcu * NWAVES + wave, NGW = G * NWAVES, r16 = lane & 15, kq = lane >> 4;
    for (int r0 = gw * 16; r0 < MROWS; r0 += NGW * 16) {
        f32x4 acc = (f32x4){0.f, 0.f, 0.f, 0.f};
        const bf16* ap = XB + (size_t)(r0 + r16) * DM + 8 * kq; const bf16* bp = WG + (size_t)r16 * DM + 8 * kq;
#pragma unroll 1
        for (int k8 = 0; k8 < 64; k8 += 8) { bf16x8 af[8], bfv[8];
#pragma unroll
            for (int i = 0; i < 8; ++i) { af[i] = *(const bf16x8*)(ap + 32 * (k8 + i)); bfv[i] = *(const bf16x8*)(bp + 32 * (k8 + i)); }
#pragma unroll
            for (int i = 0; i < 8; ++i) acc = __builtin_amdgcn_mfma_f32_16x16x32_bf16(af[i], bfv[i], acc, 0, 0, 0); }
        float ss = 0.f;
        { float sp[8];
#pragma unroll
          for (int p = 0; p < 8; ++p) sp[p] = SSP[(size_t)(8 * kq + p) * MROWS + r0 + r16];
          ss = ((sp[0] + sp[1]) + (sp[2] + sp[3])) + ((sp[4] + sp[5]) + (sp[6] + sp[7])); }
        ss += __shfl_xor(ss, 16); ss += __shfl_xor(ss, 32);
        const float rstd = 1.0f / sqrtf(ss * (1.0f / 2048.0f) + 1e-6f);
        const float bias = gb[r16];
#pragma unroll
        for (int e = 0; e < 4; ++e) { const int row = 4 * kq + e; const float rs = __shfl(rstd, row);
            const float pre = acc[e] * rs + bias; const float z = 15.0f * tanhf_(pre * (1.0f / 15.0f));
            float o;
            if (r16 < 8) o = z; else o = (z > 0.f) ? -__logf(1.0f + __expf(-z)) : (z - __logf(1.0f + __expf(z)));
            GT[(size_t)(r0 + row) * 16 + r16] = o; }
    }
}

__device__ __forceinline__ void rope_pair(v4u a, v4u b, const float* cs, v4u& oa, v4u& ob) {
    const unsigned aw[4] = {a.x, a.y, a.z, a.w}, bw[4] = {b.x, b.y, b.z, b.w}; unsigned ra[4], rb[4];
#pragma unroll
    for (int q = 0; q < 4; ++q) {
        const float x1l = bflo(aw[q]), x1h = bfhi(aw[q]), x2l = bflo(bw[q]), x2h = bfhi(bw[q]);
        const float cl = cs[4 * q], sl = cs[4 * q + 1], ch = cs[4 * q + 2], sh = cs[4 * q + 3];
        ra[q] = pk2(x1l * cl - x2l * sl, x1h * ch - x2h * sh); rb[q] = pk2(x2l * cl + x1l * sl, x2h * ch + x1h * sh); }
    oa = (v4u){ra[0], ra[1], ra[2], ra[3]}; ob = (v4u){rb[0], rb[1], rb[2], rb[3]};
}
__device__ __forceinline__ void phase_rope(const Ptrs& A, int G, int vcu, int tid) {
    bf16* P = (bf16*)(A.ws + WS_P); bf16* QR = (bf16*)(A.ws + WS_QR); const float* ROPE = (const float*)(A.ws + WS_ROPE);
    const int gt = vcu * NTHREADS + tid, NGT = G * NTHREADS;
    for (int idx = gt; idx < MROWS * 16 * 8; idx += NGT) {
        const int pc = idx & 7, h = (idx >> 3) & 15, row = idx >> 7;
        const bf16* src = P + (size_t)row * NSA_NP + PC_Q + h * 128; bf16* dst = QR + (size_t)row * DM + h * 128;
        if (pc < 2) { const v4u a = *(const v4u*)(src + 8 * pc), b = *(const v4u*)(src + 16 + 8 * pc); float cs[16];
#pragma unroll
            for (int e = 0; e < 4; ++e) { const f32x4 t = *(const f32x4*)(ROPE + (size_t)row * 32 + pc * 16 + 4 * e); cs[4 * e] = t.x; cs[4 * e + 1] = t.y; cs[4 * e + 2] = t.z; cs[4 * e + 3] = t.w; }
            v4u oa, ob; rope_pair(a, b, cs, oa, ob); *(v4u*)(dst + 8 * pc) = oa; *(v4u*)(dst + 16 + 8 * pc) = ob; }
        else { const int c0 = 32 + (pc - 2) * 16; *(v4u*)(dst + c0) = *(const v4u*)(src + c0); *(v4u*)(dst + c0 + 8) = *(const v4u*)(src + c0 + 8); }
    }
    for (int idx = gt; idx < MROWS * 8; idx += NGT) {
        const int pc = idx & 1, g = (idx >> 1) & 1, wh = (idx >> 2) & 1, row = idx >> 3;
        bf16* p = P + (size_t)row * NSA_NP + (wh ? PC_KVW : PC_KVS) + g * 128;
        const v4u a = *(const v4u*)(p + 8 * pc), b = *(const v4u*)(p + 16 + 8 * pc); float cs[16];
#pragma unroll
        for (int e = 0; e < 4; ++e) { const f32x4 t = *(const f32x4*)(ROPE + (size_t)row * 32 + pc * 16 + 4 * e); cs[4 * e] = t.x; cs[4 * e + 1] = t.y; cs[4 * e + 2] = t.z; cs[4 * e + 3] = t.w; }
        v4u oa, ob; rope_pair(a, b, cs, oa, ob); *(v4u*)(p + 8 * pc) = oa; *(v4u*)(p + 16 + 8 * pc) = ob;
    }
}

__device__ __forceinline__ void phase_compress(const Ptrs& A, int j_layer, LAS unsigned char* lds, int G, int vcu, int tid) {
    const bf16* P = (const bf16*)(A.ws + WS_P); bf16* KC = (bf16*)(A.ws + WS_KC); bf16* VC = (bf16*)(A.ws + WS_VC);
    const float* pe = A.nsa_pe + (size_t)j_layer * 2 * 32 * 128; const float* w1 = A.nsa_w1 + (size_t)j_layer * 2 * 32 * 128 * 128; const float* w2 = A.nsa_w2 + (size_t)j_layer * 2 * 128 * 128;
    LAS float* blk = (LAS float*)lds; LAS float* part = blk + 4096; LAS float* hid = part + 512;
    for (int item = vcu; item < NB * NCMP * 4; item += G) {
        const int g = item & 1, c = (item >> 1) & 1, bj = item >> 2, j = bj % NCMP, b = bj / NCMP;
        __syncthreads();
        for (int idx = tid; idx < 4096; idx += NTHREADS) { const int l = idx >> 7, d = idx & 127; const int row = b * SEQ + 16 * j + l;
            blk[idx] = bf2f(P[(size_t)row * NSA_NP + PC_KVC + c * 256 + g * 128 + d]) + pe[(c * 32 + l) * 128 + d]; }
        __syncthreads();
        { const int h = tid & 127, pt = tid >> 7; float acc = 0.f;
          for (int l = pt * 8; l < pt * 8 + 8; ++l) { const float* wp = w1 + ((size_t)(c * 32 + l) * 128) * 128 + h; const LAS float* bp = blk + l * 128;
#pragma unroll 8
              for (int d = 0; d < 128; ++d) acc += bp[d] * wp[(size_t)d * 128]; }
          part[pt * 128 + h] = acc; }
        __syncthreads();
        if (tid < 128) { const float v = (part[tid] + part[128 + tid]) + (part[256 + tid] + part[384 + tid]);
            hid[tid] = 0.5f * v * (1.0f + tanhf_(0.7978845608028654f * (v + 0.044715f * v * v * v))); }
        __syncthreads();
        if (tid < 128) { float o = 0.f; const float* wp = w2 + (size_t)c * 128 * 128 + tid;
#pragma unroll 8
            for (int h = 0; h < 128; ++h) o += hid[h] * wp[(size_t)h * 128];
            bf16* dstp = (c == 0 ? KC : VC) + ((size_t)(b * 2 + g) * 128 + j) * 128 + tid; *dstp = (bf16)f2bf(o);
            if (j == NCMP - 1) dstp[128] = 0; }
    }
}

__device__ __forceinline__ void key_dots(const bf16* krow, const LAS float* q, float (&acc)[8]) {
#pragma unroll
    for (int r = 0; r < 8; ++r) acc[r] = 0.f;
#pragma unroll 4
    for (int c = 0; c < 16; ++c) { const v4u kv = *(const v4u*)(krow + 8 * c);
        const float k0 = bflo(kv.x), k1 = bfhi(kv.x), k2 = bflo(kv.y), k3 = bfhi(kv.y), k4 = bflo(kv.z), k5 = bfhi(kv.z), k6 = bflo(kv.w), k7 = bfhi(kv.w);
#pragma unroll
        for (int r = 0; r < 8; ++r) { const f32x4 qa = *(const LAS f32x4*)(q + r * 128 + 8 * c), qb = *(const LAS f32x4*)(q + r * 128 + 8 * c + 4);
            acc[r] += (k0 * qa.x + k1 * qa.y) + (k2 * qa.z + k3 * qa.w) + (k4 * qb.x + k5 * qb.y) + (k6 * qb.z + k7 * qb.w); } }
}
__device__ __forceinline__ void softmax512(LAS float* scr, int lane) {
    float v[8]; float m = -3.0e38f;
#pragma unroll
    for (int i = 0; i < 8; ++i) { v[i] = scr[lane + 64 * i]; m = fmaxf(m, v[i]); }
    m = wave_max(m); float s = 0.f;
#pragma unroll
    for (int i = 0; i < 8; ++i) { v[i] = __expf(v[i] - m); s += v[i]; }
    s = 1.0f / wave_sum(s);
#pragma unroll
    for (int i = 0; i < 8; ++i) scr[lane + 64 * i] = v[i] * s;
}
__device__ __forceinline__ void phase_nsa_attn(const Ptrs& A, int j_layer, LAS unsigned char* lds, int G, int vcu, int wave, int lane, int tid) {
    const bf16* P = (const bf16*)(A.ws + WS_P); const bf16* QR = (const bf16*)(A.ws + WS_QR); const float* KC = (const float*)(A.ws + WS_KC); const float* VC = (const float*)(A.ws + WS_VC);
    bf16* O = (bf16*)(A.ws + WS_O); const float* gb = A.nsa_gate_b + (size_t)j_layer * 48;
    LAS float* qs = (LAS float*)lds; LAS float* qrs = qs + 1024; LAS float* sc = qrs + 1024; LAS float* pc = sc + 4096; LAS float* imp = pc + 1024; LAS int* sel = (LAS int*)(imp + 32);
    for (int item = vcu; item < NB * 2 * SEQ; item += G) {
        const int b = item >> 12, g = (item >> 11) & 1, s = item & 2047, row = b * SEQ + s, r = wave;
        __syncthreads();
        for (int idx = tid; idx < 1024; idx += NTHREADS) { qs[idx] = bf2f(P[(size_t)row * NSA_NP + PC_Q + g * 1024 + idx]); qrs[idx] = bf2f(QR[(size_t)row * DM + g * 1024 + idx]); }
        __syncthreads();
        const int nvis = (s < 31) ? 0 : (((s - 31) >> 4) + 1 > NCMP ? NCMP : ((s - 31) >> 4) + 1);
        const float* kcb = KC + (size_t)(b * 2 + g) * 128 * 128; const float* vcb = VC + (size_t)(b * 2 + g) * 128 * 128;
        { float v[2];
#pragma unroll
          for (int jr = 0; jr < 2; ++jr) { const int j = lane + 64 * jr; float d = 0.f;
              if (j < nvis) { const float* kp = kcb + (size_t)j * 128;
#pragma unroll 8
                  for (int e = 0; e < 128; e += 4) { const f32x4 kk = *(const f32x4*)(kp + e); const f32x4 qq = *(const LAS f32x4*)(qs + r * 128 + e); d += (kk.x * qq.x + kk.y * qq.y) + (kk.z * qq.z + kk.w * qq.w); }
                  v[jr] = d * ATT_SCALE; } else v[jr] = -1e30f; }
          const float m = wave_max(fmaxf(v[0], v[1]));
          const float e0 = (lane < nvis) ? __expf(v[0] - m) : 0.f, e1 = (lane + 64 < nvis) ? __expf(v[1] - m) : 0.f;
          const float ssum = wave_sum(e0 + e1); const float inv = (nvis > 0) ? 1.0f / ssum : 0.f;
          pc[r * 128 + lane] = e0 * inv; pc[r * 128 + 64 + lane] = e1 * inv; }
        __syncthreads();
        float oc0 = 0.f, oc1 = 0.f;
        for (int j = 0; j < nvis; ++j) { const float p = pc[r * 128 + j]; const f32x2 vv = *(const f32x2*)(vcb + (size_t)j * 128 + 2 * lane); oc0 += p * vv.x; oc1 += p * vv.y; }
        if (tid < 32) { const int n = tid; float a = 0.f;
            for (int rr = 0; rr < 8; ++rr) { const LAS float* pp = pc + rr * 128 + 4 * n; a += pp[0] + pp[1] + pp[2] + 0.5f * pp[3] + ((n > 0) ? 0.5f * pp[-1] : 0.f); }
            imp[n] = a; }
        __syncthreads();
        const int qb = s >> 6;
        if (wave == 0) {
            if (qb < 8) { if (lane < 8) sel[lane] = lane; if (lane == 8) sel[8] = qb + 1; }
            else { float scv = (lane >= 1 && lane < qb) ? imp[lane & 31] : -3.0e38f;
                if (lane == 0) { sel[0] = 0; sel[1] = qb; sel[8] = 8; }
                for (int t = 0; t < 6; ++t) { const float best = wave_max(scv); const unsigned long long bal = __ballot(scv == best); const int idx = __ffsll((long long)bal) - 1;
                    if (lane == idx) { sel[2 + t] = idx; scv = -3.0e38f; } } }
        }
        __syncthreads();
        const int nsel = sel[8];
        { const int kb = tid >> 6; float acc[8]; bool valid = false;
          if (kb < nsel) { const int kpos = sel[kb] * 64 + (tid & 63); valid = (kpos <= s);
              if (valid) key_dots(P + (size_t)(b * SEQ + kpos) * NSA_NP + PC_KVS + g * 128, qrs, acc); }
#pragma unroll
          for (int rr = 0; rr < 8; ++rr) sc[rr * 512 + tid] = valid ? acc[rr] * ATT_SCALE : -1e30f; }
        __syncthreads();
        softmax512(sc + r * 512, lane);
        float os0 = 0.f, os1 = 0.f;
        for (int k = 0; k < nsel * 64; ++k) { const float p = sc[r * 512 + k]; const int kpos = sel[k >> 6] * 64 + (k & 63);
            const unsigned vv = *(const unsigned*)(P + (size_t)(b * SEQ + kpos) * NSA_NP + PC_KVS + 256 + g * 128 + 2 * lane); os0 += p * bflo(vv); os1 += p * bfhi(vv); }
        __syncthreads();
        const int nk = (s + 1 < 512) ? s + 1 : 512;
        { float acc[8]; const bool valid = tid < nk;
          if (valid) key_dots(P + (size_t)(row - tid) * NSA_NP + PC_KVW + g * 128, qrs, acc);
#pragma unroll
          for (int rr = 0; rr < 8; ++rr) sc[rr * 512 + tid] = valid ? acc[rr] * ATT_SCALE : -1e30f; }
        __syncthreads();
        softmax512(sc + r * 512, lane);
        float ow0 = 0.f, ow1 = 0.f;
        for (int k = 0; k < nk; ++k) { const float p = sc[r * 512 + k];
            const unsigned vv = *(const unsigned*)(P + (size_t)(row - k) * NSA_NP + PC_KVW + 256 + g * 128 + 2 * lane); ow0 += p * bflo(vv); ow1 += p * bfhi(vv); }
        const int h = g * 8 + r; const bf16* gp = P + (size_t)row * NSA_NP + PC_GATE + h;
        const float g0 = sigmoidf_(bf2f(gp[0]) + gb[h]), g1 = sigmoidf_(bf2f(gp[16]) + gb[16 + h]), g2 = sigmoidf_(bf2f(gp[32]) + gb[32 + h]);
        *(unsigned*)(O + (size_t)row * DM + h * 128 + 2 * lane) = pk2(g0 * oc0 + g1 * os0 + g2 * ow0, g0 * oc1 + g1 * os1 + g2 * ow1);
    }
}

__device__ __forceinline__ void phase_ml_rec(const Ptrs& A, LAS unsigned char* lds, int G, int vcu, int wave, int lane, int tid) {
    const bf16* P = (const bf16*)(A.ws + WS_P); const float* GT = (const float*)(A.ws + WS_GATES); float* HRAW = (float*)(A.ws + WS_HRAW); float* HSS = (float*)(A.ws + WS_HSS);
    LAS float* qf = (LAS float*)lds; LAS float* kf = qf + 64 * 129; LAS float* vf = kf + 64 * 129; LAS float* Cs = vf + 64 * 32; LAS float* Sq = Cs + 128 * 32;
    LAS float* Fs = Sq + 64 * 65; LAS float* lis = Fs + 64; LAS float* ws_ = lis + 64; LAS float* mts = ws_ + 64; LAS float* gis = mts + 64; LAS float* dns = gis + 64; LAS float* qns = dns + 64; LAS float* nv = qns + 64; LAS float* scal = nv + 128;
    for (int unit = vcu; unit < 256; unit += G) {
        const int b = unit >> 6, h = (unit >> 3) & 7, sl = unit & 7;
        float Creg[8];
#pragma unroll
        for (int v = 0; v < 8; ++v) Creg[v] = 0.f;
        float nreg = 0.f, mrun = 0.f;
        const int kC = tid >> 2, vg = tid & 3;
        __syncthreads();
        for (int idx = tid; idx < 128 * 32; idx += NTHREADS) Cs[idx] = 0.f;
        if (tid < 128) nv[tid] = 0.f;
        for (int c = 0; c < 32; ++c) {
            const int t0 = b * SEQ + c * 64;
            __syncthreads();
            for (int idx = tid; idx < 64 * 128; idx += NTHREADS) { const int l = idx >> 7, d = idx & 127; const bf16* pr = P + (size_t)(t0 + l) * ML_NP;
                qf[l * 129 + d] = bf2f(pr[MC_Q + h * 128 + d]) * ATT_SCALE; kf[l * 129 + d] = bf2f(pr[MC_K + h * 128 + d]); }
            for (int idx = tid; idx < 64 * 32; idx += NTHREADS) { const int l = idx >> 5, v = idx & 31; vf[idx] = bf2f(P[(size_t)(t0 + l) * ML_NP + MC_V + h * 256 + sl * 32 + v]); }
            if (wave == 0) {
                const float li = GT[(size_t)(t0 + lane) * 16 + h], lf = GT[(size_t)(t0 + lane) * 16 + 8 + h];
                float F = lf;
#pragma unroll
                for (int o = 1; o < 64; o <<= 1) { const float t = __shfl_up(F, o); if (lane >= o) F += t; }
                const float Fend = __shfl(F, 63);
                const float a = Fend - F + li; const float amax = wave_max(a);
                float dm = li - F;
#pragma unroll
                for (int o = 1; o < 64; o <<= 1) { const float t = __shfl_up(dm, o); if (lane >= o) dm = fmaxf(dm, t); }
                const float inter = F + mrun, mt = fmaxf(inter, F + dm);
                Fs[lane] = F; lis[lane] = li; ws_[lane] = __expf(a - amax); mts[lane] = mt; gis[lane] = __expf(inter - mt);
                if (lane == 0) { scal[0] = Fend; scal[1] = amax; }
            }
            __syncthreads();
            const float Fend = scal[0], amax = scal[1];
            { const int l = tid >> 3, s0 = (tid & 7) * 8; const float Fl = Fs[l], mtl = mts[l];
#pragma unroll
              for (int e = 0; e < 8; ++e) { const int s = s0 + e; float val = 0.f;
                  if (s <= l) { float d = 0.f;
#pragma unroll 8
                      for (int k = 0; k < 128; ++k) d += qf[l * 129 + k] * kf[s * 129 + k];
                      val = d * __expf(Fl - Fs[s] + lis[s] - mtl); }
                  Sq[l * 65 + s] = val; }
              if ((tid & 7) == 0) { float d = 0.f;
#pragma unroll 8
                  for (int k = 0; k < 128; ++k) d += qf[l * 129 + k] * nv[k];
                  qns[l] = d; } }
            __syncthreads();
            if (tid < 64) { float rs = 0.f;
#pragma unroll 8
                for (int s = 0; s < 64; ++s) rs += Sq[tid * 65 + s];
                const float den = rs + gis[tid] * qns[tid]; dns[tid] = fmaxf(fabsf(den), __expf(-mts[tid])); }
            f32x4 num = (f32x4){0.f, 0.f, 0.f, 0.f};
            { const int l = tid >> 3, v4 = (tid & 7) * 4; f32x4 inter4 = (f32x4){0.f, 0.f, 0.f, 0.f};
              for (int s = 0; s <= l; ++s) num += Sq[l * 65 + s] * *(const LAS f32x4*)(vf + s * 32 + v4);
#pragma unroll 8
              for (int k = 0; k < 128; ++k) inter4 += qf[l * 129 + k] * *(const LAS f32x4*)(Cs + k * 32 + v4);
              num += gis[l] * inter4; }
            __syncthreads();
            { const int l = tid >> 3, v4 = (tid & 7) * 4; const float inv = 1.0f / dns[l]; const f32x4 hv = num * inv;
              *(f32x4*)(HRAW + (size_t)(t0 + l) * DM + h * 256 + sl * 32 + v4) = hv;
              float ss = (hv.x * hv.x + hv.y * hv.y) + (hv.z * hv.z + hv.w * hv.w);
              ss += __shfl_xor(ss, 1); ss += __shfl_xor(ss, 2); ss += __shfl_xor(ss, 4);
              if ((tid & 7) == 0) HSS[((size_t)(t0 + l) * 8 + h) * 8 + sl] = ss; }
            const float mnew = fmaxf(Fend + mrun, amax), decay = __expf(Fend + mrun - mnew), inject = __expf(amax - mnew);
            { float dC[8];
#pragma unroll
              for (int v = 0; v < 8; ++v) dC[v] = 0.f;
              float dn = 0.f;
              for (int l = 0; l < 64; ++l) { const float wk = ws_[l] * kf[l * 129 + kC]; dn += wk; const f32x4 va = *(const LAS f32x4*)(vf + l * 32 + vg * 8), vb = *(const LAS f32x4*)(vf + l * 32 + vg * 8 + 4);
                  dC[0] += wk * va.x; dC[1] += wk * va.y; dC[2] += wk * va.z; dC[3] += wk * va.w; dC[4] += wk * vb.x; dC[5] += wk * vb.y; dC[6] += wk * vb.z; dC[7] += wk * vb.w; }
#pragma unroll
              for (int v = 0; v < 8; ++v) { Creg[v] = decay * Creg[v] + inject * dC[v]; Cs[kC * 32 + vg * 8 + v] = Creg[v]; }
              nreg = decay * nreg + inject * dn; if (vg == 0) nv[kC] = nreg; }
            mrun = mnew;
        }
    }
}

__device__ __forceinline__ void phase_ml_norm(const Ptrs& A, int j_layer, int G, int vcu, int tid) {
    const bf16* P = (const bf16*)(A.ws + WS_P); const bf16* HRAW = (const bf16*)(A.ws + WS_HRAW); bf16* O = (bf16*)(A.ws + WS_O);
    const float* hn = A.ml_head_norm + (size_t)j_layer * DM;
    const int t0 = vcu * NTHREADS + tid, c8 = t0 & 255, col = c8 * 8, rstep = (G * NTHREADS) >> 8;
    const f32x4 ga = *(const f32x4*)(hn + col), gb2 = *(const f32x4*)(hn + col + 4);
    for (int r0 = t0 >> 8; r0 < MROWS; r0 += 4 * rstep) {
        v4u hrv[4], ogv[4];
#pragma unroll
        for (int u = 0; u < 4; ++u) { const int row = r0 + u * rstep; const bool ok = row < MROWS; const int rr = ok ? row : r0;
            hrv[u] = *(const v4u*)(HRAW + (size_t)rr * DM + col); ogv[u] = *(const v4u*)(P + (size_t)rr * ML_NP + MC_OG + col); }
#pragma unroll
        for (int u = 0; u < 4; ++u) { const int row = r0 + u * rstep; const v4u hr = hrv[u], og = ogv[u];
            const f32x4 a = (f32x4){bflo(hr.x), bfhi(hr.x), bflo(hr.y), bfhi(hr.y)}, b2 = (f32x4){bflo(hr.z), bfhi(hr.z), bflo(hr.w), bfhi(hr.w)};
            float ss = ((a.x * a.x + a.y * a.y) + (a.z * a.z + a.w * a.w)) + ((b2.x * b2.x + b2.y * b2.y) + (b2.z * b2.z + b2.w * b2.w));
#pragma unroll
            for (int o = 1; o < 32; o <<= 1) ss += __shfl_xor(ss, o);
            const float rstd = 1.0f / sqrtf(ss * (1.0f / 256.0f) + 1e-6f);
            v4u o;
            o.x = pk2(a.x * rstd * ga.x * sigmoidf_(bflo(og.x)), a.y * rstd * ga.y * sigmoidf_(bfhi(og.x)));
            o.y = pk2(a.z * rstd * ga.z * sigmoidf_(bflo(og.y)), a.w * rstd * ga.w * sigmoidf_(bfhi(og.y)));
            o.z = pk2(b2.x * rstd * gb2.x * sigmoidf_(bflo(og.z)), b2.y * rstd * gb2.y * sigmoidf_(bfhi(og.z)));
            o.w = pk2(b2.z * rstd * gb2.z * sigmoidf_(bflo(og.w)), b2.w * rstd * gb2.w * sigmoidf_(bfhi(og.w)));
            if (row < MROWS) *(v4u*)(O + (size_t)row * DM + col) = o; }
    }
}

__device__ __forceinline__ void phase_fixup(const Ptrs& A, int layer, int G, int vcu, int tid) {
    const float* US = (const float*)(A.ws + WS_U); bf16* ACT = (bf16*)(A.ws + WS_ACT);
    const float* cw = A.conv_w + (size_t)layer * 3 * NUP; const float* cb = A.conv_b + (size_t)layer * NUP;
    for (int idx = vcu * NTHREADS + tid; idx < 128 * 2 * (DFF / 8); idx += G * NTHREADS) {
        const int c8 = idx % (DFF / 8), rr = (idx / (DFF / 8)) & 1, ch = idx / (2 * (DFF / 8)), cg = c8 * 8; const bool bs = (ch & 31) == 0;
        const int chp = bs ? ch : ch - 1;
        const float* u2p = US + ((size_t)ch * 4 + 2 + rr) * NUP + cg;
        const float* u1p = rr ? US + ((size_t)ch * 4 + 2) * NUP + cg : US + ((size_t)chp * 4 + 1) * NUP + cg; const bool z1 = (rr == 0) && bs;
        const float* u0p = rr ? US + ((size_t)chp * 4 + 1) * NUP + cg : US + ((size_t)chp * 4 + 0) * NUP + cg; const bool z0 = bs;
        f32x4 g2[2], v2[2], g1[2], v1[2], g0[2], v0[2], bg[2], bv[2], wg[3][2], wv[3][2];
#pragma unroll
        for (int q = 0; q < 2; ++q) { g2[q] = *(const f32x4*)(u2p + 4 * q); v2[q] = *(const f32x4*)(u2p + DFF + 4 * q); g1[q] = *(const f32x4*)(u1p + 4 * q); v1[q] = *(const f32x4*)(u1p + DFF + 4 * q);
            g0[q] = *(const f32x4*)(u0p + 4 * q); v0[q] = *(const f32x4*)(u0p + DFF + 4 * q); bg[q] = *(const f32x4*)(cb + cg + 4 * q); bv[q] = *(const f32x4*)(cb + DFF + cg + 4 * q);
#pragma unroll
            for (int t = 0; t < 3; ++t) { wg[t][q] = *(const f32x4*)(cw + (size_t)t * NUP + cg + 4 * q); wv[t][q] = *(const f32x4*)(cw + (size_t)t * NUP + DFF + cg + 4 * q); } }
        unsigned ow[4];
#pragma unroll
        for (int q = 0; q < 2; ++q) {
            const f32x4 zero = (f32x4){0.f, 0.f, 0.f, 0.f};
            const f32x4 a1 = z1 ? zero : g1[q], b1 = z1 ? zero : v1[q], a0 = z0 ? zero : g0[q], b0 = z0 ? zero : v0[q];
            const f32x4 cgv = bg[q] + wg[0][q] * a0 + wg[1][q] * a1 + wg[2][q] * g2[q];
            const f32x4 cvv = bv[q] + wv[0][q] * b0 + wv[1][q] * b1 + wv[2][q] * v2[q];
            ow[2 * q] = pk2(cgv.x * sigmoidf_(cgv.x) * cvv.x, cgv.y * sigmoidf_(cgv.y) * cvv.y); ow[2 * q + 1] = pk2(cgv.z * sigmoidf_(cgv.z) * cvv.z, cgv.w * sigmoidf_(cgv.w) * cvv.w); }
        *(v4u*)(ACT + (size_t)(ch * 64 + rr) * DFF + cg) = (v4u){ow[0], ow[1], ow[2], ow[3]};
    }
}

__device__ __forceinline__ void phase_final(const Ptrs& A, int G, int vcu, int wave, int lane) {
    const bf16* XB = (const bf16*)(A.ws + WS_XB); const float* SSP = (const float*)(A.ws + WS_SSP);
    const int gw = vcu * NWAVES + wave, NGW = G * NWAVES;
    const f32x4* gr = (const f32x4*)A.norm_final + 2 * lane; f32x4 gv[8];
#pragma unroll
    for (int j = 0; j < 4; ++j) { gv[2 * j] = gr[128 * j]; gv[2 * j + 1] = gr[128 * j + 1]; }
    for (int m0 = gw; m0 < MROWS; m0 += 2 * NGW) {
        float ssv[2]; v4u xv[2][4];
#pragma unroll
        for (int u = 0; u < 2; ++u) { const int m = (m0 + u * NGW < MROWS) ? m0 + u * NGW : m0; ssv[u] = (lane < 32) ? SSP[(size_t)lane * MROWS + m] : 0.f;
            const v4u* xr = (const v4u*)(XB + (size_t)m * DM) + lane;
#pragma unroll
            for (int j = 0; j < 4; ++j) xv[u][j] = xr[64 * j]; }
#pragma unroll
        for (int u = 0; u < 2; ++u) { const int m = m0 + u * NGW; const float rstd = 1.0f / sqrtf(wave_sum(ssv[u]) * (1.0f / 2048.0f) + 1e-6f);
            if (m < MROWS) { f32x4* o = (f32x4*)(A.out + (size_t)m * DM) + 2 * lane;
#pragma unroll
                for (int j = 0; j < 4; ++j) { const v4u x = xv[u][j];
                    o[128 * j] = (f32x4){bflo(x.x), bfhi(x.x), bflo(x.y), bfhi(x.y)} * rstd * gv[2 * j]; o[128 * j + 1] = (f32x4){bflo(x.z), bfhi(x.z), bflo(x.w), bfhi(x.w)} * rstd * gv[2 * j + 1]; } } }
    }
}
namespace na {
typedef short bf16x8 __attribute__((ext_vector_type(8)));
typedef short s16x4 __attribute__((ext_vector_type(4)));
typedef float f32x16 __attribute__((ext_vector_type(16)));
typedef unsigned u32x4 __attribute__((ext_vector_type(4)));
constexpr int KVBLK = 64, SHM_K = 16384, SHM_V = 16384;
constexpr float THR = 8.f, SCALE = 0.08838834764831845f;
#define KSWZ(row, colB) ((row) * 256 + ((colB) ^ (((row) & 7) << 4)))
#define SBAR() __builtin_amdgcn_sched_barrier(0)
__device__ __forceinline__ int v_st(int k, int c) { const int kk = (k & ~0xC) | ((k & 4) << 1) | ((k & 8) >> 1); return ((kk >> 3) * 4 + (c >> 5)) * 512 + ((kk & 7) * 32 + (c & 31)) * 2; }
__device__ __forceinline__ int v_rd_base(int lane) { return ((lane & 3) << 3) | (((lane >> 2) & 3) << 6) | (((lane >> 4) & 1) << 5) | (((lane >> 5) & 1) << 8); }
constexpr int v_rd_off(int d0, int ks, int half) { return d0 * 512 + ks * 4096 + half * 2048; }
__device__ __forceinline__ int crow(int r, int hi) { return (r & 3) + 8 * (r >> 2) + 4 * hi; }
__device__ __forceinline__ unsigned cvtpk(float lo, float hi) { unsigned r; asm volatile("v_cvt_pk_bf16_f32 %0, %1, %2" : "=v"(r) : "v"(lo), "v"(hi)); return r; }
__device__ __forceinline__ void mask_tile(f32x16& p0, f32x16& p1, int dq, unsigned W) {
    const float NEG = -__builtin_inff();
#pragma unroll
    for (int r = 0; r < 16; ++r) { const int c = (r & 3) + 8 * (r >> 2);
        if ((unsigned)(dq - c) >= W) p0[r] = NEG;
        if ((unsigned)(dq - c - 32) >= W) p1[r] = NEG; }
}
__device__ __forceinline__ void partialSM(f32x16& p0, f32x16& p1, float& m_reg, float& mn, float& alpha) {
    float pmax = p0[0];
#pragma unroll
    for (int r = 1; r < 16; ++r) pmax = fmaxf(pmax, p0[r]);
#pragma unroll
    for (int r = 0; r < 16; ++r) pmax = fmaxf(pmax, p1[r]);
    { auto rr = __builtin_amdgcn_permlane32_swap(__float_as_uint(pmax), __float_as_uint(pmax), false, false);
      pmax = fmaxf(__uint_as_float(rr[0]), __uint_as_float(rr[1])); }
    constexpr float C2 = 1.4426950408889634f * SCALE;
    if (__builtin_expect(__all((pmax - m_reg) * SCALE <= THR), 1)) { mn = m_reg; alpha = 1.f; }
    else { mn = fmaxf(m_reg, pmax); alpha = __builtin_amdgcn_exp2f((m_reg - mn) * C2); m_reg = mn; }
    const float mnL = -mn * C2;
#pragma unroll
    for (int r = 0; r < 16; ++r) p0[r] = fmaf(p0[r], C2, mnL);
#pragma unroll
    for (int r = 0; r < 16; ++r) p1[r] = fmaf(p1[r], C2, mnL);
#pragma unroll
    for (int r = 0; r < 16; ++r) p0[r] = __builtin_amdgcn_exp2f(p0[r]);
}
#define NA_PK4(P, B_, OUT) do { unsigned a0 = cvtpk(P[B_+0], P[B_+1]), a1 = cvtpk(P[B_+2], P[B_+3]);                          \
        unsigned b0 = cvtpk(P[B_+4], P[B_+5]), b1 = cvtpk(P[B_+6], P[B_+7]);                                             \
        auto r0 = __builtin_amdgcn_permlane32_swap(a0, b0, false, false); auto r1 = __builtin_amdgcn_permlane32_swap(a1, b1, false, false); \
        u32x4 w = {r0[0], r1[0], r0[1], r1[1]}; OUT = *reinterpret_cast<bf16x8*>(&w); } while (0)
__device__ __forceinline__ void pack_p(const f32x16& p0, const f32x16& p1, bf16x8& pa0, bf16x8& pa1, bf16x8& pa2, bf16x8& pa3) {
    NA_PK4(p0, 0, pa0); NA_PK4(p0, 8, pa1); NA_PK4(p1, 0, pa2); NA_PK4(p1, 8, pa3);
}
__device__ __forceinline__ void finishSM(f32x16& p0, f32x16& p1, float alpha, float& l_reg, bf16x8& pa0, bf16x8& pa1, bf16x8& pa2, bf16x8& pa3) {
#pragma unroll
    for (int r = 0; r < 16; ++r) p1[r] = __builtin_amdgcn_exp2f(p1[r]);
    float ps = 0;
#pragma unroll
    for (int r = 0; r < 16; ++r) ps += p0[r];
#pragma unroll
    for (int r = 0; r < 16; ++r) ps += p1[r];
    { auto rr = __builtin_amdgcn_permlane32_swap(__float_as_uint(ps), __float_as_uint(ps), false, false);
      ps = __uint_as_float(rr[0]) + __uint_as_float(rr[1]); }
    l_reg = l_reg * alpha + ps;
    pack_p(p0, p1, pa0, pa1, pa2, pa3);
}
template <int KOFF>
__device__ __forceinline__ void qkt(f32x16& p0, f32x16& p1, const LAS char* K_lds, int r32, int hi, const bf16x8* qr) {
    p0 = f32x16{}; p1 = f32x16{};
    const LAS char* kb[4];
#pragma unroll
    for (int dd = 0; dd < 4; ++dd) kb[dd] = K_lds + KOFF + KSWZ(r32, (dd * 16 + hi * 8) * 2);
#define NA_KLD(d0, t) (*reinterpret_cast<const LAS bf16x8*>(kb[(d0) & 3] + ((d0) >> 2) * 128 + (t) * 32 * 256))
    bf16x8 f[2][4];
    f[0][0] = NA_KLD(0, 0); f[0][1] = NA_KLD(0, 1); f[0][2] = NA_KLD(1, 0); f[0][3] = NA_KLD(1, 1);
#pragma unroll
    for (int g = 0; g < 4; ++g) { SBAR();
        if (g + 1 < 4) { f[(g + 1) & 1][0] = NA_KLD(2 * g + 2, 0); f[(g + 1) & 1][1] = NA_KLD(2 * g + 2, 1); f[(g + 1) & 1][2] = NA_KLD(2 * g + 3, 0); f[(g + 1) & 1][3] = NA_KLD(2 * g + 3, 1); }
        p0 = __builtin_amdgcn_mfma_f32_32x32x16_bf16(f[g & 1][0], qr[2 * g], p0, 0, 0, 0);
        p1 = __builtin_amdgcn_mfma_f32_32x32x16_bf16(f[g & 1][1], qr[2 * g], p1, 0, 0, 0);
        p0 = __builtin_amdgcn_mfma_f32_32x32x16_bf16(f[g & 1][2], qr[2 * g + 1], p0, 0, 0, 0);
        p1 = __builtin_amdgcn_mfma_f32_32x32x16_bf16(f[g & 1][3], qr[2 * g + 1], p1, 0, 0, 0); }
#undef NA_KLD
}
template <int VOFF>
__device__ __forceinline__ void pv_tile(f32x16* o, int vb0, bf16x8 pa0, bf16x8 pa1, bf16x8 pa2, bf16x8 pa3) {
#define NA_TRRD(dst, off) asm volatile("ds_read_b64_tr_b16 %0, %1 offset:%2" : "=&v"(dst) : "v"(vb0), "i"(off) : "memory")
#define NA_PV_D0(d0) do { s16x4 l0, l1, l2, l3, h0, h1, h2, h3; constexpr int b_ = VOFF + v_rd_off(d0, 0, 0); \
        NA_TRRD(l0, b_); NA_TRRD(h0, b_ + 2048); NA_TRRD(l1, b_ + 4096); NA_TRRD(h1, b_ + 6144); NA_TRRD(l2, b_ + 8192); NA_TRRD(h2, b_ + 10240); NA_TRRD(l3, b_ + 12288); NA_TRRD(h3, b_ + 14336); \
        asm volatile("s_waitcnt lgkmcnt(0)" ::: "memory"); SBAR();   \
        o[d0] = __builtin_amdgcn_mfma_f32_32x32x16_bf16(pa0, (bf16x8){l0[0], l0[1], l0[2], l0[3], h0[0], h0[1], h0[2], h0[3]}, o[d0], 0, 0, 0);   \
        o[d0] = __builtin_amdgcn_mfma_f32_32x32x16_bf16(pa1, (bf16x8){l1[0], l1[1], l1[2], l1[3], h1[0], h1[1], h1[2], h1[3]}, o[d0], 0, 0, 0);   \
        o[d0] = __builtin_amdgcn_mfma_f32_32x32x16_bf16(pa2, (bf16x8){l2[0], l2[1], l2[2], l2[3], h2[0], h2[1], h2[2], h2[3]}, o[d0], 0, 0, 0);   \
        o[d0] = __builtin_amdgcn_mfma_f32_32x32x16_bf16(pa3, (bf16x8){l3[0], l3[1], l3[2], l3[3], h3[0], h3[1], h3[2], h3[3]}, o[d0], 0, 0, 0); } while (0)
    NA_PV_D0(0); NA_PV_D0(1); NA_PV_D0(2); NA_PV_D0(3);
#undef NA_PV_D0
#undef NA_TRRD
}
constexpr int VOFF0 = 0, VOFF1 = 16384, VOFF2 = 32768, KOFF0 = 49152, KOFF1 = 65536, KOFF2 = 81920, IMPW_OFF = 98304, IMPW_P = 33  , WSC_OFF = IMPW_OFF + 8 * 32 * IMPW_P * 4, SELB_OFF = WSC_OFF + 2048;
struct Ctx {
    LAS char* lds; LAS float* li_l; LAS float* al_l; int vb0, r32, hi, wave;
    int krow[2], kcolb[2], vkey[2], vcol[2];
};
__device__ __forceinline__ void dma_coords(Ctx& C, int lane) {
#pragma unroll
    for (int i = 0; i < 2; ++i) { const int L = (C.wave * 2 + i) * 1024 + lane * 16;
        const int row = L >> 8; C.krow[i] = row; C.kcolb[i] = (L & 255) ^ ((row & 7) << 4);
        const int st = L >> 9, within = L & 511, kk = (st >> 2) * 8 + (within >> 6); C.vkey[i] = (kk & ~0xC) | ((kk & 4) << 1) | ((kk & 8) >> 1); C.vcol[i] = (st & 3) * 32 + ((within & 63) >> 1); }
}
#define NA_VMWAIT(n) asm volatile("s_waitcnt vmcnt(" #n ")" ::: "memory")
#define NA_BAR() do { asm volatile("s_waitcnt lgkmcnt(0)" ::: "memory"); __builtin_amdgcn_s_barrier(); asm volatile("" ::: "memory"); } while (0)
#define NA_DMA(Kp, Vp, ld, k0, koff, voff) do { const bf16* kp_ = (Kp) + (size_t)(k0) * (ld); const bf16* vp_ = (Vp) + (size_t)(k0) * (ld); _Pragma("unroll") for (int i_ = 0; i_ < 2; ++i_) { \
        unsigned ok_ = (unsigned)(C.krow[i_] * (ld) + (C.kcolb[i_] >> 1)), ov_ = (unsigned)(C.vkey[i_] * (ld) + C.vcol[i_]); asm volatile("" : "+v"(ok_), "+v"(ov_));     \
        __builtin_amdgcn_global_load_lds((const unsigned*)(kp_ + ok_), (LAS unsigned*)(C.lds + (koff) + (C.wave * 2 + i_) * 1024), 16, 0, 0); \
        __builtin_amdgcn_global_load_lds((const unsigned*)(vp_ + ov_), (LAS unsigned*)(C.lds + (voff) + (C.wave * 2 + i_) * 1024), 16, 0, 0); } } while (0)
#define NA_RESC(a) do { if (__any((a) < 1.f)) { if (C.hi == 0) C.al_l[C.r32] = (a); asm volatile("s_waitcnt lgkmcnt(0)" ::: "memory");              \
                     _Pragma("unroll") for (int d_ = 0; d_ < 4; ++d_) _Pragma("unroll") for (int r = 0; r < 16; ++r) o[d_][r] *= C.al_l[crow(r, C.hi)]; } } while (0)
template <int MODE, bool PRE = false>
__device__ __forceinline__ void tile_loop(f32x16 (&o)[4], float& l_reg, const bf16x8 (&qr)[8], const bf16* Kg, const bf16* Vg, int ld, int NT, int j_lo, const LAS int* TL, unsigned myb, int qb, int pos, int t0, const Ctx& C) {
    float m_reg = -1e30f; l_reg = 0.f;
#pragma unroll
    for (int d = 0; d < 4; ++d) o[d] = f32x16{};
#define NA_KBASE(t) ((MODE == 0 ? TL[t] : (j_lo + (t))) * KVBLK)
    if (!PRE) {
    NA_VMWAIT(0);
    { const int kb = NA_KBASE(0); NA_DMA(Kg, Vg, ld, kb, KOFF0, VOFF0); }
    if (NT > 1) { const int kb = NA_KBASE(1); NA_DMA(Kg, Vg, ld, kb, KOFF1, VOFF1); } }
#define NA_STEP(t, KO, VO, KO2, VO2) do { const int kb = NA_KBASE(t);                                                                              \
        if ((t) + 1 < NT) NA_VMWAIT(4); else NA_VMWAIT(0);                       \
        NA_BAR();                                                              \
        if ((t) + 2 < NT) { const int kn = NA_KBASE((t) + 2); NA_DMA(Kg, Vg, ld, kn, KO2, VO2); }                                                  \
        f32x16 p0, p1; float mn, alpha; bf16x8 pa0, pa1, pa2, pa3;                                                                                 \
        SBAR(); qkt<KO>(p0, p1, C.lds, C.r32, C.hi, qr);                                                                                           \
        if (MODE == 0) { const int n = kb >> 6; const bool ok = (myb >> n) & 1u;                                                                   \
            if (n == qb) mask_tile(p0, p1, pos - kb - 4 * C.hi, 0x7fffffffu);                                                                      \
            if (!__all(ok)) { const float NEG = -__builtin_inff(); _Pragma("unroll") for (int r = 0; r < 16; ++r) { p0[r] = ok ? p0[r] : NEG; p1[r] = ok ? p1[r] : NEG; } } } \
        else { if (kb + KVBLK - 1 > t0 || kb <= t0 + 31 - 512) mask_tile(p0, p1, pos - kb - 4 * C.hi, 512u); }                                     \
        partialSM(p0, p1, m_reg, mn, alpha); NA_RESC(alpha); finishSM(p0, p1, alpha, l_reg, pa0, pa1, pa2, pa3); SBAR();                           \
        pv_tile<VO>(o, C.vb0, pa0, pa1, pa2, pa3); } while (0)
    for (int t = 0; t < NT; t += 3) { NA_STEP(t, KOFF0, VOFF0, KOFF2, VOFF2); if (t + 1 < NT) NA_STEP(t + 1, KOFF1, VOFF1, KOFF0, VOFF0); if (t + 2 < NT) NA_STEP(t + 2, KOFF2, VOFF2, KOFF1, VOFF1); }
    NA_BAR();
#undef NA_STEP
#undef NA_KBASE
}
}

__device__ __forceinline__ void phase_nsa_attn2(const Ptrs& A, int j_layer, LAS unsigned char* lds, int G, int vcu, int wave, int lane, int tid) {
    using namespace na;
    const bf16* P = (const bf16*)(A.ws + WS_P); const float* ROPE = (const float*)(A.ws + WS_ROPE); const bf16* KCb = (const bf16*)(A.ws + WS_KC); const bf16* VCb = (const bf16*)(A.ws + WS_VC);
    bf16* O = (bf16*)(A.ws + WS_O); const float* gb = A.nsa_gate_b + (size_t)j_layer * 48;
    Ctx C; C.lds = (LAS char*)lds; C.li_l = (LAS float*)(lds + WSC_OFF) + wave * 64; C.al_l = C.li_l + 32; C.wave = wave;
    LAS float* IMPW = (LAS float*)(lds + IMPW_OFF);
    LAS unsigned* SELB = (LAS unsigned*)(lds + SELB_OFF);
    LAS int* TL = (LAS int*)(SELB + 32);
    C.r32 = lane & 31; C.hi = lane >> 5; dma_coords(C, lane);
    C.vb0 = (int)(unsigned long long)C.lds + v_rd_base(lane);
    const int r32 = C.r32, hi = C.hi;
    constexpr float C2 = 1.4426950408889634f * SCALE;
    for (int u = vcu; u < 512; u += G) {
        const int w8 = u & 255, rnd = u >> 8, tbase = w8 & 63, tb = rnd ? 63 - tbase : tbase, bg = (w8 >> 6) + 4 * rnd, b = bg >> 1, g = bg & 1;
        const int t0 = tb * 32, qb = t0 >> 6, row0 = b * SEQ + t0, h = g * 8 + wave, pos = t0 + r32;
        const bf16* Prow = P + (size_t)(row0 + r32) * NSA_NP;
        f32x16 o[4]; unsigned otot[4][8];
        bf16x8 qr[8];
        NA_BAR();
        { const bf16* Kc = KCb + (size_t)(b * 2 + g) * 128 * 128; const bf16* Vc = VCb + (size_t)(b * 2 + g) * 128 * 128;
          NA_DMA(Kc, Vc, 128, 0, KOFF0, VOFF0); NA_DMA(Kc, Vc, 128, 64, KOFF1, VOFF1); }
#pragma unroll
        for (int d0 = 0; d0 < 8; ++d0) qr[d0] = *(const bf16x8*)(Prow + PC_Q + h * 128 + d0 * 16 + hi * 8);
        const float gz0 = bf2f(Prow[PC_GATE + h]) + gb[h], gz1 = bf2f(Prow[PC_GATE + 16 + h]) + gb[16 + h], gz2 = bf2f(Prow[PC_GATE + 32 + h]) + gb[32 + h];
        NA_VMWAIT(0); __syncthreads();
        {
            f32x16 pA0, pA1, pB0, pB1;
            qkt<KOFF0>(pA0, pA1, C.lds, r32, hi, qr); qkt<KOFF1>(pB0, pB1, C.lds, r32, hi, qr);
            const int lim = (pos - 31) >> 4;
            mask_tile(pA0, pA1, lim - 4 * hi, 0x7fffffffu); mask_tile(pB0, pB1, lim - 64 - 4 * hi, 0x7fffffffu);
            float mx = -1e30f;
#pragma unroll
            for (int r = 0; r < 16; ++r) mx = fmaxf(fmaxf(mx, fmaxf(pA0[r], pA1[r])), fmaxf(pB0[r], pB1[r]));
            { auto rr = __builtin_amdgcn_permlane32_swap(__float_as_uint(mx), __float_as_uint(mx), false, false); mx = fmaxf(__uint_as_float(rr[0]), __uint_as_float(rr[1])); }
            float ls = 0.f;
#pragma unroll
            for (int r = 0; r < 16; ++r) { pA0[r] = __builtin_amdgcn_exp2f((pA0[r] - mx) * C2); pA1[r] = __builtin_amdgcn_exp2f((pA1[r] - mx) * C2);
                pB0[r] = __builtin_amdgcn_exp2f((pB0[r] - mx) * C2); pB1[r] = __builtin_amdgcn_exp2f((pB1[r] - mx) * C2); ls += (pA0[r] + pA1[r]) + (pB0[r] + pB1[r]); }
            { auto rr = __builtin_amdgcn_permlane32_swap(__float_as_uint(ls), __float_as_uint(ls), false, false); ls = __uint_as_float(rr[0]) + __uint_as_float(rr[1]); }
            const float inv = (ls > 0.f) ? 1.0f / ls : 0.f;
            float recv[4][4], own[4][4];
#pragma unroll
            for (int ti = 0; ti < 4; ++ti)
#pragma unroll
                for (int gq = 0; gq < 4; ++gq) { const f32x16& pt = (ti == 0) ? pA0 : (ti == 1) ? pA1 : (ti == 2) ? pB0 : pB1;
                    const float hh = 0.5f * pt[4 * gq + 3] * inv; own[ti][gq] = (pt[4 * gq] + pt[4 * gq + 1] + pt[4 * gq + 2]) * inv + hh; recv[ti][gq] = __shfl_xor(hh, 32); }
#pragma unroll
            for (int ti = 0; ti < 4; ++ti)
#pragma unroll
                for (int gq = 0; gq < 4; ++gq) { const float pl = (gq > 0) ? recv[ti][gq > 0 ? gq - 1 : 0] : ((ti > 0) ? recv[ti > 0 ? ti - 1 : 0][3] : 0.f);
                    const float prev = hi ? recv[ti][gq] : pl;
                    IMPW[(wave * 32 + r32) * IMPW_P + 8 * ti + 2 * gq + hi] = own[ti][gq] + prev; }
            bf16x8 pa0, pa1, pa2, pa3;
#pragma unroll
            for (int d = 0; d < 4; ++d) o[d] = f32x16{};
            pack_p(pA0, pA1, pa0, pa1, pa2, pa3); SBAR(); pv_tile<VOFF0>(o, C.vb0, pa0, pa1, pa2, pa3);
            pack_p(pB0, pB1, pa0, pa1, pa2, pa3); SBAR(); pv_tile<VOFF1>(o, C.vb0, pa0, pa1, pa2, pa3);
            if (hi == 0) C.li_l[r32] = sigmoidf_(gz0) * inv;
            asm volatile("s_waitcnt lgkmcnt(0)" ::: "memory");
#pragma unroll
            for (int q2 = 0; q2 < 8; ++q2) { const float w0 = C.li_l[crow(2 * q2, hi)], w1 = C.li_l[crow(2 * q2 + 1, hi)];
#pragma unroll
                for (int d = 0; d < 4; ++d) otot[d][q2] = cvtpk(o[d][2 * q2] * w0, o[d][2 * q2 + 1] * w1); }
        }
        __syncthreads();
        const int w_lowk = t0 - 511, w_jlo = w_lowk > 0 ? w_lowk / KVBLK : 0, w_NT = qb + 1 - w_jlo;
        const bf16* KgW = P + (size_t)b * SEQ * NSA_NP + PC_KVW + g * 128;
        { NA_VMWAIT(0); NA_DMA(KgW, KgW + 256, NSA_NP, w_jlo * KVBLK, KOFF0, VOFF0); if (w_NT > 1) NA_DMA(KgW, KgW + 256, NSA_NP, (w_jlo + 1) * KVBLK, KOFF1, VOFF1); }
        if (wave == 0) {
            float imp[32];
#pragma unroll
            for (int n = 0; n < 32; ++n) { float s = 0.f;
#pragma unroll
                for (int w = 0; w < 8; ++w) s += IMPW[(w * 32 + r32) * IMPW_P + n];
                imp[n] = s; }
            unsigned selbits;
            if (qb < 8) selbits = (2u << qb) - 1u;
            else { selbits = 1u | (1u << qb);
                for (int t = 0; t < 6; ++t) { float best = -3.0e38f; int bi = 0;
#pragma unroll
                    for (int n = 1; n < 32; ++n) { const bool c = (n < qb) && !((selbits >> n) & 1u) && (imp[n] > best); best = c ? imp[n] : best; bi = c ? n : bi; }
                    selbits |= 1u << bi; } }
            if (hi == 0) SELB[r32] = selbits;
            unsigned un = selbits;
#pragma unroll
            for (int o_ = 1; o_ < 32; o_ <<= 1) un |= (unsigned)__shfl_xor((int)un, o_);
            if (lane == 0) { int cnt = 0; for (int n = 0; n < 32; ++n) if ((un >> n) & 1u) { TL[cnt] = n; ++cnt; } TL[32] = cnt; }
        }
        __syncthreads();
        { const float* cs = ROPE + (size_t)(row0 + r32) * 32 + hi * 16;
          u32x4 w0, w1; unsigned a0[4], a1[4];
#pragma unroll
          for (int q2 = 0; q2 < 4; ++q2) { const f32x4 t = *(const f32x4*)(cs + 4 * q2);
              const float x1a = bf2f((unsigned short)qr[0][2 * q2]), x1b = bf2f((unsigned short)qr[0][2 * q2 + 1]), x2a = bf2f((unsigned short)qr[1][2 * q2]), x2b = bf2f((unsigned short)qr[1][2 * q2 + 1]);
              a0[q2] = pk2(x1a * t[0] - x2a * t[1], x1b * t[2] - x2b * t[3]); a1[q2] = pk2(x2a * t[0] + x1a * t[1], x2b * t[2] + x1b * t[3]); }
          w0 = (u32x4){a0[0], a0[1], a0[2], a0[3]}; w1 = (u32x4){a1[0], a1[1], a1[2], a1[3]};
          qr[0] = __builtin_bit_cast(bf16x8, w0); qr[1] = __builtin_bit_cast(bf16x8, w1); }
        float l_reg;
        { tile_loop<1, true>(o, l_reg, qr, KgW, KgW + 256, NSA_NP, w_NT, w_jlo, TL, 0u, qb, pos, t0, C);
          if (hi == 0) C.li_l[r32] = sigmoidf_(gz2) / l_reg;
          asm volatile("s_waitcnt lgkmcnt(0)" ::: "memory");
#pragma unroll
          for (int q2 = 0; q2 < 8; ++q2) { const float w0 = C.li_l[crow(2 * q2, hi)], w1 = C.li_l[crow(2 * q2 + 1, hi)];
#pragma unroll
              for (int d = 0; d < 4; ++d) otot[d][q2] = cvtpk(bflo(otot[d][q2]) + o[d][2 * q2] * w0, bfhi(otot[d][q2]) + o[d][2 * q2 + 1] * w1); } }
        { const unsigned myb = SELB[r32]; const int NT = TL[32];
          const bf16* Kg = P + (size_t)b * SEQ * NSA_NP + PC_KVS + g * 128;
          tile_loop<0>(o, l_reg, qr, Kg, Kg + 256, NSA_NP, NT, 0, TL, myb, qb, pos, t0, C);
          if (hi == 0) C.li_l[r32] = sigmoidf_(gz1) / l_reg;
          asm volatile("s_waitcnt lgkmcnt(0)" ::: "memory");
#pragma unroll
          for (int q2 = 0; q2 < 8; ++q2) { const float w0 = C.li_l[crow(2 * q2, hi)], w1 = C.li_l[crow(2 * q2 + 1, hi)];
#pragma unroll
              for (int d = 0; d < 4; ++d) otot[d][q2] = cvtpk(bflo(otot[d][q2]) + o[d][2 * q2] * w0, bfhi(otot[d][q2]) + o[d][2 * q2 + 1] * w1); } }
#pragma unroll
        for (int q2 = 0; q2 < 8; ++q2) { bf16* orow = O + (size_t)(row0 + crow(2 * q2, hi)) * DM + h * 128;
#pragma unroll
            for (int d = 0; d < 4; ++d) { const unsigned mine = otot[d][q2]; const unsigned nb = (unsigned)__shfl_xor((int)mine, 1);
                if ((r32 & 1) == 0) { *(unsigned*)(orow + d * 32 + r32) = (mine & 0xffffu) | (nb << 16); *(unsigned*)(orow + DM + d * 32 + r32) = (mine >> 16) | (nb & 0xffff0000u); } } }
    }
}
namespace ml4 {
using na::bf16x8; using na::s16x4; using na::f32x16; using na::u32x4;
constexpr int NGRP = 8, GCH = 4;
constexpr int BUF = 49152, T_KT = 0, T_V0 = 16384, T_V1 = 32768;
constexpr int B2_K = 2 * BUF, B2_Q = 2 * BUF + 16384;
constexpr int OFF_WS = 3 * BUF, OFF_AQ = OFF_WS + 8192, OFF_BQ = OFF_AQ + 1024, OFF_GI = OFF_BQ + 1024, OFF_EM = OFF_GI + 1024, OFF_DEC = OFF_EM + 1024, OFF_INV = OFF_DEC + 128, OFF_QN = OFF_INV + 2048,
              OFF_END = OFF_QN + 1024;
constexpr int TMP_F = 0, TMP_B = 8192, TMP_DMX = 16384, TMP_W = 24576, TMP_CH = 32768;
static_assert(OFF_END <= MISC_OFF, "mlstm4 LDS map");
#define M4_TRRD(dst, addr, off) asm volatile("ds_read_b64_tr_b16 %0, %1 offset:%2" : "=&v"(dst) : "v"(addr), "i"(off) : "memory")
#define M4_LDSWAIT() do { asm volatile("s_waitcnt lgkmcnt(0)" ::: "memory"); __builtin_amdgcn_sched_barrier(0); } while (0)
#define M4_FRAG(l_, h_) ((bf16x8){l_[0], l_[1], l_[2], l_[3], h_[0], h_[1], h_[2], h_[3]})
__device__ __forceinline__ void state_step(f32x16 (&cst)[4], f32x16& ntile, int vbK, int vbV, const LAS float* wsp, float dec, int wave, int r32) {
#pragma unroll
    for (int kt = 0; kt < 4; ++kt)
#pragma unroll
        for (int r = 0; r < 16; ++r) cst[kt][r] *= dec;
    if (wave < 4) {
#pragma unroll
        for (int r = 0; r < 16; ++r) ntile[r] *= dec; }
#pragma unroll
    for (int ks = 0; ks < 4; ++ks) {
        s16x4 vl, vh, kl0, kh0, kl1, kh1, kl2, kh2, kl3, kh3;
        M4_TRRD(vl, vbV, ks * 4096); M4_TRRD(vh, vbV, ks * 4096 + 2048);
        M4_TRRD(kl0, vbK, ks * 4096); M4_TRRD(kh0, vbK, ks * 4096 + 2048); M4_TRRD(kl1, vbK, 512 + ks * 4096); M4_TRRD(kh1, vbK, 512 + ks * 4096 + 2048);
        M4_TRRD(kl2, vbK, 1024 + ks * 4096); M4_TRRD(kh2, vbK, 1024 + ks * 4096 + 2048); M4_TRRD(kl3, vbK, 1536 + ks * 4096); M4_TRRD(kh3, vbK, 1536 + ks * 4096 + 2048);
        const f32x4 w0 = *(const LAS f32x4*)(wsp + 16 * ks), w1 = *(const LAS f32x4*)(wsp + 16 * ks + 4);
        M4_LDSWAIT();
        u32x4 sv;
        sv.x = na::cvtpk(bf2f((unsigned short)vl[0]) * w0.x, bf2f((unsigned short)vl[1]) * w0.y); sv.y = na::cvtpk(bf2f((unsigned short)vl[2]) * w0.z, bf2f((unsigned short)vl[3]) * w0.w);
        sv.z = na::cvtpk(bf2f((unsigned short)vh[0]) * w1.x, bf2f((unsigned short)vh[1]) * w1.y); sv.w = na::cvtpk(bf2f((unsigned short)vh[2]) * w1.z, bf2f((unsigned short)vh[3]) * w1.w);
        const bf16x8 vs = __builtin_bit_cast(bf16x8, sv);
        const bf16x8 ka0 = M4_FRAG(kl0, kh0), ka1 = M4_FRAG(kl1, kh1), ka2 = M4_FRAG(kl2, kh2), ka3 = M4_FRAG(kl3, kh3);
        cst[0] = __builtin_amdgcn_mfma_f32_32x32x16_bf16(ka0, vs, cst[0], 0, 0, 0);
        cst[1] = __builtin_amdgcn_mfma_f32_32x32x16_bf16(ka1, vs, cst[1], 0, 0, 0);
        cst[2] = __builtin_amdgcn_mfma_f32_32x32x16_bf16(ka2, vs, cst[2], 0, 0, 0);
        cst[3] = __builtin_amdgcn_mfma_f32_32x32x16_bf16(ka3, vs, cst[3], 0, 0, 0);
        if (wave < 4) {
            u32x4 nw; nw.x = na::cvtpk(w0.x, w0.y); nw.y = na::cvtpk(w0.z, w0.w); nw.z = na::cvtpk(w1.x, w1.y); nw.w = na::cvtpk(w1.z, w1.w);
            if (r32 != 0) nw = (u32x4){0u, 0u, 0u, 0u};
            const bf16x8 nb = __builtin_bit_cast(bf16x8, nw);
            if (wave == 0) ntile = __builtin_amdgcn_mfma_f32_32x32x16_bf16(ka0, nb, ntile, 0, 0, 0);
            else if (wave == 1) ntile = __builtin_amdgcn_mfma_f32_32x32x16_bf16(ka1, nb, ntile, 0, 0, 0);
            else if (wave == 2) ntile = __builtin_amdgcn_mfma_f32_32x32x16_bf16(ka2, nb, ntile, 0, 0, 0);
            else ntile = __builtin_amdgcn_mfma_f32_32x32x16_bf16(ka3, nb, ntile, 0, 0, 0);
        }
    }
}
}

__device__ __forceinline__ void phase_ml_rec4(const int PROBE, const Ptrs& A, int jl, LAS unsigned char* lds, int G, int vcu, int wave, int lane_in, int tid_in) {
    using namespace na; using namespace ml4;
    const bf16* P = (const bf16*)(A.ws + WS_P); const float* GT = (const float*)(A.ws + WS_GATES); bf16* HRAW = (bf16*)(A.ws + WS_HRAW);
    LAS float* t_f = (LAS float*)(lds + TMP_F); LAS float* t_b = (LAS float*)(lds + TMP_B); LAS float* t_dmx = (LAS float*)(lds + TMP_DMX); LAS float* t_w = (LAS float*)(lds + TMP_W);
    LAS float* c_fe = (LAS float*)(lds + TMP_CH); LAS float* c_am = c_fe + 32; LAS float* c_m0 = c_am + 32; LAS float* c_inj = c_m0 + 32;
    LAS float* f_ws = (LAS float*)(lds + OFF_WS); LAS float* f_aq = (LAS float*)(lds + OFF_AQ); LAS float* f_bq = (LAS float*)(lds + OFF_BQ); LAS float* f_gi = (LAS float*)(lds + OFF_GI);
    LAS float* f_em = (LAS float*)(lds + OFF_EM); LAS float* f_dec = (LAS float*)(lds + OFF_DEC); LAS float* s_inv = (LAS float*)(lds + OFF_INV) + wave * 64; LAS float* s_qn = (LAS float*)(lds + OFF_QN);
    LAS char* const ldsc = (LAS char*)lds;
#define M4_LANEVARS() int ln_ = lane_in; asm volatile("" : "+v"(ln_)); const int r32 = ln_ & 31, hi = ln_ >> 5; const int vb0 = (int)(unsigned long long)ldsc + v_rd_base(ln_); (void)r32; (void)hi; (void)vb0; \
        Ctx Cc; Cc.wave = wave; dma_coords(Cc, ln_); const unsigned vo0 = (unsigned)(Cc.vkey[0] * ML_NP + Cc.vcol[0]), vo1 = (unsigned)(Cc.vkey[1] * ML_NP + Cc.vcol[1]), \
        ko0 = (unsigned)(Cc.krow[0] * ML_NP + (Cc.kcolb[0] >> 1)), ko1 = (unsigned)(Cc.krow[1] * ML_NP + (Cc.kcolb[1] >> 1)); (void)vo0; (void)vo1; (void)ko0; (void)ko1
    for (int unit = vcu; unit < 32 * NGRP; unit += G) {
        const int bh = unit / NGRP, g = unit % NGRP, b = bh >> 3, h = bh & 7, c0 = g * GCH;
        int lane = lane_in, tid = tid_in; asm volatile("" : "+v"(lane), "+v"(tid));
        __syncthreads();
        const bf16* Pb = P + (size_t)(b * SEQ) * ML_NP; const bf16* Kg = Pb + MC_K + h * 128; const bf16* Qg = Pb + MC_Q + h * 128; const bf16* Vg = Pb + MC_V + h * 256;
#define M4_DMA2(src, row0, ldsoff, o0_, o1_) do { const bf16* s_ = (src) + (size_t)(row0) * ML_NP; LAS char* d_ = ldsc + (ldsoff) + wave * 2048; unsigned o0 = (o0_), o1 = (o1_); asm volatile("" : "+v"(o0), "+v"(o1));     \
            __builtin_amdgcn_global_load_lds((const unsigned*)(s_ + o0), (LAS unsigned*)d_, 16, 0, 0); __builtin_amdgcn_global_load_lds((const unsigned*)(s_ + o1), (LAS unsigned*)(d_ + 1024), 16, 0, 0); } while (0)
#define M4_DMA_VL(src, row0, ldsoff) M4_DMA2(src, row0, ldsoff, vo0, vo1)
#define M4_DMA_KS(src, row0, ldsoff) M4_DMA2(src, row0, ldsoff, ko0, ko1)
#define M4_DMA_STATE(c_, bo_) do { M4_DMA_VL(Kg, (c_) * 64, (bo_) + T_KT); M4_DMA_VL(Vg, (c_) * 64, (bo_) + T_V0); M4_DMA_VL(Vg + 128, (c_) * 64, (bo_) + T_V1); } while (0)
#define M4_DMA_QK(c_) do { M4_DMA_KS(Kg, (c_) * 64, B2_K); M4_DMA_KS(Qg, (c_) * 64, B2_Q); } while (0)
#ifndef M4_XCH
#define M4_XCH 1
#endif
        const bool xch = M4_XCH && (G >= 32 * NGRP);
        const int cs = xch ? c0 : 0, ns = xch ? ((g + 1 < NGRP) ? GCH : 0) : c0;
        const bool early_full = xch && ns == 0;
        NA_VMWAIT(0);
        { M4_LANEVARS();
          if (ns > 0) { M4_DMA_STATE(cs, BUF); if (ns > 1) M4_DMA_STATE(cs + 1, 2 * BUF); }
          else if (early_full) { M4_DMA_STATE(c0, BUF); M4_DMA_QK(c0); } }
        { float li[4], F[4], dm[4], Fend[4], amax[4];
#pragma unroll
          for (int cc = 0; cc < 4; ++cc) { const size_t grow = (size_t)(b * SEQ + (wave * 4 + cc) * 64 + lane) * 16; li[cc] = GT[grow + h]; F[cc] = GT[grow + 8 + h]; }
#pragma unroll
          for (int o = 1; o < 64; o <<= 1) {
#pragma unroll
              for (int cc = 0; cc < 4; ++cc) { const float t = __shfl_up(F[cc], o); if (lane >= o) F[cc] += t; } }
#pragma unroll
          for (int cc = 0; cc < 4; ++cc) { Fend[cc] = __shfl(F[cc], 63); amax[cc] = Fend[cc] - F[cc] + li[cc]; dm[cc] = li[cc] - F[cc]; }
#pragma unroll
          for (int o = 1; o < 64; o <<= 1) {
#pragma unroll
              for (int cc = 0; cc < 4; ++cc) { amax[cc] = fmaxf(amax[cc], __shfl_xor(amax[cc], o)); const float t = __shfl_up(dm[cc], o); if (lane >= o) dm[cc] = fmaxf(dm[cc], t); } }
#pragma unroll
          for (int cc = 0; cc < 4; ++cc) { const int c = wave * 4 + cc, tk = c * 64 + lane; const float a = Fend[cc] - F[cc] + li[cc];
              t_f[tk] = F[cc]; t_b[tk] = li[cc] - F[cc]; t_w[tk] = __expf(a - amax[cc]); t_dmx[tk] = F[cc] + dm[cc];
              if (lane == 0) { c_fe[c] = Fend[cc]; c_am[c] = amax[cc]; } } }
        __syncthreads();
        if (wave == 0) {
            const int c = lane & 31; const float fe = c_fe[c], am = c_am[c]; float sa = fe, sb = am;
#pragma unroll
            for (int o = 1; o < 32; o <<= 1) { const float pa = __shfl_up(sa, o), pb = __shfl_up(sb, o); if (c >= o) { sb = fmaxf(pb + sa, sb); sa = pa + sa; } }
            const float mn = fmaxf(sa, sb);
            float m = __shfl_up(mn, 1); if (c == 0) m = 0.f;
            if (lane < 32) { c_m0[c] = m; f_dec[c] = __expf(fe + m - mn); c_inj[c] = __expf(am - mn); } }
        __syncthreads();
        for (int tk = tid; tk < 2048; tk += NTHREADS) { const int c = tk >> 6; const float F = t_f[tk]; const float inter = F + c_m0[c]; const float mt = fmaxf(inter, t_dmx[tk]);
            f_ws[tk] = t_w[tk] * c_inj[c];
            const int lc = c - c0;
            if ((unsigned)lc < (unsigned)GCH) { const int i = lc * 64 + (tk & 63);
                f_aq[i] = (F - mt) * 1.4426950408889634f - 3.5f  ; f_bq[i] = t_b[tk] * 1.4426950408889634f; f_gi[i] = __expf(inter - mt) * ATT_SCALE; f_em[i] = __expf(-mt); } }
        __syncthreads();
        f32x16 cst[4]; f32x16 ntile = f32x16{};
#pragma unroll
        for (int kt = 0; kt < 4; ++kt) cst[kt] = f32x16{};
        const int vsl = ((wave >> 2) ? T_V1 : T_V0) + (wave & 3) * 512;
        if (ns > 0) {
#pragma unroll 1
            for (int t = 0, bo = BUF; t < ns; ++t) {
                M4_LANEVARS();
                if (t + 1 < ns) NA_VMWAIT(6); else NA_VMWAIT(0);
                NA_BAR();
                if (t + 2 < ns) { const int bn = (bo >= BUF) ? bo - BUF : bo + 2 * BUF; M4_DMA_STATE(cs + t + 2, bn); }
                state_step(cst, ntile, vb0 + bo + T_KT, vb0 + bo + vsl, f_ws + (cs + t) * 64 + 8 * hi, f_dec[cs + t], wave, r32);
                bo = (bo == 2 * BUF) ? 0 : bo + BUF;
            }
            NA_BAR();
        }
        if (xch) {
            unsigned* flags = (unsigned*)(A.ws + WS_CTL + 131072 + jl * 2048);
            float* LX = (float*)(A.ws + WS_U + ((size_t)64 << 20));
            constexpr size_t LX_UNIT = 8 * 20 * 256, LX_WAVE = 20 * 256;
            int lane2 = lane; asm volatile("" : "+v"(lane2));
            if (ns > 0) {
                float* lx = LX + (size_t)unit * LX_UNIT + wave * LX_WAVE + lane2 * 4;
#pragma unroll
                for (int kt = 0; kt < 4; ++kt)
#pragma unroll
                    for (int q = 0; q < 4; ++q) *(f32x4*)(lx + (kt * 4 + q) * 256) = (f32x4){cst[kt][4 * q], cst[kt][4 * q + 1], cst[kt][4 * q + 2], cst[kt][4 * q + 3]};
                if (wave < 4) {
#pragma unroll
                    for (int q = 0; q < 4; ++q) *(f32x4*)(lx + (16 + q) * 256) = (f32x4){ntile[4 * q], ntile[4 * q + 1], ntile[4 * q + 2], ntile[4 * q + 3]}; }
                asm volatile("s_waitcnt vmcnt(0)" ::: "memory");
                __syncthreads();
                if (tid == 0) { __builtin_amdgcn_fence(__ATOMIC_RELEASE, "agent"); asm volatile("s_waitcnt vmcnt(0)" ::: "memory"); __hip_atomic_store(&flags[unit], 1u, __ATOMIC_RELAXED, __HIP_MEMORY_SCOPE_AGENT); }
            }
            if (!early_full) { M4_LANEVARS(); M4_DMA_STATE(c0, BUF); M4_DMA_QK(c0); }
#pragma unroll
            for (int kt = 0; kt < 4; ++kt) cst[kt] = f32x16{};
            ntile = f32x16{};
            if (g > 0) {
                if (tid == 0) {
                    for (int gp = 0; gp < g; ++gp) { unsigned sp = 0u;
                        while (__hip_atomic_load(&flags[unit - g + gp], __ATOMIC_RELAXED, __HIP_MEMORY_SCOPE_AGENT) == 0u) { __builtin_amdgcn_s_sleep(1); if (++sp > (1u << 22)) break; } }
                    __builtin_amdgcn_fence(__ATOMIC_ACQUIRE, "agent"); asm volatile("s_waitcnt vmcnt(0)" ::: "memory"); }
                __syncthreads();
                float coef = 1.f;
#pragma unroll 1
                for (int gp = g - 1; gp >= 0; --gp) { const float* lp = LX + (size_t)(unit - g + gp) * LX_UNIT + wave * LX_WAVE + lane2 * 4;
#pragma unroll
                    for (int kt = 0; kt < 4; ++kt)
#pragma unroll
                        for (int q = 0; q < 4; ++q) { const f32x4 v = *(const f32x4*)(lp + (kt * 4 + q) * 256);
                            cst[kt][4 * q] += coef * v.x; cst[kt][4 * q + 1] += coef * v.y; cst[kt][4 * q + 2] += coef * v.z; cst[kt][4 * q + 3] += coef * v.w; }
                    if (wave < 4) {
#pragma unroll
                        for (int q = 0; q < 4; ++q) { const f32x4 v = *(const f32x4*)(lp + (16 + q) * 256);
                            ntile[4 * q] += coef * v.x; ntile[4 * q + 1] += coef * v.y; ntile[4 * q + 2] += coef * v.z; ntile[4 * q + 3] += coef * v.w; } }
                    coef *= (f_dec[4 * gp] * f_dec[4 * gp + 1]) * (f_dec[4 * gp + 2] * f_dec[4 * gp + 3]); }
            }
        }
        if (!xch) { NA_VMWAIT(0); M4_LANEVARS(); M4_DMA_STATE(c0, BUF); M4_DMA_QK(c0); }
#pragma unroll 1
        for (int j = 0; j < (PROBE == 2 ? 0 : GCH); ++j) { const int c = c0 + j, bo = ((j & 1) ^ 1) * BUF, lt = j * 64;
            NA_VMWAIT(0);
            NA_BAR();
            if (j + 1 < GCH) { M4_LANEVARS(); M4_DMA_STATE(c + 1, BUF - bo); }
            int ln_ = lane_in; asm volatile("" : "+v"(ln_)); const int r32 = ln_ & 31, hi = ln_ >> 5; const int vb0 = (int)(unsigned long long)ldsc + v_rd_base(ln_);
            f32x16 hn0, hn1; float rs0, rs1;
#define M4_KADDR(T, d) (kb4[(d) & 3] + ((d) >> 2) * 128 + (T) * 8192)
#define M4_QADDR(QT, d) (kb4[(d) & 3] + (B2_Q - B2_K) + ((d) >> 2) * 128 + (QT) * 8192)
#define M4_STILE(QT, T, PA0, PA1) do { f32x16 pt = f32x16{}; bf16x8 kf0[4], kf1[4];                                                                              \
                _Pragma("unroll") for (int i = 0; i < 4; ++i) kf0[i] = *(const LAS bf16x8*)M4_KADDR(T, i);                                                        \
                SBAR();                                                                                                                                           \
                _Pragma("unroll") for (int i = 0; i < 4; ++i) kf1[i] = *(const LAS bf16x8*)M4_KADDR(T, 4 + i);                                                    \
                f32x4 bq[4];                                                                                                                                      \
                _Pragma("unroll") for (int g4 = 0; g4 < 4; ++g4) bq[g4] = *(const LAS f32x4*)(f_bq + lt + 32 * (T) + 8 * g4 + 4 * hi);     \
                _Pragma("unroll") for (int i = 0; i < 4; ++i) pt = __builtin_amdgcn_mfma_f32_32x32x16_bf16(kf0[i], qr[i], pt, 0, 0, 0);                           \
                SBAR();                                                                                                                                           \
                _Pragma("unroll") for (int i = 0; i < 4; ++i) pt = __builtin_amdgcn_mfma_f32_32x32x16_bf16(kf1[i], qr[4 + i], pt, 0, 0, 0);                       \
                SBAR();                                                                                                                                           \
                _Pragma("unroll") for (int r = 0; r < 16; ++r) { const float e_ = __builtin_amdgcn_exp2f(aql + bq[r >> 2][r & 3]);                                \
                    const float wgt = ((T) != (QT) || crow(r, hi) <= r32) ? e_ : 0.f; pt[r] *= wgt; rs += pt[r]; }                                                \
                NA_PK4(pt, 0, PA0); NA_PK4(pt, 8, PA1); SBAR(); } while (0)
#define M4_QT(QT, HN, RS) do { const int l = 32 * (QT) + r32; bf16x8 qr[8];                                                                                     \
                _Pragma("unroll") for (int d = 0; d < 8; ++d) qr[d] = *(const LAS bf16x8*)M4_QADDR(QT, d);                                                        \
                const float aql = f_aq[lt + l];                                                                                                                   \
                if (wave < 4) { const bf16x8 qa = *(const LAS bf16x8*)(ldsc + B2_Q + KSWZ(l, 64 * wave + 16 * hi)), qb = *(const LAS bf16x8*)(ldsc + B2_Q + KSWZ(l, 64 * wave + 32 + 16 * hi)); \
                    bf16x8 n0, n1; NA_PK4(ntile, 0, n0); NA_PK4(ntile, 8, n1); f32x16 qn = f32x16{};                                                              \
                    qn = __builtin_amdgcn_mfma_f32_32x32x16_bf16(qa, n0, qn, 0, 0, 0); qn = __builtin_amdgcn_mfma_f32_32x32x16_bf16(qb, n1, qn, 0, 0, 0);        \
                    if (r32 == 0) { _Pragma("unroll") for (int r = 0; r < 16; ++r) s_qn[wave * 64 + 32 * (QT) + crow(r, hi)] = qn[r]; } }                         \
                SBAR(); float rs = 0.f; bf16x8 pa0, pa1, pa2, pa3;                                                                                                \
                M4_STILE(QT, 0, pa0, pa1);                                                                                                                        \
                if ((QT) == 1) M4_STILE(QT, 1, pa2, pa3);                                                                                                         \
                { auto rr = __builtin_amdgcn_permlane32_swap(__float_as_uint(rs), __float_as_uint(rs), false, false); rs = __uint_as_float(rr[0]) + __uint_as_float(rr[1]); } \
                RS = rs;                                                                                                                                          \
                f32x16 o = f32x16{}; const int vbV = vb0 + bo + vsl; s16x4 l0, h0, l1, h1, l2, h2, l3, h3;                                                         \
                M4_TRRD(l0, vbV, 0); M4_TRRD(h0, vbV, 2048); M4_TRRD(l1, vbV, 4096); M4_TRRD(h1, vbV, 6144);                                                      \
                if ((QT) == 1) { M4_TRRD(l2, vbV, 8192); M4_TRRD(h2, vbV, 10240); M4_TRRD(l3, vbV, 12288); M4_TRRD(h3, vbV, 14336); }                             \
                M4_LDSWAIT();                                                                                                                                     \
                o = __builtin_amdgcn_mfma_f32_32x32x16_bf16(pa0, M4_FRAG(l0, h0), o, 0, 0, 0); o = __builtin_amdgcn_mfma_f32_32x32x16_bf16(pa1, M4_FRAG(l1, h1), o, 0, 0, 0); \
                if ((QT) == 1) { o = __builtin_amdgcn_mfma_f32_32x32x16_bf16(pa2, M4_FRAG(l2, h2), o, 0, 0, 0); o = __builtin_amdgcn_mfma_f32_32x32x16_bf16(pa3, M4_FRAG(l3, h3), o, 0, 0, 0); } \
                f32x16 oc = f32x16{}; f32x4 giv[4];                                                                                                               \
                _Pragma("unroll") for (int g4 = 0; g4 < 4; ++g4) giv[g4] = *(const LAS f32x4*)(f_gi + lt + 32 * (QT) + 8 * g4 + 4 * hi);                          \
                _Pragma("unroll") for (int kt = 0; kt < 4; ++kt) { bf16x8 cb0, cb1; NA_PK4(cst[kt], 0, cb0); NA_PK4(cst[kt], 8, cb1);                              \
                    oc = __builtin_amdgcn_mfma_f32_32x32x16_bf16(qr[2 * kt], cb0, oc, 0, 0, 0); oc = __builtin_amdgcn_mfma_f32_32x32x16_bf16(qr[2 * kt + 1], cb1, oc, 0, 0, 0); } \
                SBAR();                                                                                                                                           \
                _Pragma("unroll") for (int r = 0; r < 16; ++r) HN[r] = o[r] + giv[r >> 2][r & 3] * oc[r]; SBAR(); } while (0)
            const LAS char* kb4[4];
#pragma unroll
            for (int dd = 0; dd < 4; ++dd) kb4[dd] = ldsc + B2_K + KSWZ(r32, 32 * dd + 16 * hi);
            asm volatile("s_nop 7\n\ts_nop 7\n\ts_nop 7" ::: "memory");
            M4_QT(0, hn0, rs0);
            M4_QT(1, hn1, rs1);
#undef M4_QT
#undef M4_STILE
#undef M4_KADDR
#undef M4_QADDR
            NA_BAR();
            if (j + 1 < GCH) { M4_LANEVARS(); M4_DMA_QK(c + 1); }
            { const float qn0 = (s_qn[r32] + s_qn[64 + r32]) + (s_qn[128 + r32] + s_qn[192 + r32]), qn1 = (s_qn[32 + r32] + s_qn[96 + r32]) + (s_qn[160 + r32] + s_qn[224 + r32]);
              const float d0 = rs0 + f_gi[lt + r32] * qn0, d1 = rs1 + f_gi[lt + 32 + r32] * qn1;
              const float i0 = 1.0f / fmaxf(fabsf(d0), f_em[lt + r32]), i1 = 1.0f / fmaxf(fabsf(d1), f_em[lt + 32 + r32]);
              if (hi == 0) { s_inv[r32] = i0; s_inv[32 + r32] = i1; } }
#define M4_OUT(QT, HN) do { bf16* hp = HRAW + (size_t)(b * SEQ + c * 64 + 32 * (QT)) * DM + h * 256 + wave * 32 + r32; f32x4 iv[4];     \
              _Pragma("unroll") for (int g4 = 0; g4 < 4; ++g4) iv[g4] = *(const LAS f32x4*)(s_inv + 32 * (QT) + 8 * g4 + 4 * hi);                                  \
              _Pragma("unroll") for (int r = 0; r < 16; r += 2) { const int row = crow(r, hi); const unsigned w0 = cvtpk(HN[r] * iv[r >> 2][r & 3], HN[r + 1] * iv[r >> 2][(r & 3) + 1]); \
                  if (PROBE == 0) { hp[(size_t)row * DM] = (bf16)w0; hp[(size_t)(row + 1) * DM] = (bf16)(w0 >> 16); } else asm volatile("" :: "v"(w0)); } SBAR(); } while (0)
            M4_OUT(0, hn0); M4_OUT(1, hn1);
#undef M4_OUT
            if (j + 1 < GCH) state_step(cst, ntile, vb0 + bo + T_KT, vb0 + bo + vsl, f_ws + c * 64 + 8 * hi, f_dec[c], wave, r32);
        }
        asm volatile("s_waitcnt vmcnt(0)" ::: "memory");
        __syncthreads();
        if (PROBE == 0) { const bf16* HR = HRAW; bf16* Oo = (bf16*)(A.ws + WS_O); const float* hnw = A.ml_head_norm + (size_t)jl * DM + h * 256;
            int t2 = tid_in; asm volatile("" : "+v"(t2)); const int c8 = t2 & 31, rq = t2 >> 5, col = h * 256 + 8 * c8; const f32x4 ga = *(const f32x4*)(hnw + 8 * c8), gb2 = *(const f32x4*)(hnw + 8 * c8 + 4);
#pragma unroll 1
            for (int r0 = 0; r0 < 256; r0 += 64) {
                v4u hrv[4], ogv[4];
#pragma unroll
                for (int u = 0; u < 4; ++u) { const size_t row = (size_t)(b * SEQ + c0 * 64 + r0 + 16 * u + rq); hrv[u] = *(const v4u*)(HR + row * DM + col); ogv[u] = *(const v4u*)(P + row * ML_NP + MC_OG + col); }
#pragma unroll
                for (int u = 0; u < 4; ++u) { const size_t row = (size_t)(b * SEQ + c0 * 64 + r0 + 16 * u + rq); const v4u hr = hrv[u], og = ogv[u];
                    const f32x4 a = (f32x4){bflo(hr.x), bfhi(hr.x), bflo(hr.y), bfhi(hr.y)}, b2 = (f32x4){bflo(hr.z), bfhi(hr.z), bflo(hr.w), bfhi(hr.w)};
                    float ss = ((a.x * a.x + a.y * a.y) + (a.z * a.z + a.w * a.w)) + ((b2.x * b2.x + b2.y * b2.y) + (b2.z * b2.z + b2.w * b2.w));
#pragma unroll
                    for (int o = 1; o < 32; o <<= 1) ss += __shfl_xor(ss, o);
                    const float rstd = 1.0f / sqrtf(ss * (1.0f / 256.0f) + 1e-6f);
                    v4u o;
                    o.x = pk2(a.x * rstd * ga.x * sigmoidf_(bflo(og.x)), a.y * rstd * ga.y * sigmoidf_(bfhi(og.x)));
                    o.y = pk2(a.z * rstd * ga.z * sigmoidf_(bflo(og.y)), a.w * rstd * ga.w * sigmoidf_(bfhi(og.y)));
                    o.z = pk2(b2.x * rstd * gb2.x * sigmoidf_(bflo(og.z)), b2.y * rstd * gb2.y * sigmoidf_(bfhi(og.z)));
                    o.w = pk2(b2.z * rstd * gb2.z * sigmoidf_(bflo(og.w)), b2.w * rstd * gb2.w * sigmoidf_(bfhi(og.w)));
                    *(v4u*)(Oo + row * DM + col) = o; } }
        }
        NA_BAR();
#undef M4_DMA_VL
#undef M4_DMA2
#undef M4_LANEVARS
#undef M4_DMA_KS
#undef M4_DMA_STATE
#undef M4_DMA_QK
    }
}
__device__ __forceinline__ void phase_compress2(const Ptrs& A, int j_layer, LAS unsigned char* lds, int G, int vcu, int wave, int lane, int tid) {
    typedef short bf16x8 __attribute__((ext_vector_type(8))); typedef float f32x16 __attribute__((ext_vector_type(16)));
    const bf16* P = (const bf16*)(A.ws + WS_P); bf16* KC = (bf16*)(A.ws + WS_KC); bf16* VC = (bf16*)(A.ws + WS_VC);
    const float* pe = A.nsa_pe + (size_t)j_layer * 2 * 32 * 128;
    const bf16* W1T = (const bf16*)(A.ws + WS_W1T) + (size_t)j_layer * 2 * 32 * 128 * 128; const bf16* W2T = (const bf16*)(A.ws + WS_W2T) + (size_t)j_layer * 2 * 128 * 128;
    LAS float* part = (LAS float*)lds;
    LAS bf16* hidb = (LAS bf16*)(lds + RSTD_OFF);
    const int r32 = lane & 31, hi = lane >> 5;
    for (int unit = vcu; unit < 64; unit += G) {
        const int jt = unit & 3, g = (unit >> 2) & 1, b = (unit >> 3) & 3, c = unit >> 5, j0 = 32 * jt;
        const int jc = (j0 + r32 < NCMP) ? j0 + r32 : NCMP - 1;
        f32x16 acc[4];
#pragma unroll
        for (int nt = 0; nt < 4; ++nt) acc[nt] = f32x16{};
        for (int li = 0; li < 4; ++li) { const int l = wave * 4 + li;
            const bf16* arow = P + (size_t)(b * SEQ + 16 * jc + l) * NSA_NP + PC_KVC + c * 256 + g * 128 + hi * 8;
            const float* perow = pe + (size_t)(c * 32 + l) * 128 + hi * 8;
            const bf16* brow = W1T + ((size_t)(c * 32 + l) * 128 + r32) * 128 + hi * 8;
#pragma unroll
            for (int k2 = 0; k2 < 8; k2 += 2) {
                v4u xa[2]; f32x4 p0[2], p1[2]; bf16x8 bfr[2][4];
#pragma unroll
                for (int q = 0; q < 2; ++q) { const int ks = k2 + q; xa[q] = *(const v4u*)(arow + ks * 16); p0[q] = *(const f32x4*)(perow + ks * 16); p1[q] = *(const f32x4*)(perow + ks * 16 + 4);
#pragma unroll
                    for (int nt = 0; nt < 4; ++nt) bfr[q][nt] = *(const bf16x8*)(brow + (size_t)nt * 32 * 128 + ks * 16); }
#pragma unroll
                for (int q = 0; q < 2; ++q) {
                    v4u aw; aw.x = pk2(bflo(xa[q].x) + p0[q].x, bfhi(xa[q].x) + p0[q].y); aw.y = pk2(bflo(xa[q].y) + p0[q].z, bfhi(xa[q].y) + p0[q].w); aw.z = pk2(bflo(xa[q].z) + p1[q].x, bfhi(xa[q].z) + p1[q].y); aw.w = pk2(bflo(xa[q].w) + p1[q].z, bfhi(xa[q].w) + p1[q].w);
                    const bf16x8 af = __builtin_bit_cast(bf16x8, aw);
#pragma unroll
                    for (int nt = 0; nt < 4; ++nt) acc[nt] = __builtin_amdgcn_mfma_f32_32x32x16_bf16(af, bfr[q][nt], acc[nt], 0, 0, 0); } } }
        __syncthreads();
#pragma unroll
        for (int nt = 0; nt < 4; ++nt)
#pragma unroll
            for (int r = 0; r < 16; ++r) part[(wave * 32 + (r & 3) + 8 * (r >> 2) + 4 * hi) * 128 + nt * 32 + r32] = acc[nt][r];
        __syncthreads();
        { const int row = tid >> 4, h8 = (tid & 15) * 8; unsigned ow[4];
#pragma unroll
          for (int q = 0; q < 2; ++q) { f32x4 s = (f32x4){0.f, 0.f, 0.f, 0.f};
#pragma unroll
              for (int w = 0; w < 8; ++w) s += *(const LAS f32x4*)(part + (w * 32 + row) * 128 + h8 + 4 * q);
              float e[4];
#pragma unroll
              for (int i = 0; i < 4; ++i) { const float v = s[i]; e[i] = 0.5f * v * (1.0f + tanhf_(0.7978845608028654f * (v + 0.044715f * v * v * v))); }
              ow[2 * q] = pk2(e[0], e[1]); ow[2 * q + 1] = pk2(e[2], e[3]); }
          *(LAS v4u*)(hidb + row * 136 + h8) = (v4u){ow[0], ow[1], ow[2], ow[3]}; }
        __syncthreads();
        if (wave < 4) { const int nt = wave; f32x16 o = f32x16{};
            const bf16* brow = W2T + ((size_t)c * 128 + nt * 32 + r32) * 128 + hi * 8; bf16x8 bfw[8];
#pragma unroll
            for (int ks = 0; ks < 8; ++ks) bfw[ks] = *(const bf16x8*)(brow + ks * 16);
#pragma unroll
            for (int ks = 0; ks < 8; ++ks) { const bf16x8 af = *(const LAS bf16x8*)(hidb + r32 * 136 + ks * 16 + hi * 8); o = __builtin_amdgcn_mfma_f32_32x32x16_bf16(af, bfw[ks], o, 0, 0, 0); }
            bf16* dst = (c == 0 ? KC : VC) + ((size_t)(b * 2 + g) * 128 + j0) * 128 + nt * 32 + r32;
#pragma unroll
            for (int r = 0; r < 16; ++r) { const int row = (r & 3) + 8 * (r >> 2) + 4 * hi; dst[(size_t)row * 128] = (j0 + row < NCMP) ? (bf16)f2bf(o[r]) : (bf16)0; } }
    }
}
__device__ __forceinline__ Ptrs load_ptrs() {
    const void* const* kp = (const void* const*)__builtin_amdgcn_kernarg_segment_ptr();
    int z = 0; asm volatile("" : "+s"(z));
    Ptrs A;
    A.x = (const float*)kp[z + 0]; A.pos = (const int*)kp[z + 1];
    A.nsa_w_in = (const float*)kp[z + 2]; A.nsa_gate_b = (const float*)kp[z + 3]; A.nsa_pe = (const float*)kp[z + 4]; A.nsa_w1 = (const float*)kp[z + 5]; A.nsa_w2 = (const float*)kp[z + 6]; A.nsa_w_out = (const float*)kp[z + 7];
    A.ml_w_in = (const float*)kp[z + 8]; A.ml_gate_b = (const float*)kp[z + 9]; A.ml_head_norm = (const float*)kp[z + 10]; A.ml_w_out = (const float*)kp[z + 11];
    A.norm_mix = (const float*)kp[z + 12]; A.norm_ffn = (const float*)kp[z + 13]; A.w_up = (const float*)kp[z + 14]; A.conv_w = (const float*)kp[z + 15]; A.conv_b = (const float*)kp[z + 16]; A.w_down = (const float*)kp[z + 17]; A.norm_final = (const float*)kp[z + 18];
    A.out = (float*)kp[z + 19]; A.ws = (unsigned char*)kp[z + 20];
    return A;
}
constexpr int NPHASES = 30;
struct Args { const void* in[19]; float* out; unsigned char* ws; int ph_lo, ph_hi; };
__global__ void __launch_bounds__(NTHREADS, 2) fwd_kernel(Args args) {
    extern __shared__ __attribute__((aligned(16))) unsigned char lds_raw[];
    LAS unsigned char* lds = (LAS unsigned char*)lds_raw;
    volatile LAS unsigned* MISC = (volatile LAS unsigned*)(lds + MISC_OFF);
    const int G = gridDim.x; const int bx = blockIdx.x; const int vcu = (G % 8 == 0) ? (bx % 8) * (G / 8) + bx / 8 : bx;
    const int lo = args.ph_lo, hi = args.ph_hi;
    const int wv0 = __builtin_amdgcn_readfirstlane((int)threadIdx.x >> 6);
#define TIDX() ((wv0 << 6) | hw_lane())
    if (TIDX() < 32) MISC[TIDX()] = 0u;
    __syncthreads();
    XcdBarrier bar; bar.bar = (unsigned*)(args.ws + WS_CTL) + CW_BAR; bar.x = 0; bar.st = nullptr; bar.wv = wv0;
    if (hi - lo > 1) bar = xcd_barrier_post((unsigned*)(args.ws + WS_CTL) + CW_BAR, MISC + 8, wv0);
#ifndef DUP_MASK
#define DUP_MASK 0
#endif
#define DUP(bit) for (int rep_ = 0; rep_ < (((DUP_MASK) >> (bit)) & 1 ? 2 : 1); ++rep_)
#define IN(k) (lo <= (k) && (k) < hi)
#define SEAM(k) do { if (IN(k) && IN((k) + 1)) xcd_barrier(bar); } while (0)
#define SITE() const Ptrs A = load_ptrs(); int tid = TIDX(); asm volatile("" : "+v"(tid)); const int lane = tid & 63, wave = __builtin_amdgcn_readfirstlane(tid >> 6); (void)lane; (void)wave; \
    bf16* XB = (bf16*)(A.ws + WS_XB); float* XR = (float*)(A.ws + WS_XR); float* SSP = (float*)(A.ws + WS_SSP); bf16* P = (bf16*)(A.ws + WS_P); bf16* O = (bf16*)(A.ws + WS_O); (void)XB; (void)XR; (void)SSP; (void)P; (void)O

    if (IN(0)) { SITE(); DUP(0) phase_prologue(A, lds, G, vcu, wave, lane, tid); }
    SEAM(0);
    for (int layer = 0; layer < DEPTH; ++layer) {
        const int pb = 1 + 7 * layer; const bool nsa = (layer & 1) == 0; const int jl = layer >> 1;
        if (IN(pb)) { SITE();
            const int N = nsa ? NSA_NP : ML_NP;
            pg8::Gemm g{XB, (const bf16*)(A.ws + (nsa ? WS_WNSA + jl * SZ_WNSA : WS_WML + jl * SZ_WML)), MROWS, N, DM, wave}; pg8::StaticOrder S; S.init(MROWS, N, G, bx);
            LAS float* rtab = (LAS float*)(lds + RSTD_OFF); pg8::prep_rstd(SSP, S, rtab, tid);
            pg8::EpiProj E{P, N, rtab, nsa ? (const float*)(A.ws + WS_ROPE) : nullptr};
            DUP(1) pg8::gemm_phase<pg8::EpiProj, pg8::StaticOrder, true, true>(lds, g, S, E);
            if (!nsa) DUP(8) phase_ml_gates(A, jl, layer, G, vcu, wave, lane);
            if (nsa && layer + 1 < DEPTH) { const int rem = (32 * (NSA_NP / 256)) % G, n = cv_inslot_items(layer + 1, G);
                if (n > 0 && bx >= rem) { __syncthreads(); const int t0 = cv_tail_items(layer + 1, G); convert_layer(A, layer + 1, t0, t0 + n, (bx - rem) * NWAVES + wave, (G - rem) * NWAVES, (LAS float*)(lds + wave * 16640), lane); } }
        }
        SEAM(pb);
        if (IN(pb + 1)) { SITE();
            if (nsa) { DUP(2) phase_compress2(A, jl, lds, G, vcu, wave, lane, tid);
                if (vcu >= 64 && cv_slot_items(layer, G) > 0) convert_layer(A, layer, cv_layer_items(layer) - cv_slot_items(layer, G), cv_layer_items(layer), (vcu - 64) * NWAVES + wave, (G - 64) * NWAVES, (LAS float*)(lds + wave * 16640), lane); }
            else { for (int rep_ = 0; rep_ < (((DUP_MASK >> 13) & 7) ? 2 : 1); ++rep_) phase_ml_rec4(rep_ ? ((DUP_MASK >> 13) & 7) - 1 : 0, A, jl, lds, G, vcu, wave, lane, tid);
            }
        }
        SEAM(pb + 1);
        if (IN(pb + 2)) { SITE();
            if (nsa) DUP(3) phase_nsa_attn2(A, jl, lds, G, vcu, wave, lane, tid);
        }
        if (nsa) SEAM(pb + 2);
        if (IN(pb + 3)) { SITE();
            pg8::Gemm g{O, (const bf16*)(A.ws + WS_WOUT + layer * SZ_WOUT), MROWS, DM, DM, wave}; pg8::StaticOrder S; S.init(MROWS, DM, G, bx);
            pg8::EpiRes E{nullptr, XB, SSP};
            pg8::gemm_phase<pg8::EpiRes, pg8::StaticOrder, true, true>(lds, g, S, E);
        }
        SEAM(pb + 3);
        if (IN(pb + 4)) { SITE();
            pg8::Gemm g{XB, (const bf16*)(A.ws + WS_WUP + layer * SZ_WUP), MROWS, NUP, DM, wave}; pg8::StaticOrder S; S.init(MROWS, NUP, G, bx);
            LAS float* rtab = (LAS float*)(lds + RSTD_OFF); pg8::prep_rstd(SSP, S, rtab, tid);
            pg8::EpiUp E{(bf16*)(A.ws + WS_ACT), (float*)(A.ws + WS_U), A.conv_w + (size_t)layer * 3 * NUP, A.conv_b + (size_t)layer * NUP, rtab};
            DUP(6) pg8::gemm_phase<pg8::EpiUp, pg8::StaticOrder, true, true>(lds, g, S, E);
            {
              const int nwg = (MROWS / 256) * (NUP / 256), rem = nwg % G;
              if (layer + 1 < DEPTH && rem != 0 && bx >= rem) convert_layer(A, layer + 1, 0, cv_tail_items(layer + 1, G), (bx - rem) * NWAVES + wave, (G - rem) * NWAVES, (LAS float*)(lds + wave * 16640), lane); }
#if (DUP_MASK >> 9) & 1
            { pg8::EpiNull EN{(float*)(A.ws + WS_QR) + (A.pos[0] < 0 ? 0 : 0)}; EN.sink = (A.pos[0] == -12345) ? (float*)(A.ws + WS_QR) : nullptr; pg8::gemm_phase<pg8::EpiNull, pg8::StaticOrder, true, true>(lds, g, S, EN); }
#endif
        }
        SEAM(pb + 4);
        if (IN(pb + 5)) { SITE(); DUP(7) phase_fixup(A, layer, G, vcu, tid); }
        SEAM(pb + 5);
        if (IN(pb + 6)) { SITE();
            pg8::Gemm g{(const bf16*)(A.ws + WS_ACT), (const bf16*)(A.ws + WS_WDN + layer * SZ_WDN), MROWS, DM, DFF, wave}; pg8::StaticOrder S; S.init(MROWS, DM, G, bx);
            pg8::EpiRes E{nullptr, XB, SSP};
            pg8::gemm_phase<pg8::EpiRes, pg8::StaticOrder, true, true>(lds, g, S, E);
        }
        SEAM(pb + 6);
    }
#if (DUP_MASK >> 12) & 1
    if (hi - lo > 1) { for (int rep_ = 0; rep_ < 20; ++rep_) xcd_barrier(bar); }
#endif
    if (IN(29)) { SITE(); phase_final(A, G, vcu, wave, lane); }
#undef SITE
#undef IN
#undef SEAM
}

extern "C" void kernel_launch(void* const* d_in, const int* in_sizes, int n_in, void* d_out, int out_size, void* d_ws, size_t ws_size, hipStream_t stream) {
    static int grid = 0;
    if (grid == 0) {
        if (n_in != 19 || out_size != MROWS * DM || ws_size < WS_END) { fprintf(stderr, "kernel_launch: unexpected shapes (n_in %d, out %d, ws %zu, need %zu); nothing launched\n", n_in, out_size, ws_size, (size_t)WS_END); grid = -1; return; }
        int dev = 0, cus = 0, per_cu = 0;
        if (hipGetDevice(&dev) != hipSuccess || hipDeviceGetAttribute(&cus, hipDeviceAttributeMultiprocessorCount, dev) != hipSuccess) { fprintf(stderr, "kernel_launch: device query failed\n"); grid = -1; return; }
        if (hipFuncSetAttribute((const void*)fwd_kernel, hipFuncAttributeMaxDynamicSharedMemorySize, LDS_BYTES) != hipSuccess) { fprintf(stderr, "kernel_launch: hipFuncSetAttribute failed\n"); grid = -1; return; }
        if (hipOccupancyMaxActiveBlocksPerMultiprocessor(&per_cu, (const void*)fwd_kernel, NTHREADS, LDS_BYTES) != hipSuccess || per_cu < 1) fprintf(stderr, "kernel_launch: occupancy query reports %d blocks per CU\n", per_cu);
        (void)hipGetLastError();
        grid = cus;
    }
    if (grid < 0) return;
    (void)hipMemsetAsync((char*)d_ws + WS_CTL, 0, CTL_BYTES, stream);
    Args a{};
    for (int i = 0; i < 19; ++i) a.in[i] = d_in[i];
    a.out = (float*)d_out; a.ws = (unsigned char*)d_ws;
#if MK_ONE_LAUNCH
    a.ph_lo = 0; a.ph_hi = NPHASES;
    hipLaunchKernelGGL(fwd_kernel, dim3(grid), dim3(NTHREADS), LDS_BYTES, stream, a);
#else
    for (int p = 0; p < NPHASES; ++p) { a.ph_lo = p; a.ph_hi = p + 1; hipLaunchKernelGGL(fwd_kernel, dim3(grid), dim3(NTHREADS), LDS_BYTES, stream, a); }
#endif
}
```

```cpp
#include <hip/hip_runtime.h>
#include <cstdio>
#include <cstdint>
namespace pg8 {
#define PG8_LAS __attribute__((address_space(3)))
typedef unsigned short bf16_t;
typedef short bf16x8 __attribute__((ext_vector_type(8)));
typedef float f32x4 __attribute__((ext_vector_type(4)));
typedef unsigned u32x4 __attribute__((ext_vector_type(4)));
constexpr int BM = 256, BK = 64, HALF = 128, HTB = HALF * BK * 2  , STAGE_BYTES = 8 * HTB, NXCD = 8, WGM = 8;

__host__ __device__ __forceinline__ int lds_byte(int r, int c) { const int st = (r >> 4) * 2 + (c >> 5), rr = r & 15, cc = c & 31, ob = rr * 64 + cc * 2; return st * 1024 + (ob ^ (((ob >> 9) & 1) << 5)); }
__host__ __device__ __forceinline__ void stage_rc(int b, int& R, int& C) { const int st = b / 1024, sb = b % 1024, swz = sb ^ (((sb >> 9) & 1) << 5); R = (st >> 1) * 16 + swz / 64; C = (st & 1) * 32 + (swz % 64) / 2; }
__host__ __device__ __forceinline__ int perm32(int rho) { const int n = rho >> 4, i = rho & 15; return 8 * (i >> 2) + 4 * n + (i & 3); }

struct Unit { int pm, pn, idx; };
struct Gemm { const bf16_t* A; const bf16_t* Bt; int M, N, K, wv; };

struct StaticOrder {
    int nM, nN, nwg, G, c;
    __host__ __device__ void init(int M, int N, int G_, int c_) { nM = M / BM; nN = N / BM; nwg = nM * nN; G = G_; c = c_; }
    __host__ __device__ bool next(int i, Unit& u) const {
        const long L = (long)i * G + c; if (L >= nwg) return false;
        int wgid = (int)L; { const int q = nwg / NXCD, r = nwg % NXCD, xcd = wgid % NXCD, off = wgid / NXCD; wgid = (xcd < r ? xcd * (q + 1) : r * (q + 1) + (xcd - r) * q) + off; }
        const int nig = WGM * nN, gid = wgid / nig, fm = gid * WGM, gsz = (nM - fm) < WGM ? (nM - fm) : WGM;
        u.pm = fm + ((wgid % nig) % gsz); u.pn = (wgid % nig) / gsz; u.idx = i; return true;
    }
    __device__ __forceinline__ void a_ready(const Unit&) const {}
    __device__ __forceinline__ void done(const Unit&) const {}
};
__device__ __forceinline__ unsigned cvt_pk_bf16(float lo, float hi) { unsigned r; asm volatile("v_cvt_pk_bf16_f32 %0, %1, %2" : "=v"(r) : "v"(lo), "v"(hi)); return r; }
typedef float f32x2 __attribute__((ext_vector_type(2)));
constexpr int EP_ROWS = 8192;
template <class Sched> __device__ __forceinline__ void prep_rstd(const float* ssp, const Sched& S, PG8_LAS float* tab, int tid) {
    float pv[3][32]; int slot[3];
#pragma unroll
    for (int q = 0; q < 3; ++q) { const int idx = tid + 512 * q, i = idx >> 8, r = idx & 255; Unit u; slot[q] = -1;
        const bool ok = S.next(i, u); if (ok) slot[q] = idx; const float* p = ssp + (ok ? u.pm * BM + r : 0);
#pragma unroll
        for (int j = 0; j < 32; ++j) pv[q][j] = p[(size_t)j * EP_ROWS]; }
#pragma unroll
    for (int q = 0; q < 3; ++q) { float s[4] = {0.f, 0.f, 0.f, 0.f};
#pragma unroll
        for (int j = 0; j < 32; j += 4) { s[0] += pv[q][j]; s[1] += pv[q][j + 1]; s[2] += pv[q][j + 2]; s[3] += pv[q][j + 3]; }
        if (slot[q] >= 0) tab[slot[q]] = 1.0f / sqrtf(((s[0] + s[1]) + (s[2] + s[3])) * (1.0f / 2048.0f) + 1e-6f); }
    __syncthreads();
}
struct EpiProj {
    static constexpr bool PERM = true, AFTER_DRAIN = false, ROWPERM = false, PREFETCH = false;
    bf16_t* O; int ldc; const PG8_LAS float* rtab; const float* ropetab;
    __device__ __forceinline__ void operator()(const f32x4 (&acc)[2][2][4][2], const Unit& u, int wr, int wc, int fr, int fq) const {
        const int row0 = u.pm * BM + wr * 64 + fr, col0 = u.pn * BM + wc * 32 + 8 * fq;
        const bool rk = (ropetab != nullptr) && (wc == 0) && (u.pn == 10 || u.pn == 12);
#pragma unroll
        for (int ai = 0; ai < 2; ++ai) {
#pragma unroll
          for (int mp = 0; mp < 4; mp += 2) {
            f32x4 tt[2][4];
            if (rk) {
#pragma unroll
                for (int m = 0; m < 2; ++m)
#pragma unroll
                    for (int q = 0; q < 4; ++q) tt[m][q] = *(const f32x4*)(ropetab + (size_t)(row0 + ai * HALF + (mp + m) * 16) * 32 + 16 * (fq & 1) + 4 * q); }
#pragma unroll
            for (int m = mp; m < mp + 2; ++m) { const int row = row0 + ai * HALF + m * 16; bf16_t* rowp = O + (size_t)row * ldc + col0; const float s = rtab[u.idx * 256 + ai * HALF + wr * 64 + m * 16 + fr];
                f32x4 c0, s0, c1, s1;
                if (rk) { const f32x4 t0 = tt[m - mp][0], t1 = tt[m - mp][1], t2 = tt[m - mp][2], t3 = tt[m - mp][3];
                    const float sg = (fq < 2) ? -1.0f : 1.0f;
                    c0 = (f32x4){t0[0], t0[2], t1[0], t1[2]}; s0 = (f32x4){t0[1], t0[3], t1[1], t1[3]} * sg; c1 = (f32x4){t2[0], t2[2], t3[0], t3[2]}; s1 = (f32x4){t2[1], t2[3], t3[1], t3[3]} * sg; }
#pragma unroll
                for (int bj = 0; bj < 2; ++bj) { f32x4 v0 = acc[ai][bj][m][0] * s, v1 = acc[ai][bj][m][1] * s;
                    if (rk) { f32x4 p0, p1;
#pragma unroll
                        for (int j = 0; j < 4; ++j) { p0[j] = __shfl_xor(v0[j], 32); p1[j] = __shfl_xor(v1[j], 32); }
                        v0 = v0 * c0 + p0 * s0; v1 = v1 * c1 + p1 * s1; }
                    u32x4 w; w.x = cvt_pk_bf16(v0[0], v0[1]); w.y = cvt_pk_bf16(v0[2], v0[3]); w.z = cvt_pk_bf16(v1[0], v1[1]); w.w = cvt_pk_bf16(v1[2], v1[3]);
                    *(u32x4*)(rowp + bj * HALF) = w; } } } }
    }
};
struct EpiNull { static constexpr bool PERM = true, AFTER_DRAIN = false, ROWPERM = false, PREFETCH = false; float* sink;
    __device__ __forceinline__ void operator()(const f32x4 (&acc)[2][2][4][2], const Unit& u, int wr, int wc, int fr, int fq) const { if (sink) { f32x4 t = acc[0][0][0][0];
#pragma unroll
        for (int ai = 0; ai < 2; ++ai)
#pragma unroll
            for (int bj = 0; bj < 2; ++bj)
#pragma unroll
                for (int m = 0; m < 4; ++m)
#pragma unroll
                    for (int n = 0; n < 2; ++n) t += acc[ai][bj][m][n];
        *(f32x4*)(sink + (size_t)(u.pm * 32 + u.pn) * 4) = t; } } };
__device__ __forceinline__ float dpp_shr1(float x) { return __builtin_bit_cast(float, __builtin_amdgcn_update_dpp(0, __builtin_bit_cast(int, x), 0x111, 0xf, 0xf, false)); }
__device__ __forceinline__ f32x4 dpp_shr1_4(f32x4 x) { f32x4 r; r[0] = dpp_shr1(x[0]); r[1] = dpp_shr1(x[1]); r[2] = dpp_shr1(x[2]); r[3] = dpp_shr1(x[3]); return r; }
__device__ __forceinline__ f32x4 silu_mul4(f32x4 g, f32x4 v) { f32x4 e = g * (-1.4426950408889634f), d;
    d[0] = __builtin_amdgcn_exp2f(e[0]); d[1] = __builtin_amdgcn_exp2f(e[1]); d[2] = __builtin_amdgcn_exp2f(e[2]); d[3] = __builtin_amdgcn_exp2f(e[3]); d = d + 1.0f;
    f32x4 r; r[0] = __builtin_amdgcn_rcpf(d[0]); r[1] = __builtin_amdgcn_rcpf(d[1]); r[2] = __builtin_amdgcn_rcpf(d[2]); r[3] = __builtin_amdgcn_rcpf(d[3]); return (g * v) * r; }
struct EpiUp {
    static constexpr bool PERM = true, AFTER_DRAIN = false, ROWPERM = true, PREFETCH = true;
    bf16_t* ACT; float* USIDE; const float* cw; const float* cb; const PG8_LAS float* rtab;
    static constexpr int TAPS_F = 6 * 256;
    __device__ __forceinline__ void prefetch(const Unit& u, int wid, int lane) const {
        if (wid < 4) { constexpr int DFF_ = 5632, NUP_ = 11264; const int seg = 2 * wid + (lane >> 5), cg = u.pn * HALF + 4 * (lane & 31);
            const float* src = ((seg < 2) ? cb : cw + (size_t)((seg >> 1) - 1) * NUP_) + ((seg & 1) ? DFF_ : 0) + cg;
            __builtin_amdgcn_global_load_lds((const unsigned*)src, (PG8_LAS unsigned*)(rtab + TAPS_F + (u.idx & 1) * 1024 + wid * 256), 16, 0, 0); } }
    __device__ __forceinline__ void operator()(const f32x4 (&acc)[2][2][4][2], const Unit& u, int wr, int wc, int fr, int fq) const {
        constexpr int DFF_ = 5632, NUP_ = 11264;
        typedef unsigned u32x2 __attribute__((ext_vector_type(2)));
#pragma unroll
        for (int n = 0; n < 2; ++n) {
            const int cg = u.pn * HALF + wc * 32 + 8 * fq + 4 * n;
            const PG8_LAS float* tp = rtab + TAPS_F + (u.idx & 1) * 1024 + wc * 32 + 8 * fq + 4 * n;
            const f32x4 bg = *(const PG8_LAS f32x4*)(tp), bv = *(const PG8_LAS f32x4*)(tp + 128);
            const f32x4 wg0 = *(const PG8_LAS f32x4*)(tp + 256), wg1 = *(const PG8_LAS f32x4*)(tp + 512), wg2 = *(const PG8_LAS f32x4*)(tp + 768);
            const f32x4 wv0 = *(const PG8_LAS f32x4*)(tp + 384), wv1 = *(const PG8_LAS f32x4*)(tp + 640), wv2 = *(const PG8_LAS f32x4*)(tp + 896);
#pragma unroll
            for (int ai = 0; ai < 2; ++ai) {
                const int rl0 = ai * HALF + wr * 64 + 4 * fr, row0 = u.pm * BM + rl0;
                const f32x4 sc = *(const PG8_LAS f32x4*)(rtab + u.idx * 256 + rl0);
                const f32x4 g0 = acc[ai][0][0][n] * sc[0], g1 = acc[ai][0][1][n] * sc[1], g2 = acc[ai][0][2][n] * sc[2], g3 = acc[ai][0][3][n] * sc[3];
                const f32x4 v0 = acc[ai][1][0][n] * sc[0], v1 = acc[ai][1][1][n] * sc[1], v2 = acc[ai][1][2][n] * sc[2], v3 = acc[ai][1][3][n] * sc[3];
                const f32x4 gp3 = dpp_shr1_4(g3), gp2 = dpp_shr1_4(g2), vp3 = dpp_shr1_4(v3), vp2 = dpp_shr1_4(v2);
                if (fr == 15) { float* sp = USIDE + ((size_t)(row0 >> 6) * 4) * NUP_ + cg;
                    *(f32x4*)(sp) = g2; *(f32x4*)(sp + DFF_) = v2; *(f32x4*)(sp + NUP_) = g3; *(f32x4*)(sp + NUP_ + DFF_) = v3; }
                if (fr == 0) { float* sp = USIDE + ((size_t)(row0 >> 6) * 4 + 2) * NUP_ + cg;
                    *(f32x4*)(sp) = g0; *(f32x4*)(sp + DFF_) = v0; *(f32x4*)(sp + NUP_) = g1; *(f32x4*)(sp + NUP_ + DFF_) = v1; }
                const f32x4 a0 = silu_mul4(bg + wg0 * gp2 + wg1 * gp3 + wg2 * g0, bv + wv0 * vp2 + wv1 * vp3 + wv2 * v0);
                const f32x4 a1 = silu_mul4(bg + wg0 * gp3 + wg1 * g0 + wg2 * g1, bv + wv0 * vp3 + wv1 * v0 + wv2 * v1);
                const f32x4 a2 = silu_mul4(bg + wg0 * g0 + wg1 * g1 + wg2 * g2, bv + wv0 * v0 + wv1 * v1 + wv2 * v2);
                const f32x4 a3 = silu_mul4(bg + wg0 * g1 + wg1 * g2 + wg2 * g3, bv + wv0 * v1 + wv1 * v2 + wv2 * v3);
                bf16_t* op = ACT + (size_t)row0 * DFF_ + cg; u32x2 w;
                if (fr != 0) { w.x = cvt_pk_bf16(a0[0], a0[1]); w.y = cvt_pk_bf16(a0[2], a0[3]); *(u32x2*)(op) = w;
                               w.x = cvt_pk_bf16(a1[0], a1[1]); w.y = cvt_pk_bf16(a1[2], a1[3]); *(u32x2*)(op + DFF_) = w; }
                w.x = cvt_pk_bf16(a2[0], a2[1]); w.y = cvt_pk_bf16(a2[2], a2[3]); *(u32x2*)(op + 2 * DFF_) = w;
                w.x = cvt_pk_bf16(a3[0], a3[1]); w.y = cvt_pk_bf16(a3[2], a3[3]); *(u32x2*)(op + 3 * DFF_) = w;
            }
        }
    }
};
struct EpiRes {
    static constexpr bool PERM = true, AFTER_DRAIN = false, ROWPERM = false, PREFETCH = false;
    const float* basef; bf16_t* xb; float* ssp;
    __device__ __forceinline__ void operator()(const f32x4 (&acc)[2][2][4][2], const Unit& u, int wr, int wc, int fr, int fq) const {
        const int row0 = u.pm * BM + wr * 64 + fr, col0 = u.pn * BM + wc * 32 + 8 * fq;
        u32x4 pbv[2][4][2];
        if (!basef) {
#pragma unroll
            for (int ai = 0; ai < 2; ++ai)
#pragma unroll
                for (int m = 0; m < 4; ++m)
#pragma unroll
                    for (int bj = 0; bj < 2; ++bj) pbv[ai][m][bj] = *(const u32x4*)(xb + (size_t)(row0 + ai * HALF + m * 16) * 2048 + col0 + bj * HALF);
        }
#pragma unroll
        for (int ai = 0; ai < 2; ++ai)
#pragma unroll
            for (int m = 0; m < 4; ++m) { const int row = row0 + ai * HALF + m * 16; const size_t off = (size_t)row * 2048 + col0; float ss = 0.f;
#pragma unroll
                for (int bj = 0; bj < 2; ++bj) { f32x4 b0, b1;
                    if (basef) { b0 = *(const f32x4*)(basef + off + bj * HALF); b1 = *(const f32x4*)(basef + off + bj * HALF + 4); }
                    else { const u32x4 pb = pbv[ai][m][bj];
                        b0 = (f32x4){__builtin_bit_cast(float, pb.x << 16), __builtin_bit_cast(float, pb.x & 0xffff0000u), __builtin_bit_cast(float, pb.y << 16), __builtin_bit_cast(float, pb.y & 0xffff0000u)};
                        b1 = (f32x4){__builtin_bit_cast(float, pb.z << 16), __builtin_bit_cast(float, pb.z & 0xffff0000u), __builtin_bit_cast(float, pb.w << 16), __builtin_bit_cast(float, pb.w & 0xffff0000u)}; }
                    const f32x4 v0 = acc[ai][bj][m][0] + b0, v1 = acc[ai][bj][m][1] + b1;
                    ss += (v0[0] * v0[0] + v0[1] * v0[1]) + (v0[2] * v0[2] + v0[3] * v0[3]) + (v1[0] * v1[0] + v1[1] * v1[1]) + (v1[2] * v1[2] + v1[3] * v1[3]);
                    u32x4 w; w.x = cvt_pk_bf16(v0[0], v0[1]); w.y = cvt_pk_bf16(v0[2], v0[3]); w.z = cvt_pk_bf16(v1[0], v1[1]); w.w = cvt_pk_bf16(v1[2], v1[3]);
                    *(u32x4*)(xb + off + bj * HALF) = w; }
                ss += __shfl_xor(ss, 16); ss += __shfl_xor(ss, 32);
                if (fq == 0) ssp[(size_t)(u.pn * 4 + wc) * EP_ROWS + row] = ss; }
    }
};
template <class Epi, class Sched, bool ALIGN_EPI = false, bool SP2 = false>
__device__ __forceinline__ void gemm_phase(PG8_LAS unsigned char* lds, const Gemm g, const Sched& S, const Epi& E) {
    int tid_; { unsigned z_ = 0u; asm volatile("" : "+v"(z_)); tid_ = (g.wv << 6) | (int)__builtin_amdgcn_mbcnt_hi(~0u, __builtin_amdgcn_mbcnt_lo(~0u, z_)); } asm volatile("" : "+v"(tid_));
    const int tid = tid_, wid = __builtin_amdgcn_readfirstlane(tid >> 6), lane = tid & 63, wr = wid >> 2, wc = wid & 3, fr = lane & 15, fq = lane >> 4;
    const int K = g.K, nt = K / BK;
    unsigned voffA[2], voffB[2];
#pragma unroll
    for (int i = 0; i < 2; ++i) { int R, C; stage_rc(tid * 16 + i * 8192, R, C); const int Rb = Epi::PERM ? ((R & ~31) + perm32(R & 31)) : R;
        const int Ra = Epi::ROWPERM ? ((R & 64) + 4 * (R & 15) + ((R >> 4) & 3)) : R;
        voffA[i] = (unsigned)(Ra * K + C) * 2u; voffB[i] = (unsigned)(Rb * K + C) * 2u; }
    const size_t kstep = (size_t)(BK * 2);
    const size_t hstep = (size_t)HALF * K * 2;
    const size_t tstep = 2 * hstep;
    const unsigned ldsw = (unsigned)wid * 1024u;
    const int aoff = lds_byte(wr * 64 + fr, fq * 8), boff = lds_byte(wc * 32 + fr, fq * 8);
#define PG8_SA(b, h) (((b) * 2 + (h)) * HTB)
#define PG8_SB(b, h) ((4 + (b) * 2 + (h)) * HTB)
#define PG8_STAGE(bufoff, gbase, voff) do { _Pragma("unroll") for (int _i = 0; _i < 2; ++_i) \
        __builtin_amdgcn_global_load_lds((const unsigned*)((const char*)(gbase) + (voff)[_i]), (PG8_LAS unsigned*)(lds + (bufoff) + ldsw + _i * 8192), 16, 0, 0); } while (0)
#define PG8_LDA(dst, b, h) do { _Pragma("unroll") for (int m = 0; m < 4; ++m) _Pragma("unroll") for (int k = 0; k < 2; ++k) dst[m][k] = *(const PG8_LAS bf16x8*)(lds + PG8_SA(b, h) + aoff + m * 2048 + k * 1024); } while (0)
#define PG8_LDB(dst, b, h) do { _Pragma("unroll") for (int n = 0; n < 2; ++n) _Pragma("unroll") for (int k = 0; k < 2; ++k) dst[n][k] = *(const PG8_LAS bf16x8*)(lds + PG8_SB(b, h) + boff + n * 2048 + k * 1024); } while (0)
#define PG8_MMA(ai, bj, At, Bt) do { __builtin_amdgcn_s_setprio(1); _Pragma("unroll") for (int m = 0; m < 4; ++m) _Pragma("unroll") for (int n = 0; n < 2; ++n) _Pragma("unroll") for (int k = 0; k < 2; ++k) \
        acc[ai][bj][m][n] = __builtin_amdgcn_mfma_f32_16x16x32_bf16(Bt[n][k], At[m][k], acc[ai][bj][m][n], 0, 0, 0); __builtin_amdgcn_s_setprio(0); } while (0)
#define PG8_WAIT_V(n) asm volatile("s_waitcnt vmcnt(" #n ")" ::: "memory")
#define PG8_WAIT_L(n) asm volatile("s_waitcnt lgkmcnt(" #n ")" ::: "memory")
#define PG8_BAR __builtin_amdgcn_s_barrier()
#define PG8_SCHED __builtin_amdgcn_sched_barrier(0)
    Unit cur, nxt; int ui = 0;
    if (!S.next(0, cur)) return;
    f32x4 acc[2][2][4][2];
#pragma unroll
    for (int a = 0; a < 2; ++a)
#pragma unroll
        for (int b = 0; b < 2; ++b)
#pragma unroll
            for (int m = 0; m < 4; ++m)
#pragma unroll
                for (int n = 0; n < 2; ++n) acc[a][b][m][n] = (f32x4){0.f, 0.f, 0.f, 0.f};
    bf16x8 At[4][2], B0[2][2], B1[2][2];
    const char* cA = (const char*)g.A + (size_t)cur.pm * tstep; const char* cB = (const char*)g.Bt + (size_t)cur.pn * tstep;
    S.a_ready(cur);
    if constexpr (SP2) {
        PG8_STAGE(PG8_SB(0, 0), cB, voffB); PG8_STAGE(PG8_SB(0, 1), cB + hstep, voffB); PG8_STAGE(PG8_SA(0, 0), cA, voffA); PG8_STAGE(PG8_SA(0, 1), cA + hstep, voffA);
        if (wr == 1) PG8_BAR;
        PG8_WAIT_V(2); PG8_BAR;
        PG8_STAGE(PG8_SB(1, 0), cB + kstep, voffB); PG8_STAGE(PG8_SA(1, 0), cA + kstep, voffA); PG8_STAGE(PG8_SB(1, 1), cB + hstep + kstep, voffB);
        PG8_WAIT_V(6); PG8_BAR;
    } else {
        PG8_STAGE(PG8_SB(0, 0), cB, voffB); PG8_STAGE(PG8_SA(0, 0), cA, voffA); PG8_STAGE(PG8_SB(0, 1), cB + hstep, voffB); PG8_STAGE(PG8_SA(0, 1), cA + hstep, voffA);
        if (wr == 1) PG8_BAR;
        PG8_WAIT_V(4); PG8_BAR;
        PG8_STAGE(PG8_SB(1, 0), cB + kstep, voffB); PG8_STAGE(PG8_SA(1, 0), cA + kstep, voffA); PG8_STAGE(PG8_SB(1, 1), cB + hstep + kstep, voffB);
        PG8_WAIT_V(6); PG8_BAR;
    }
    for (;;) {
        const bool has_next = S.next(ui + 1, nxt);
        const char* nA = has_next ? (const char*)g.A + (size_t)nxt.pm * tstep : cA; const char* nB = has_next ? (const char*)g.Bt + (size_t)nxt.pn * tstep : cB;
        if constexpr (Epi::PREFETCH) E.prefetch(cur, wid, lane);
        for (int t = 0; t < nt; t += 2) {
            const bool last = (t == nt - 2);
            const char* a1 = cA + (size_t)(t + 1) * kstep;
            const char* a2 = last ? nA : cA + (size_t)(t + 2) * kstep; const char* b2 = last ? nB : cB + (size_t)(t + 2) * kstep;
            const char* a3 = a2 + kstep; const char* b3 = b2 + kstep;
            if (last && has_next) S.a_ready(nxt);
            if constexpr (SP2) {
            PG8_LDB(B0, 0, 0); PG8_LDB(B1, 0, 1); PG8_SCHED; PG8_LDA(At, 0, 0); PG8_STAGE(PG8_SA(1, 1), a1 + hstep, voffA);
            PG8_WAIT_V(8); PG8_WAIT_L(0); PG8_BAR; PG8_MMA(0, 0, At, B0); PG8_MMA(0, 1, At, B1); PG8_BAR; PG8_SCHED;
            PG8_LDA(At, 0, 1); PG8_STAGE(PG8_SB(0, 0), b2, voffB); PG8_STAGE(PG8_SB(0, 1), b2 + hstep, voffB); PG8_STAGE(PG8_SA(0, 0), a2, voffA);
            PG8_WAIT_V(8); PG8_WAIT_L(0); PG8_BAR; PG8_MMA(1, 0, At, B0); PG8_MMA(1, 1, At, B1); PG8_BAR; PG8_SCHED;
            PG8_LDB(B0, 1, 0); PG8_LDB(B1, 1, 1); PG8_SCHED; PG8_LDA(At, 1, 0); PG8_STAGE(PG8_SA(0, 1), a2 + hstep, voffA);
            PG8_WAIT_V(8); PG8_WAIT_L(0); PG8_BAR; PG8_MMA(0, 0, At, B0); PG8_MMA(0, 1, At, B1); PG8_BAR; PG8_SCHED;
            PG8_LDA(At, 1, 1); PG8_STAGE(PG8_SB(1, 0), b3, voffB); PG8_STAGE(PG8_SB(1, 1), b3 + hstep, voffB); PG8_STAGE(PG8_SA(1, 0), a3, voffA);
            PG8_WAIT_V(8); PG8_WAIT_L(0); PG8_BAR; PG8_MMA(1, 0, At, B0); PG8_MMA(1, 1, At, B1); PG8_BAR; PG8_SCHED;
            } else {
            PG8_LDB(B0, 0, 0); PG8_SCHED; PG8_LDA(At, 0, 0); PG8_STAGE(PG8_SA(1, 1), a1 + hstep, voffA);
            PG8_WAIT_L(8); PG8_BAR; PG8_WAIT_L(0); PG8_MMA(0, 0, At, B0); PG8_BAR; PG8_SCHED;
            PG8_LDB(B1, 0, 1); PG8_STAGE(PG8_SB(0, 0), b2, voffB);
            PG8_BAR; PG8_WAIT_L(0); PG8_MMA(0, 1, At, B1); PG8_BAR;
            PG8_LDA(At, 0, 1); PG8_STAGE(PG8_SA(0, 0), a2, voffA);
            PG8_BAR; PG8_WAIT_L(0); PG8_MMA(1, 0, At, B0); PG8_BAR; PG8_SCHED;
            PG8_STAGE(PG8_SB(0, 1), b2 + hstep, voffB);
            PG8_WAIT_V(6); PG8_BAR; PG8_MMA(1, 1, At, B1); PG8_BAR;
            PG8_LDB(B0, 1, 0); PG8_SCHED; PG8_LDA(At, 1, 0); PG8_STAGE(PG8_SA(0, 1), a2 + hstep, voffA);
            PG8_WAIT_L(8); PG8_BAR; PG8_WAIT_L(0); PG8_MMA(0, 0, At, B0); PG8_BAR; PG8_SCHED;
            PG8_LDB(B1, 1, 1); PG8_STAGE(PG8_SB(1, 0), b3, voffB);
            PG8_BAR; PG8_WAIT_L(0); PG8_MMA(0, 1, At, B1); PG8_BAR;
            PG8_LDA(At, 1, 1); PG8_STAGE(PG8_SA(1, 0), a3, voffA);
            PG8_BAR; PG8_WAIT_L(0); PG8_MMA(1, 0, At, B0); PG8_BAR; PG8_SCHED;
            PG8_STAGE(PG8_SB(1, 1), b3 + hstep, voffB);
            PG8_WAIT_V(6); PG8_BAR; PG8_MMA(1, 1, At, B1); PG8_BAR;
            }
        }
        if constexpr (ALIGN_EPI) { if (wr == 0) PG8_BAR; }
        if constexpr (!Epi::AFTER_DRAIN) { E(acc, cur, wr, wc, fr, fq); S.done(cur); }
        if (!has_next) break;
#pragma unroll
        for (int a = 0; a < 2; ++a)
#pragma unroll
            for (int b = 0; b < 2; ++b)
#pragma unroll
                for (int m = 0; m < 4; ++m)
#pragma unroll
                    for (int n = 0; n < 2; ++n) acc[a][b][m][n] = (f32x4){0.f, 0.f, 0.f, 0.f};
        cur = nxt; cA = nA; cB = nB; ++ui;
        if constexpr (ALIGN_EPI) { if (wr == 1) PG8_BAR; }
    }
    PG8_WAIT_V(0);
    if constexpr (!ALIGN_EPI) { if (wr == 0) PG8_BAR; }
    PG8_BAR;
    if constexpr (Epi::AFTER_DRAIN) { E.fused(acc, cur, wr, wc, fr, fq, lds, wid, lane); S.done(cur); }
#undef PG8_SA
#undef PG8_SB
#undef PG8_STAGE
#undef PG8_LDA
#undef PG8_LDB
#undef PG8_MMA
#undef PG8_WAIT_V
#undef PG8_WAIT_L
#undef PG8_BAR
#undef PG8_SCHED
}
}
#ifndef MK_ONE_LAUNCH
#define MK_ONE_LAUNCH 1
#endif
constexpr int NWAVES = 8, NTHREADS = 512;
constexpr int NB = 4, SEQ = 2048, DM = 2048, MROWS = NB * SEQ, DEPTH = 4;
constexpr int NSA_N = 3632, NSA_NP = 3840;
constexpr int PC_Q = 0, PC_KVC = 2048, PC_KVS = 2560, PC_KVW = 3072, PC_GATE = 3584;
constexpr int ML_N = 6160, ML_NP = 6144;
constexpr int MC_Q = 0, MC_K = 1024, MC_V = 2048, MC_OG = 4096;
constexpr int DFF = 5632, NUP = 2 * DFF;
constexpr int NCMP = 127;
constexpr float ATT_SCALE = 0.08838834764831845f;
constexpr size_t al256(size_t x) { return (x + 255) & ~(size_t)255; }
constexpr size_t WS_CTL = 0, CTL_BYTES = 1u << 20;
constexpr size_t SZ_WNSA = (size_t)NSA_NP * DM * 2, SZ_WML = (size_t)ML_NP * DM * 2, SZ_WOUT = (size_t)DM * DM * 2, SZ_WUP = (size_t)NUP * DM * 2, SZ_WDN = (size_t)DM * DFF * 2;
constexpr size_t WS_WNSA = WS_CTL + CTL_BYTES;
constexpr size_t WS_WML = WS_WNSA + 2 * SZ_WNSA;
constexpr size_t WS_WOUT = WS_WML + 2 * SZ_WML;
constexpr size_t WS_WUP = WS_WOUT + 4 * SZ_WOUT;
constexpr size_t WS_WDN = WS_WUP + 4 * SZ_WUP;
constexpr size_t WS_XR = WS_WDN + 4 * SZ_WDN;
constexpr size_t WS_XB = WS_XR + (size_t)MROWS * DM * 4;
constexpr size_t WS_SSP = WS_XB + (size_t)MROWS * DM * 2;
constexpr size_t WS_P = WS_SSP + (size_t)32 * MROWS * 4;
constexpr size_t WS_QR = WS_P + (size_t)MROWS * ML_NP * 2;
constexpr size_t WS_KC = WS_QR + (size_t)MROWS * DM * 2;
constexpr size_t WS_VC = WS_KC + (size_t)NB * 2 * 128 * 128 * 4;
constexpr size_t WS_O = WS_VC + (size_t)NB * 2 * 128 * 128 * 4;
constexpr size_t WS_U = WS_O + (size_t)MROWS * DM * 2;
constexpr size_t WS_ACT = WS_U + (size_t)MROWS * NUP * 2;
constexpr size_t WS_ROPE = WS_ACT + (size_t)MROWS * DFF * 2;
constexpr size_t WS_GATES = WS_ROPE + (size_t)MROWS * 32 * 4;
constexpr size_t WS_HRAW = WS_GATES + (size_t)MROWS * 16 * 4;
constexpr size_t WS_HSS = WS_HRAW + (size_t)MROWS * DM * 4;
constexpr size_t WS_W1T = WS_HSS + (size_t)MROWS * 64 * 4;
constexpr size_t WS_W2T = WS_W1T + (size_t)2 * 2 * 32 * 128 * 128 * 2;
constexpr size_t WS_WGT = WS_W2T + (size_t)2 * 2 * 128 * 128 * 2;
constexpr size_t WS_END = WS_WGT + (size_t)2 * 16 * DM * 2;
constexpr int CW_BAR = 4096;
constexpr int RING_BYTES = 131072, LDS_BYTES = 163840, MISC_OFF = LDS_BYTES - 256, RSTD_OFF = 135168;

#define GAS __attribute__((address_space(1)))
#define LAS __attribute__((address_space(3)))
typedef unsigned short bf16;
typedef unsigned v4u __attribute__((ext_vector_type(4)));
typedef unsigned v2u __attribute__((ext_vector_type(2)));
typedef float f32x4 __attribute__((ext_vector_type(4)));
typedef float f32x2 __attribute__((ext_vector_type(2)));
#define LDS_WAIT() asm volatile("s_waitcnt lgkmcnt(0)" ::: "memory")
__device__ __forceinline__ unsigned f2bf(float f) { unsigned u = __builtin_bit_cast(unsigned, f); return (u + 0x7fffu + ((u >> 16) & 1u)) >> 16; }
__device__ __forceinline__ unsigned pk2(float lo, float hi) { return f2bf(lo) | (f2bf(hi) << 16); }
__device__ __forceinline__ float bf2f(unsigned short b) { return __builtin_bit_cast(float, (unsigned)b << 16); }
__device__ __forceinline__ float bflo(unsigned w) { return __builtin_bit_cast(float, w << 16); }
__device__ __forceinline__ float bfhi(unsigned w) { return __builtin_bit_cast(float, w & 0xffff0000u); }
__device__ __forceinline__ int hw_lane() { unsigned z = 0u; asm volatile("" : "+v"(z)); return (int)__builtin_amdgcn_mbcnt_hi(~0u, __builtin_amdgcn_mbcnt_lo(~0u, z)); }
__device__ __forceinline__ float wave_sum(float v) {
#pragma unroll
    for (int o = 1; o < 64; o <<= 1) v += __shfl_xor(v, o);
    return v;
}
__device__ __forceinline__ float wave_max(float v) {
#pragma unroll
    for (int o = 1; o < 64; o <<= 1) v = fmaxf(v, __shfl_xor(v, o));
    return v;
}
__device__ __forceinline__ float sigmoidf_(float x) { return 1.0f / (1.0f + __expf(-x)); }
__device__ __forceinline__ float tanhf_(float y) { return 1.0f - 2.0f / (__expf(2.0f * y) + 1.0f); }
#define XB_TMO      128
#define XB_XCNT(j)  (256  + 64 * (j))
#define XB_XSUB(j)  (1280 + 64 * (j))
#define XB_XGEN(j)  (2304 + 64 * (j))
#define XB_TOP      3328
#define XB_TOPGEN   3392
#define XCD_BAR_WORDS 3456
#define XB_SPIN_CAP (1u << 18)

__device__ __forceinline__ unsigned xb_ld(unsigned* p)              { return __hip_atomic_load(p, __ATOMIC_RELAXED, __HIP_MEMORY_SCOPE_AGENT); }
__device__ __forceinline__ unsigned xb_add(unsigned* p, unsigned v) { return __hip_atomic_fetch_add(p, v, __ATOMIC_RELAXED, __HIP_MEMORY_SCOPE_AGENT); }
__device__ __forceinline__ unsigned xb_xcc_id() { return (unsigned)__builtin_amdgcn_s_getreg((3 << 11) | 20) & 0xFu; }
#define XB_SPIN(cond, bar) do { unsigned _sp = 0; while (cond) { __builtin_amdgcn_s_sleep(1); \
    if ((++_sp & 255u) == 0u) { if (xb_ld(&(bar)[XB_TMO])) break; if (_sp > XB_SPIN_CAP) { atomicAdd(&(bar)[XB_TMO], 1u); break; } } } } while (0)

struct XcdBarrier {
    unsigned* bar; unsigned x; int wv;
    volatile LAS unsigned* st;
};

__device__ __forceinline__ bool xb_thread0(int wv) { return wv == 0 && hw_lane() == 0; }
__device__ __forceinline__ XcdBarrier xcd_barrier_post(unsigned* bar, volatile LAS unsigned* st, int wv) {
    XcdBarrier b; b.bar = bar; b.x = xb_xcc_id(); b.st = st; b.wv = wv;
    if (xb_thread0(wv)) (void)xb_add(&bar[XB_XCNT(b.x)], 1u);
    return b;
}
__device__ __forceinline__ void xcd_barrier_complete(unsigned* bar, unsigned x, unsigned& nloc, unsigned& nx) {
    const unsigned G = gridDim.x * gridDim.y * gridDim.z;
    unsigned sum, cnt, mine, sp = 0u;
    for (;;) {
        sum = 0u; cnt = 0u; mine = 0u;
#pragma unroll
        for (unsigned j = 0; j < 16; ++j) { const unsigned c = xb_ld(&bar[XB_XCNT(j)]); sum += c; cnt += (c > 0u) ? 1u : 0u; mine = (j == x) ? c : mine; }
        if (sum == G) break;
        __builtin_amdgcn_s_sleep(1);
        if ((++sp & 255u) == 0u) { if (xb_ld(&bar[XB_TMO])) break; if (sp > XB_SPIN_CAP) { atomicAdd(&bar[XB_TMO], 1u); break; } }
    }
    nloc = mine > 0u ? mine : 1u; nx = cnt > 0u ? cnt : 1u;
}

__device__ __forceinline__ void xcd_barrier(const XcdBarrier& b) {
    asm volatile("s_waitcnt vmcnt(0)" ::: "memory");
    __syncthreads();
    if (xb_thread0(b.wv)) {
        unsigned* bar = b.bar;
        __builtin_amdgcn_s_waitcnt(0);
        unsigned nloc = b.st[0], nx = b.st[1];
        if (nloc == 0u) { xcd_barrier_complete(bar, b.x, nloc, nx); b.st[0] = nloc; b.st[1] = nx; }
        const unsigned old = xb_add(&bar[XB_XSUB(b.x)], 1u);
        const unsigned gen = old / nloc;
        if (old + 1u == (gen + 1u) * nloc) {
            __builtin_amdgcn_fence(__ATOMIC_RELEASE, "agent");
            asm volatile("s_waitcnt vmcnt(0)" ::: "memory");
            const unsigned og = xb_add(&bar[XB_TOP], 1u);
            const unsigned tg = og / nx;
            if (og + 1u == (tg + 1u) * nx) xb_add(&bar[XB_TOPGEN], 1u);
            else XB_SPIN(xb_ld(&bar[XB_TOPGEN]) == tg, bar);
            __builtin_amdgcn_fence(__ATOMIC_ACQUIRE, "agent");
            xb_add(&bar[XB_XGEN(b.x)], 1u);
            asm volatile("s_waitcnt vmcnt(0)" ::: "memory");
        } else {
            XB_SPIN(xb_ld(&bar[XB_XGEN(b.x)]) == gen, bar);
            __builtin_amdgcn_fence(__ATOMIC_ACQUIRE, "agent");
            asm volatile("s_waitcnt vmcnt(0)" ::: "memory");
        }
    }
    __syncthreads();
}
__constant__ double c_rope_inv[16] = {1.0, 0.44036660267178046, 0.19392274474868576, 0.08539710028576561, 0.03760603093086393, 0.016560440080994446, 0.007292664737217109, 0.003211445994752591,
    0.001414213562373095, 0.000622772421914596, 0.0002742481756762073, 0.00012076973741146504, 5.318295896944988e-05, 2.341999896140934e-05, 1.031338537721246e-05, 4.5416704806078695e-06};

__device__ __forceinline__ void cvt_item(const float* W, int ldw, int nvalid, const float* gain, bf16* WT, int K, int npad, int mode, LAS float* scr, int item, int lane) {
    const int nblk = npad / 64, kb = item / nblk, nb = item - kb * nblk, k0 = 64 * kb, n0 = 64 * nb;
    const int kl = lane >> 4, nl = (lane & 15) * 4; const bool ok = (n0 + nl) < nvalid;
    f32x4 v[16]; const int c = lane & 7;
    const int ncol = ok ? n0 + nl : 0;
#pragma unroll
    for (int i = 0; i < 16; ++i) v[i] = *(const GAS f32x4*)(W + (size_t)(k0 + kl + 4 * i) * ldw + ncol);
    if (!ok) {
#pragma unroll
        for (int i = 0; i < 16; ++i) v[i] = (f32x4){0.f, 0.f, 0.f, 0.f}; }
#pragma unroll
    for (int i = 0; i < 16; ++i) { const int kk = kl + 4 * i; LAS float* d = scr + kk * 65 + nl; d[0] = v[i].x; d[1] = v[i].y; d[2] = v[i].z; d[3] = v[i].w; }
    f32x4 g0 = (f32x4){1.f, 1.f, 1.f, 1.f}, g1 = g0;
    if (gain) { g0 = *(const f32x4*)(gain + k0 + 8 * c); g1 = *(const f32x4*)(gain + k0 + 8 * c + 4); }
    LDS_WAIT(); asm volatile("" ::: "memory");
#pragma unroll
    for (int j = 0; j < 8; ++j) { const int n = (lane >> 3) + 8 * j; const LAS float* sp = scr + (8 * c) * 65 + n;
        v4u o; o.x = pk2(sp[0 * 65] * g0.x, sp[1 * 65] * g0.y); o.y = pk2(sp[2 * 65] * g0.z, sp[3 * 65] * g0.w); o.z = pk2(sp[4 * 65] * g1.x, sp[5 * 65] * g1.y); o.w = pk2(sp[6 * 65] * g1.z, sp[7 * 65] * g1.w);
        const int nn = n0 + n; int row = nn;
        if (mode == 1) { row = (nn < DFF) ? (256 * (nn >> 7) + (nn & 127)) : (256 * ((nn - DFF) >> 7) + 128 + ((nn - DFF) & 127)); }
        *(GAS v4u*)(WT + (size_t)row * K + k0 + 8 * c) = o; }
    LDS_WAIT(); asm volatile("" ::: "memory");
}

struct Ptrs {
    const float *x; const int* pos;
    const float *nsa_w_in, *nsa_gate_b, *nsa_pe, *nsa_w1, *nsa_w2, *nsa_w_out;
    const float *ml_w_in, *ml_gate_b, *ml_head_norm, *ml_w_out;
    const float *norm_mix, *norm_ffn, *w_up, *conv_w, *conv_b, *w_down, *norm_final;
    float* out; unsigned char* ws;
};

constexpr int CV_NSA_IN = 32 * (NSA_NP / 64), CV_ML_IN = 32 * (ML_NP / 64), CV_OUT = 32 * 32, CV_UP = 32 * (NUP / 64), CV_DN = (DFF / 64) * 32;
__device__ __forceinline__ int cv_layer_items(int layer) { return ((layer & 1) ? CV_ML_IN : CV_NSA_IN) + CV_OUT + CV_UP + CV_DN; }
__device__ __forceinline__ void convert_layer(const Ptrs& A, int layer, int it_lo, int it_hi, int rank, int nranks, LAS float* scr, int lane) {
    const bool ml = layer & 1; const int jl = layer >> 1; const int n_in = ml ? CV_ML_IN : CV_NSA_IN;
    for (int it = it_lo + rank; it < it_hi; it += nranks) {
        if (it < n_in) {
            if (ml) cvt_item(A.ml_w_in + (size_t)jl * DM * ML_N, ML_N, ML_NP, A.norm_mix + (size_t)layer * DM, (bf16*)(A.ws + WS_WML + jl * SZ_WML), DM, ML_NP, 0, scr, it, lane);
            else cvt_item(A.nsa_w_in + (size_t)jl * DM * NSA_N, NSA_N, NSA_N, A.norm_mix + (size_t)layer * DM, (bf16*)(A.ws + WS_WNSA + jl * SZ_WNSA), DM, NSA_NP, 0, scr, it, lane);
        } else if (it < n_in + CV_OUT) cvt_item((ml ? A.ml_w_out : A.nsa_w_out) + (size_t)jl * DM * DM, DM, DM, nullptr, (bf16*)(A.ws + WS_WOUT + layer * SZ_WOUT), DM, DM, 0, scr, it - n_in, lane);
        else if (it < n_in + CV_OUT + CV_UP) cvt_item(A.w_up + (size_t)layer * DM * NUP, NUP, NUP, A.norm_ffn + (size_t)layer * DM, (bf16*)(A.ws + WS_WUP + layer * SZ_WUP), DM, NUP, 1, scr, it - n_in - CV_OUT, lane);
        else cvt_item(A.w_down + (size_t)layer * DFF * DM, DM, DM, nullptr, (bf16*)(A.ws + WS_WDN + layer * SZ_WDN), DFF, DM, 0, scr, it - n_in - CV_OUT - CV_UP, lane);
    }
}
#ifndef CV_TAIL_PCT
#define CV_TAIL_PCT 35
#endif
__device__ __forceinline__ int cv_tail_items(int layer, int G) { const int nwg = (MROWS / 256) * (NUP / 256); const int idle = (nwg % G) ? G - nwg % G : 0; return (layer >= 1 && idle >= 64) ? (int)((long)cv_layer_items(layer) * CV_TAIL_PCT / 100) : 0; }

#ifndef CV_SLOT_ITEMS
#define CV_SLOT_ITEMS 2800
#endif
__device__ __forceinline__ int cv_slot_items(int layer, int G) { return (!(layer & 1) && G >= 128) ? CV_SLOT_ITEMS : 0; }
#ifndef CV_INSLOT_ITEMS
#define CV_INSLOT_ITEMS 2048
#endif
__device__ __forceinline__ int cv_inslot_items(int layer, int G) { return ((layer & 1) && G == 256) ? CV_INSLOT_ITEMS : 0; }

__device__ __forceinline__ void phase_prologue(const Ptrs& A, LAS unsigned char* lds, int G, int vcu, int wave, int lane, int tid) {
    LAS float* scr = (LAS float*)(lds + wave * 16640);
    const int gw = vcu * NWAVES + wave, NGW = G * NWAVES;
    for (int layer = 0; layer < DEPTH; ++layer) convert_layer(A, layer, cv_tail_items(layer, G) + cv_inslot_items(layer, G), cv_layer_items(layer) - cv_slot_items(layer, G), gw, NGW, scr, lane);
    for (int it = gw; it < 132 * 4; it += NGW) { const int m = it >> 2;
        if (m < 128) cvt_item(A.nsa_w1 + (size_t)m * 128 * 128, 128, 128, nullptr, (bf16*)(A.ws + WS_W1T) + (size_t)m * 128 * 128, 128, 128, 0, scr, it & 3, lane);
        else cvt_item(A.nsa_w2 + (size_t)(m - 128) * 128 * 128, 128, 128, nullptr, (bf16*)(A.ws + WS_W2T) + (size_t)(m - 128) * 128 * 128, 128, 128, 0, scr, it & 3, lane); }
    for (int idx = vcu * NTHREADS + tid; idx < 2 * 16 * DM; idx += G * NTHREADS) { const int k = idx & (DM - 1), c = (idx >> 11) & 15, j = idx >> 15;
        ((bf16*)(A.ws + WS_WGT))[idx] = (bf16)f2bf(A.ml_w_in[((size_t)j * DM + k) * ML_N + ML_NP + c] * A.norm_mix[(size_t)(2 * j + 1) * DM + k]); }
    bf16* XB = (bf16*)(A.ws + WS_XB); float* SSP = (float*)(A.ws + WS_SSP);
    for (int m = gw; m < MROWS; m += NGW) {
        const GAS f32x4* xr = (const GAS f32x4*)(A.x + (size_t)m * DM) + lane; float s = 0.f;
        GAS v2u* o8 = (GAS v2u*)(XB + (size_t)m * DM) + lane;
#pragma unroll
        for (int j = 0; j < 8; ++j) { const f32x4 v = xr[64 * j]; s += (v.x * v.x + v.y * v.y) + (v.z * v.z + v.w * v.w); v2u w; w.x = pk2(v.x, v.y); w.y = pk2(v.z, v.w); o8[64 * j] = w; }
        s = wave_sum(s);
        if (lane < 32) SSP[(size_t)lane * MROWS + m] = (lane == 0) ? s : 0.f;
    }
    float* ROPE = (float*)(A.ws + WS_ROPE);
    for (int idx = (vcu * NTHREADS + tid); idx < MROWS * 16; idx += G * NTHREADS) {
        const int row = idx >> 4, i = idx & 15; const double rev = (double)A.pos[row] * c_rope_inv[i] * 0.15915494309189535; const float fr = (float)(rev - floor(rev));
        ROPE[2 * idx] = __builtin_amdgcn_cosf(fr); ROPE[2 * idx + 1] = __builtin_amdgcn_sinf(fr);
    }
}

__device__ __forceinline__ void phase_ml_gates(const Ptrs& A, int j, int layer, int G, int vcu, int wave, int lane) {
    typedef short bf16x8 __attribute__((ext_vector_type(8)));
    const bf16* WG = (const bf16*)(A.ws + WS_WGT) + (size_t)j * 16 * DM; const float* gb = A.ml_gate_b + (size_t)j * 16;
    const bf16* XB = (const bf16*)(A.ws + WS_XB); const float* SSP = (const float*)(A.ws + WS_SSP); float* GT = (float*)(A.ws + WS_GATES);
    const int gw = vcu * NWAVES + wave, NGW = G * NWAVES, r16 = lane & 15, kq = lane >> 4;
    for (int r0 = gw * 16; r0 < MROWS; r0 += NGW * 16) {
        f32x4 acc = (f32x4){0.f, 0.f, 0.f, 0.f};
        const bf16* ap = XB + (size_t)(r0 + r16) * DM + 8 * kq; const bf16* bp = WG + (size_t)r16 * DM + 8 * kq;
#pragma unroll 1
        for (int k8 = 0; k8 < 64; k8 += 8) { bf16x8 af[8], bfv[8];
#pragma unroll
            for (int i = 0; i < 8; ++i) { af[i] = *(const bf16x8*)(ap + 32 * (k8 + i)); bfv[i] = *(const bf16x8*)(bp + 32 * (k8 + i)); }
#pragma unroll
            for (int i = 0; i < 8; ++i) acc = __builtin_amdgcn_mfma_f32_16x16x32_bf16(af[i], bfv[i], acc, 0, 0, 0); }
        float ss = 0.f;
        { float sp[8];
#pragma unroll
          for (int p = 0; p < 8; ++p) sp[p] = SSP[(size_t)(8 * kq + p) * MROWS + r0 + r16];
          ss = ((sp[0] + sp[1]) + (sp[2] + sp[3])) + ((sp[4] + sp[5]) + (sp[6] + sp[7])); }
        ss += __shfl_xor(ss, 16); ss += __shfl_xor(ss, 32);
        const float rstd = 1.0f / sqrtf(ss * (1.0f / 2048.0f) + 1e-6f);
        const float bias = gb[r16];
#pragma unroll
        for (int e = 0; e < 4; ++e) { const int row = 4 * kq + e; const float rs = __shfl(rstd, row);
            const float pre = acc[e] * rs + bias; const float z = 15.0f * tanhf_(pre * (1.0f / 15.0f));
            float o;
            if (r16 < 8) o = z; else o = (z > 0.f) ? -__logf(1.0f + __expf(-z)) : (z - __logf(1.0f + __expf(z)));
            GT[(size_t)(r0 + row) * 16 + r16] = o; }
    }
}

__device__ __forceinline__ void rope_pair(v4u a, v4u b, const float* cs, v4u& oa, v4u& ob) {
    const unsigned aw[4] = {a.x, a.y, a.z, a.w}, bw[4] = {b.x, b.y, b.z, b.w}; unsigned ra[4], rb[4];
#pragma unroll
    for (int q = 0; q < 4; ++q) {
        const float x1l = bflo(aw[q]), x1h = bfhi(aw[q]), x2l = bflo(bw[q]), x2h = bfhi(bw[q]);
        const float cl = cs[4 * q], sl = cs[4 * q + 1], ch = cs[4 * q + 2], sh = cs[4 * q + 3];
        ra[q] = pk2(x1l * cl - x2l * sl, x1h * ch - x2h * sh); rb[q] = pk2(x2l * cl + x1l * sl, x2h * ch + x1h * sh); }
    oa = (v4u){ra[0], ra[1], ra[2], ra[3]}; ob = (v4u){rb[0], rb[1], rb[2], rb[3]};
}
__device__ __forceinline__ void phase_rope(const Ptrs& A, int G, int vcu, int tid) {
    bf16* P = (bf16*)(A.ws + WS_P); bf16* QR = (bf16*)(A.ws + WS_QR); const float* ROPE = (const float*)(A.ws + WS_ROPE);
    const int gt = vcu * NTHREADS + tid, NGT = G * NTHREADS;
    for (int idx = gt; idx < MROWS * 16 * 8; idx += NGT) {
        const int pc = idx & 7, h = (idx >> 3) & 15, row = idx >> 7;
        const bf16* src = P + (size_t)row * NSA_NP + PC_Q + h * 128; bf16* dst = QR + (size_t)row * DM + h * 128;
        if (pc < 2) { const v4u a = *(const v4u*)(src + 8 * pc), b = *(const v4u*)(src + 16 + 8 * pc); float cs[16];
#pragma unroll
            for (int e = 0; e < 4; ++e) { const f32x4 t = *(const f32x4*)(ROPE + (size_t)row * 32 + pc * 16 + 4 * e); cs[4 * e] = t.x; cs[4 * e + 1] = t.y; cs[4 * e + 2] = t.z; cs[4 * e + 3] = t.w; }
            v4u oa, ob; rope_pair(a, b, cs, oa, ob); *(v4u*)(dst + 8 * pc) = oa; *(v4u*)(dst + 16 + 8 * pc) = ob; }
        else { const int c0 = 32 + (pc - 2) * 16; *(v4u*)(dst + c0) = *(const v4u*)(src + c0); *(v4u*)(dst + c0 + 8) = *(const v4u*)(src + c0 + 8); }
    }
    for (int idx = gt; idx < MROWS * 8; idx += NGT) {
        const int pc = idx & 1, g = (idx >> 1) & 1, wh = (idx >> 2) & 1, row = idx >> 3;
        bf16* p = P + (size_t)row * NSA_NP + (wh ? PC_KVW : PC_KVS) + g * 128;
        const v4u a = *(const v4u*)(p + 8 * pc), b = *(const v4u*)(p + 16 + 8 * pc); float cs[16];
#pragma unroll
        for (int e = 0; e < 4; ++e) { const f32x4 t = *(const f32x4*)(ROPE + (size_t)row * 32 + pc * 16 + 4 * e); cs[4 * e] = t.x; cs[4 * e + 1] = t.y; cs[4 * e + 2] = t.z; cs[4 * e + 3] = t.w; }
        v4u oa, ob; rope_pair(a, b, cs, oa, ob); *(v4u*)(p + 8 * pc) = oa; *(v4u*)(p + 16 + 8 * pc) = ob;
    }
}

__device__ __forceinline__ void phase_compress(const Ptrs& A, int j_layer, LAS unsigned char* lds, int G, int vcu, int tid) {
    const bf16* P = (const bf16*)(A.ws + WS_P); bf16* KC = (bf16*)(A.ws + WS_KC); bf16* VC = (bf16*)(A.ws + WS_VC);
    const float* pe = A.nsa_pe + (size_t)j_layer * 2 * 32 * 128; const float* w1 = A.nsa_w1 + (size_t)j_layer * 2 * 32 * 128 * 128; const float* w2 = A.nsa_w2 + (size_t)j_layer * 2 * 128 * 128;
    LAS float* blk = (LAS float*)lds; LAS float* part = blk + 4096; LAS float* hid = part + 512;
    for (int item = vcu; item < NB * NCMP * 4; item += G) {
        const int g = item & 1, c = (item >> 1) & 1, bj = item >> 2, j = bj % NCMP, b = bj / NCMP;
        __syncthreads();
        for (int idx = tid; idx < 4096; idx += NTHREADS) { const int l = idx >> 7, d = idx & 127; const int row = b * SEQ + 16 * j + l;
            blk[idx] = bf2f(P[(size_t)row * NSA_NP + PC_KVC + c * 256 + g * 128 + d]) + pe[(c * 32 + l) * 128 + d]; }
        __syncthreads();
        { const int h = tid & 127, pt = tid >> 7; float acc = 0.f;
          for (int l = pt * 8; l < pt * 8 + 8; ++l) { const float* wp = w1 + ((size_t)(c * 32 + l) * 128) * 128 + h; const LAS float* bp = blk + l * 128;
#pragma unroll 8
              for (int d = 0; d < 128; ++d) acc += bp[d] * wp[(size_t)d * 128]; }
          part[pt * 128 + h] = acc; }
        __syncthreads();
        if (tid < 128) { const float v = (part[tid] + part[128 + tid]) + (part[256 + tid] + part[384 + tid]);
            hid[tid] = 0.5f * v * (1.0f + tanhf_(0.7978845608028654f * (v + 0.044715f * v * v * v))); }
        __syncthreads();
        if (tid < 128) { float o = 0.f; const float* wp = w2 + (size_t)c * 128 * 128 + tid;
#pragma unroll 8
            for (int h = 0; h < 128; ++h) o += hid[h] * wp[(size_t)h * 128];
            bf16* dstp = (c == 0 ? KC : VC) + ((size_t)(b * 2 + g) * 128 + j) * 128 + tid; *dstp = (bf16)f2bf(o);
            if (j == NCMP - 1) dstp[128] = 0; }
    }
}

__device__ __forceinline__ void key_dots(const bf16* krow, const LAS float* q, float (&acc)[8]) {
#pragma unroll
    for (int r = 0; r < 8; ++r) acc[r] = 0.f;
#pragma unroll 4
    for (int c = 0; c < 16; ++c) { const v4u kv = *(const v4u*)(krow + 8 * c);
        const float k0 = bflo(kv.x), k1 = bfhi(kv.x), k2 = bflo(kv.y), k3 = bfhi(kv.y), k4 = bflo(kv.z), k5 = bfhi(kv.z), k6 = bflo(kv.w), k7 = bfhi(kv.w);
#pragma unroll
        for (int r = 0; r < 8; ++r) { const f32x4 qa = *(const LAS f32x4*)(q + r * 128 + 8 * c), qb = *(const LAS f32x4*)(q + r * 128 + 8 * c + 4);
            acc[r] += (k0 * qa.x + k1 * qa.y) + (k2 * qa.z + k3 * qa.w) + (k4 * qb.x + k5 * qb.y) + (k6 * qb.z + k7 * qb.w); } }
}
__device__ __forceinline__ void softmax512(LAS float* scr, int lane) {
    float v[8]; float m = -3.0e38f;
#pragma unroll
    for (int i = 0; i < 8; ++i) { v[i] = scr[lane + 64 * i]; m = fmaxf(m, v[i]); }
    m = wave_max(m); float s = 0.f;
#pragma unroll
    for (int i = 0; i < 8; ++i) { v[i] = __expf(v[i] - m); s += v[i]; }
    s = 1.0f / wave_sum(s);
#pragma unroll
    for (int i = 0; i < 8; ++i) scr[lane + 64 * i] = v[i] * s;
}
__device__ __forceinline__ void phase_nsa_attn(const Ptrs& A, int j_layer, LAS unsigned char* lds, int G, int vcu, int wave, int lane, int tid) {
    const bf16* P = (const bf16*)(A.ws + WS_P); const bf16* QR = (const bf16*)(A.ws + WS_QR); const float* KC = (const float*)(A.ws + WS_KC); const float* VC = (const float*)(A.ws + WS_VC);
    bf16* O = (bf16*)(A.ws + WS_O); const float* gb = A.nsa_gate_b + (size_t)j_layer * 48;
    LAS float* qs = (LAS float*)lds; LAS float* qrs = qs + 1024; LAS float* sc = qrs + 1024; LAS float* pc = sc + 4096; LAS float* imp = pc + 1024; LAS int* sel = (LAS int*)(imp + 32);
    for (int item = vcu; item < NB * 2 * SEQ; item += G) {
        const int b = item >> 12, g = (item >> 11) & 1, s = item & 2047, row = b * SEQ + s, r = wave;
        __syncthreads();
        for (int idx = tid; idx < 1024; idx += NTHREADS) { qs[idx] = bf2f(P[(size_t)row * NSA_NP + PC_Q + g * 1024 + idx]); qrs[idx] = bf2f(QR[(size_t)row * DM + g * 1024 + idx]); }
        __syncthreads();
        const int nvis = (s < 31) ? 0 : (((s - 31) >> 4) + 1 > NCMP ? NCMP : ((s - 31) >> 4) + 1);
        const float* kcb = KC + (size_t)(b * 2 + g) * 128 * 128; const float* vcb = VC + (size_t)(b * 2 + g) * 128 * 128;
        { float v[2];
#pragma unroll
          for (int jr = 0; jr < 2; ++jr) { const int j = lane + 64 * jr; float d = 0.f;
              if (j < nvis) { const float* kp = kcb + (size_t)j * 128;
#pragma unroll 8
                  for (int e = 0; e < 128; e += 4) { const f32x4 kk = *(const f32x4*)(kp + e); const f32x4 qq = *(const LAS f32x4*)(qs + r * 128 + e); d += (kk.x * qq.x + kk.y * qq.y) + (kk.z * qq.z + kk.w * qq.w); }
                  v[jr] = d * ATT_SCALE; } else v[jr] = -1e30f; }
          const float m = wave_max(fmaxf(v[0], v[1]));
          const float e0 = (lane < nvis) ? __expf(v[0] - m) : 0.f, e1 = (lane + 64 < nvis) ? __expf(v[1] - m) : 0.f;
          const float ssum = wave_sum(e0 + e1); const float inv = (nvis > 0) ? 1.0f / ssum : 0.f;
          pc[r * 128 + lane] = e0 * inv; pc[r * 128 + 64 + lane] = e1 * inv; }
        __syncthreads();
        float oc0 = 0.f, oc1 = 0.f;
        for (int j = 0; j < nvis; ++j) { const float p = pc[r * 128 + j]; const f32x2 vv = *(const f32x2*)(vcb + (size_t)j * 128 + 2 * lane); oc0 += p * vv.x; oc1 += p * vv.y; }
        if (tid < 32) { const int n = tid; float a = 0.f;
            for (int rr = 0; rr < 8; ++rr) { const LAS float* pp = pc + rr * 128 + 4 * n; a += pp[0] + pp[1] + pp[2] + 0.5f * pp[3] + ((n > 0) ? 0.5f * pp[-1] : 0.f); }
            imp[n] = a; }
        __syncthreads();
        const int qb = s >> 6;
        if (wave == 0) {
            if (qb < 8) { if (lane < 8) sel[lane] = lane; if (lane == 8) sel[8] = qb + 1; }
            else { float scv = (lane >= 1 && lane < qb) ? imp[lane & 31] : -3.0e38f;
                if (lane == 0) { sel[0] = 0; sel[1] = qb; sel[8] = 8; }
                for (int t = 0; t < 6; ++t) { const float best = wave_max(scv); const unsigned long long bal = __ballot(scv == best); const int idx = __ffsll((long long)bal) - 1;
                    if (lane == idx) { sel[2 + t] = idx; scv = -3.0e38f; } } }
        }
        __syncthreads();
        const int nsel = sel[8];
        { const int kb = tid >> 6; float acc[8]; bool valid = false;
          if (kb < nsel) { const int kpos = sel[kb] * 64 + (tid & 63); valid = (kpos <= s);
              if (valid) key_dots(P + (size_t)(b * SEQ + kpos) * NSA_NP + PC_KVS + g * 128, qrs, acc); }
#pragma unroll
          for (int rr = 0; rr < 8; ++rr) sc[rr * 512 + tid] = valid ? acc[rr] * ATT_SCALE : -1e30f; }
        __syncthreads();
        softmax512(sc + r * 512, lane);
        float os0 = 0.f, os1 = 0.f;
        for (int k = 0; k < nsel * 64; ++k) { const float p = sc[r * 512 + k]; const int kpos = sel[k >> 6] * 64 + (k & 63);
            const unsigned vv = *(const unsigned*)(P + (size_t)(b * SEQ + kpos) * NSA_NP + PC_KVS + 256 + g * 128 + 2 * lane); os0 += p * bflo(vv); os1 += p * bfhi(vv); }
        __syncthreads();
        const int nk = (s + 1 < 512) ? s + 1 : 512;
        { float acc[8]; const bool valid = tid < nk;
          if (valid) key_dots(P + (size_t)(row - tid) * NSA_NP + PC_KVW + g * 128, qrs, acc);
#pragma unroll
          for (int rr = 0; rr < 8; ++rr) sc[rr * 512 + tid] = valid ? acc[rr] * ATT_SCALE : -1e30f; }
        __syncthreads();
        softmax512(sc + r * 512, lane);
        float ow0 = 0.f, ow1 = 0.f;
        for (int k = 0; k < nk; ++k) { const float p = sc[r * 512 + k];
            const unsigned vv = *(const unsigned*)(P + (size_t)(row - k) * NSA_NP + PC_KVW + 256 + g * 128 + 2 * lane); ow0 += p * bflo(vv); ow1 += p * bfhi(vv); }
        const int h = g * 8 + r; const bf16* gp = P + (size_t)row * NSA_NP + PC_GATE + h;
        const float g0 = sigmoidf_(bf2f(gp[0]) + gb[h]), g1 = sigmoidf_(bf2f(gp[16]) + gb[16 + h]), g2 = sigmoidf_(bf2f(gp[32]) + gb[32 + h]);
        *(unsigned*)(O + (size_t)row * DM + h * 128 + 2 * lane) = pk2(g0 * oc0 + g1 * os0 + g2 * ow0, g0 * oc1 + g1 * os1 + g2 * ow1);
    }
}

__device__ __forceinline__ void phase_ml_rec(const Ptrs& A, LAS unsigned char* lds, int G, int vcu, int wave, int lane, int tid) {
    const bf16* P = (const bf16*)(A.ws + WS_P); const float* GT = (const float*)(A.ws + WS_GATES); float* HRAW = (float*)(A.ws + WS_HRAW); float* HSS = (float*)(A.ws + WS_HSS);
    LAS float* qf = (LAS float*)lds; LAS float* kf = qf + 64 * 129; LAS float* vf = kf + 64 * 129; LAS float* Cs = vf + 64 * 32; LAS float* Sq = Cs + 128 * 32;
    LAS float* Fs = Sq + 64 * 65; LAS float* lis = Fs + 64; LAS float* ws_ = lis + 64; LAS float* mts = ws_ + 64; LAS float* gis = mts + 64; LAS float* dns = gis + 64; LAS float* qns = dns + 64; LAS float* nv = qns + 64; LAS float* scal = nv + 128;
    for (int unit = vcu; unit < 256; unit += G) {
        const int b = unit >> 6, h = (unit >> 3) & 7, sl = unit & 7;
        float Creg[8];
#pragma unroll
        for (int v = 0; v < 8; ++v) Creg[v] = 0.f;
        float nreg = 0.f, mrun = 0.f;
        const int kC = tid >> 2, vg = tid & 3;
        __syncthreads();
        for (int idx = tid; idx < 128 * 32; idx += NTHREADS) Cs[idx] = 0.f;
        if (tid < 128) nv[tid] = 0.f;
        for (int c = 0; c < 32; ++c) {
            const int t0 = b * SEQ + c * 64;
            __syncthreads();
            for (int idx = tid; idx < 64 * 128; idx += NTHREADS) { const int l = idx >> 7, d = idx & 127; const bf16* pr = P + (size_t)(t0 + l) * ML_NP;
                qf[l * 129 + d] = bf2f(pr[MC_Q + h * 128 + d]) * ATT_SCALE; kf[l * 129 + d] = bf2f(pr[MC_K + h * 128 + d]); }
            for (int idx = tid; idx < 64 * 32; idx += NTHREADS) { const int l = idx >> 5, v = idx & 31; vf[idx] = bf2f(P[(size_t)(t0 + l) * ML_NP + MC_V + h * 256 + sl * 32 + v]); }
            if (wave == 0) {
                const float li = GT[(size_t)(t0 + lane) * 16 + h], lf = GT[(size_t)(t0 + lane) * 16 + 8 + h];
                float F = lf;
#pragma unroll
                for (int o = 1; o < 64; o <<= 1) { const float t = __shfl_up(F, o); if (lane >= o) F += t; }
                const float Fend = __shfl(F, 63);
                const float a = Fend - F + li; const float amax = wave_max(a);
                float dm = li - F;
#pragma unroll
                for (int o = 1; o < 64; o <<= 1) { const float t = __shfl_up(dm, o); if (lane >= o) dm = fmaxf(dm, t); }
                const float inter = F + mrun, mt = fmaxf(inter, F + dm);
                Fs[lane] = F; lis[lane] = li; ws_[lane] = __expf(a - amax); mts[lane] = mt; gis[lane] = __expf(inter - mt);
                if (lane == 0) { scal[0] = Fend; scal[1] = amax; }
            }
            __syncthreads();
            const float Fend = scal[0], amax = scal[1];
            { const int l = tid >> 3, s0 = (tid & 7) * 8; const float Fl = Fs[l], mtl = mts[l];
#pragma unroll
              for (int e = 0; e < 8; ++e) { const int s = s0 + e; float val = 0.f;
                  if (s <= l) { float d = 0.f;
#pragma unroll 8
                      for (int k = 0; k < 128; ++k) d += qf[l * 129 + k] * kf[s * 129 + k];
                      val = d * __expf(Fl - Fs[s] + lis[s] - mtl); }
                  Sq[l * 65 + s] = val; }
              if ((tid & 7) == 0) { float d = 0.f;
#pragma unroll 8
                  for (int k = 0; k < 128; ++k) d += qf[l * 129 + k] * nv[k];
                  qns[l] = d; } }
            __syncthreads();
            if (tid < 64) { float rs = 0.f;
#pragma unroll 8
                for (int s = 0; s < 64; ++s) rs += Sq[tid * 65 + s];
                const float den = rs + gis[tid] * qns[tid]; dns[tid] = fmaxf(fabsf(den), __expf(-mts[tid])); }
            f32x4 num = (f32x4){0.f, 0.f, 0.f, 0.f};
            { const int l = tid >> 3, v4 = (tid & 7) * 4; f32x4 inter4 = (f32x4){0.f, 0.f, 0.f, 0.f};
              for (int s = 0; s <= l; ++s) num += Sq[l * 65 + s] * *(const LAS f32x4*)(vf + s * 32 + v4);
#pragma unroll 8
              for (int k = 0; k < 128; ++k) inter4 += qf[l * 129 + k] * *(const LAS f32x4*)(Cs + k * 32 + v4);
              num += gis[l] * inter4; }
            __syncthreads();
            { const int l = tid >> 3, v4 = (tid & 7) * 4; const float inv = 1.0f / dns[l]; const f32x4 hv = num * inv;
              *(f32x4*)(HRAW + (size_t)(t0 + l) * DM + h * 256 + sl * 32 + v4) = hv;
              float ss = (hv.x * hv.x + hv.y * hv.y) + (hv.z * hv.z + hv.w * hv.w);
              ss += __shfl_xor(ss, 1); ss += __shfl_xor(ss, 2); ss += __shfl_xor(ss, 4);
              if ((tid & 7) == 0) HSS[((size_t)(t0 + l) * 8 + h) * 8 + sl] = ss; }
            const float mnew = fmaxf(Fend + mrun, amax), decay = __expf(Fend + mrun - mnew), inject = __expf(amax - mnew);
            { float dC[8];
#pragma unroll
              for (int v = 0; v < 8; ++v) dC[v] = 0.f;
              float dn = 0.f;
              for (int l = 0; l < 64; ++l) { const float wk = ws_[l] * kf[l * 129 + kC]; dn += wk; const f32x4 va = *(const LAS f32x4*)(vf + l * 32 + vg * 8), vb = *(const LAS f32x4*)(vf + l * 32 + vg * 8 + 4);
                  dC[0] += wk * va.x; dC[1] += wk * va.y; dC[2] += wk * va.z; dC[3] += wk * va.w; dC[4] += wk * vb.x; dC[5] += wk * vb.y; dC[6] += wk * vb.z; dC[7] += wk * vb.w; }
#pragma unroll
              for (int v = 0; v < 8; ++v) { Creg[v] = decay * Creg[v] + inject * dC[v]; Cs[kC * 32 + vg * 8 + v] = Creg[v]; }
              nreg = decay * nreg + inject * dn; if (vg == 0) nv[kC] = nreg; }
            mrun = mnew;
        }
    }
}

__device__ __forceinline__ void phase_ml_norm(const Ptrs& A, int j_layer, int G, int vcu, int tid) {
    const bf16* P = (const bf16*)(A.ws + WS_P); const bf16* HRAW = (const bf16*)(A.ws + WS_HRAW); bf16* O = (bf16*)(A.ws + WS_O);
    const float* hn = A.ml_head_norm + (size_t)j_layer * DM;
    const int t0 = vcu * NTHREADS + tid, c8 = t0 & 255, col = c8 * 8, rstep = (G * NTHREADS) >> 8;
    const f32x4 ga = *(const f32x4*)(hn + col), gb2 = *(const f32x4*)(hn + col + 4);
    for (int r0 = t0 >> 8; r0 < MROWS; r0 += 4 * rstep) {
        v4u hrv[4], ogv[4];
#pragma unroll
        for (int u = 0; u < 4; ++u) { const int row = r0 + u * rstep; const bool ok = row < MROWS; const int rr = ok ? row : r0;
            hrv[u] = *(const v4u*)(HRAW + (size_t)rr * DM + col); ogv[u] = *(const v4u*)(P + (size_t)rr * ML_NP + MC_OG + col); }
#pragma unroll
        for (int u = 0; u < 4; ++u) { const int row = r0 + u * rstep; const v4u hr = hrv[u], og = ogv[u];
            const f32x4 a = (f32x4){bflo(hr.x), bfhi(hr.x), bflo(hr.y), bfhi(hr.y)}, b2 = (f32x4){bflo(hr.z), bfhi(hr.z), bflo(hr.w), bfhi(hr.w)};
            float ss = ((a.x * a.x + a.y * a.y) + (a.z * a.z + a.w * a.w)) + ((b2.x * b2.x + b2.y * b2.y) + (b2.z * b2.z + b2.w * b2.w));
#pragma unroll
            for (int o = 1; o < 32; o <<= 1) ss += __shfl_xor(ss, o);
            const float rstd = 1.0f / sqrtf(ss * (1.0f / 256.0f) + 1e-6f);
            v4u o;
            o.x = pk2(a.x * rstd * ga.x * sigmoidf_(bflo(og.x)), a.y * rstd * ga.y * sigmoidf_(bfhi(og.x)));
            o.y = pk2(a.z * rstd * ga.z * sigmoidf_(bflo(og.y)), a.w * rstd * ga.w * sigmoidf_(bfhi(og.y)));
            o.z = pk2(b2.x * rstd * gb2.x * sigmoidf_(bflo(og.z)), b2.y * rstd * gb2.y * sigmoidf_(bfhi(og.z)));
            o.w = pk2(b2.z * rstd * gb2.z * sigmoidf_(bflo(og.w)), b2.w * rstd * gb2.w * sigmoidf_(bfhi(og.w)));
            if (row < MROWS) *(v4u*)(O + (size_t)row * DM + col) = o; }
    }
}

__device__ __forceinline__ void phase_fixup(const Ptrs& A, int layer, int G, int vcu, int tid) {
    const float* US = (const float*)(A.ws + WS_U); bf16* ACT = (bf16*)(A.ws + WS_ACT);
    const float* cw = A.conv_w + (size_t)layer * 3 * NUP; const float* cb = A.conv_b + (size_t)layer * NUP;
    for (int idx = vcu * NTHREADS + tid; idx < 128 * 2 * (DFF / 8); idx += G * NTHREADS) {
        const int c8 = idx % (DFF / 8), rr = (idx / (DFF / 8)) & 1, ch = idx / (2 * (DFF / 8)), cg = c8 * 8; const bool bs = (ch & 31) == 0;
        const int chp = bs ? ch : ch - 1;
        const float* u2p = US + ((size_t)ch * 4 + 2 + rr) * NUP + cg;
        const float* u1p = rr ? US + ((size_t)ch * 4 + 2) * NUP + cg : US + ((size_t)chp * 4 + 1) * NUP + cg; const bool z1 = (rr == 0) && bs;
        const float* u0p = rr ? US + ((size_t)chp * 4 + 1) * NUP + cg : US + ((size_t)chp * 4 + 0) * NUP + cg; const bool z0 = bs;
        f32x4 g2[2], v2[2], g1[2], v1[2], g0[2], v0[2], bg[2], bv[2], wg[3][2], wv[3][2];
#pragma unroll
        for (int q = 0; q < 2; ++q) { g2[q] = *(const f32x4*)(u2p + 4 * q); v2[q] = *(const f32x4*)(u2p + DFF + 4 * q); g1[q] = *(const f32x4*)(u1p + 4 * q); v1[q] = *(const f32x4*)(u1p + DFF + 4 * q);
            g0[q] = *(const f32x4*)(u0p + 4 * q); v0[q] = *(const f32x4*)(u0p + DFF + 4 * q); bg[q] = *(const f32x4*)(cb + cg + 4 * q); bv[q] = *(const f32x4*)(cb + DFF + cg + 4 * q);
#pragma unroll
            for (int t = 0; t < 3; ++t) { wg[t][q] = *(const f32x4*)(cw + (size_t)t * NUP + cg + 4 * q); wv[t][q] = *(const f32x4*)(cw + (size_t)t * NUP + DFF + cg + 4 * q); } }
        unsigned ow[4];
#pragma unroll
        for (int q = 0; q < 2; ++q) {
            const f32x4 zero = (f32x4){0.f, 0.f, 0.f, 0.f};
            const f32x4 a1 = z1 ? zero : g1[q], b1 = z1 ? zero : v1[q], a0 = z0 ? zero : g0[q], b0 = z0 ? zero : v0[q];
            const f32x4 cgv = bg[q] + wg[0][q] * a0 + wg[1][q] * a1 + wg[2][q] * g2[q];
            const f32x4 cvv = bv[q] + wv[0][q] * b0 + wv[1][q] * b1 + wv[2][q] * v2[q];
            ow[2 * q] = pk2(cgv.x * sigmoidf_(cgv.x) * cvv.x, cgv.y * sigmoidf_(cgv.y) * cvv.y); ow[2 * q + 1] = pk2(cgv.z * sigmoidf_(cgv.z) * cvv.z, cgv.w * sigmoidf_(cgv.w) * cvv.w); }
        *(v4u*)(ACT + (size_t)(ch * 64 + rr) * DFF + cg) = (v4u){ow[0], ow[1], ow[2], ow[3]};
    }
}

__device__ __forceinline__ void phase_final(const Ptrs& A, int G, int vcu, int wave, int lane) {
    const bf16* XB = (const bf16*)(A.ws + WS_XB); const float* SSP = (const float*)(A.ws + WS_SSP);
    const int gw = vcu * NWAVES + wave, NGW = G * NWAVES;
    const f32x4* gr = (const f32x4*)A.norm_final + 2 * lane; f32x4 gv[8];
#pragma unroll
    for (int j = 0; j < 4; ++j) { gv[2 * j] = gr[128 * j]; gv[2 * j + 1] = gr[128 * j + 1]; }
    for (int m0 = gw; m0 < MROWS; m0 += 2 * NGW) {
        float ssv[2]; v4u xv[2][4];
#pragma unroll
        for (int u = 0; u < 2; ++u) { const int m = (m0 + u * NGW < MROWS) ? m0 + u * NGW : m0; ssv[u] = (lane < 32) ? SSP[(size_t)lane * MROWS + m] : 0.f;
            const v4u* xr = (const v4u*)(XB + (size_t)m * DM) + lane;
#pragma unroll
            for (int j = 0; j < 4; ++j) xv[u][j] = xr[64 * j]; }
#pragma unroll
        for (int u = 0; u < 2; ++u) { const int m = m0 + u * NGW; const float rstd = 1.0f / sqrtf(wave_sum(ssv[u]) * (1.0f / 2048.0f) + 1e-6f);
            if (m < MROWS) { f32x4* o = (f32x4*)(A.out + (size_t)m * DM) + 2 * lane;
#pragma unroll
                for (int j = 0; j < 4; ++j) { const v4u x = xv[u][j];
                    o[128 * j] = (f32x4){bflo(x.x), bfhi(x.x), bflo(x.y), bfhi(x.y)} * rstd * gv[2 * j]; o[128 * j + 1] = (f32x4){bflo(x.z), bfhi(x.z), bflo(x.w), bfhi(x.w)} * rstd * gv[2 * j + 1]; } } }
    }
}
namespace na {
typedef short bf16x8 __attribute__((ext_vector_type(8)));
typedef short s16x4 __attribute__((ext_vector_type(4)));
typedef float f32x16 __attribute__((ext_vector_type(16)));
typedef unsigned u32x4 __attribute__((ext_vector_type(4)));
constexpr int KVBLK = 64, SHM_K = 16384, SHM_V = 16384;
constexpr float THR = 8.f, SCALE = 0.08838834764831845f;
#define KSWZ(row, colB) ((row) * 256 + ((colB) ^ (((row) & 7) << 4)))
#define SBAR() __builtin_amdgcn_sched_barrier(0)
__device__ __forceinline__ int v_st(int k, int c) { const int kk = (k & ~0xC) | ((k & 4) << 1) | ((k & 8) >> 1); return ((kk >> 3) * 4 + (c >> 5)) * 512 + ((kk & 7) * 32 + (c & 31)) * 2; }
__device__ __forceinline__ int v_rd_base(int lane) { return ((lane & 3) << 3) | (((lane >> 2) & 3) << 6) | (((lane >> 4) & 1) << 5) | (((lane >> 5) & 1) << 8); }
constexpr int v_rd_off(int d0, int ks, int half) { return d0 * 512 + ks * 4096 + half * 2048; }
__device__ __forceinline__ int crow(int r, int hi) { return (r & 3) + 8 * (r >> 2) + 4 * hi; }
__device__ __forceinline__ unsigned cvtpk(float lo, float hi) { unsigned r; asm volatile("v_cvt_pk_bf16_f32 %0, %1, %2" : "=v"(r) : "v"(lo), "v"(hi)); return r; }
__device__ __forceinline__ void mask_tile(f32x16& p0, f32x16& p1, int dq, unsigned W) {
    const float NEG = -__builtin_inff();
#pragma unroll
    for (int r = 0; r < 16; ++r) { const int c = (r & 3) + 8 * (r >> 2);
        if ((unsigned)(dq - c) >= W) p0[r] = NEG;
        if ((unsigned)(dq - c - 32) >= W) p1[r] = NEG; }
}
__device__ __forceinline__ void partialSM(f32x16& p0, f32x16& p1, float& m_reg, float& mn, float& alpha) {
    float pmax = p0[0];
#pragma unroll
    for (int r = 1; r < 16; ++r) pmax = fmaxf(pmax, p0[r]);
#pragma unroll
    for (int r = 0; r < 16; ++r) pmax = fmaxf(pmax, p1[r]);
    { auto rr = __builtin_amdgcn_permlane32_swap(__float_as_uint(pmax), __float_as_uint(pmax), false, false);
      pmax = fmaxf(__uint_as_float(rr[0]), __uint_as_float(rr[1])); }
    constexpr float C2 = 1.4426950408889634f * SCALE;
    if (__builtin_expect(__all((pmax - m_reg) * SCALE <= THR), 1)) { mn = m_reg; alpha = 1.f; }
    else { mn = fmaxf(m_reg, pmax); alpha = __builtin_amdgcn_exp2f((m_reg - mn) * C2); m_reg = mn; }
    const float mnL = -mn * C2;
#pragma unroll
    for (int r = 0; r < 16; ++r) p0[r] = fmaf(p0[r], C2, mnL);
#pragma unroll
    for (int r = 0; r < 16; ++r) p1[r] = fmaf(p1[r], C2, mnL);
#pragma unroll
    for (int r = 0; r < 16; ++r) p0[r] = __builtin_amdgcn_exp2f(p0[r]);
}
#define NA_PK4(P, B_, OUT) do { unsigned a0 = cvtpk(P[B_+0], P[B_+1]), a1 = cvtpk(P[B_+2], P[B_+3]);                          \
        unsigned b0 = cvtpk(P[B_+4], P[B_+5]), b1 = cvtpk(P[B_+6], P[B_+7]);                                             \
        auto r0 = __builtin_amdgcn_permlane32_swap(a0, b0, false, false); auto r1 = __builtin_amdgcn_permlane32_swap(a1, b1, false, false); \
        u32x4 w = {r0[0], r1[0], r0[1], r1[1]}; OUT = *reinterpret_cast<bf16x8*>(&w); } while (0)
__device__ __forceinline__ void pack_p(const f32x16& p0, const f32x16& p1, bf16x8& pa0, bf16x8& pa1, bf16x8& pa2, bf16x8& pa3) {
    NA_PK4(p0, 0, pa0); NA_PK4(p0, 8, pa1); NA_PK4(p1, 0, pa2); NA_PK4(p1, 8, pa3);
}
__device__ __forceinline__ void finishSM(f32x16& p0, f32x16& p1, float alpha, float& l_reg, bf16x8& pa0, bf16x8& pa1, bf16x8& pa2, bf16x8& pa3) {
#pragma unroll
    for (int r = 0; r < 16; ++r) p1[r] = __builtin_amdgcn_exp2f(p1[r]);
    float ps = 0;
#pragma unroll
    for (int r = 0; r < 16; ++r) ps += p0[r];
#pragma unroll
    for (int r = 0; r < 16; ++r) ps += p1[r];
    { auto rr = __builtin_amdgcn_permlane32_swap(__float_as_uint(ps), __float_as_uint(ps), false, false);
      ps = __uint_as_float(rr[0]) + __uint_as_float(rr[1]); }
    l_reg = l_reg * alpha + ps;
    pack_p(p0, p1, pa0, pa1, pa2, pa3);
}
template <int KOFF>
__device__ __forceinline__ void qkt(f32x16& p0, f32x16& p1, const LAS char* K_lds, int r32, int hi, const bf16x8* qr) {
    p0 = f32x16{}; p1 = f32x16{};
    const LAS char* kb[4];
#pragma unroll
    for (int dd = 0; dd < 4; ++dd) kb[dd] = K_lds + KOFF + KSWZ(r32, (dd * 16 + hi * 8) * 2);
#define NA_KLD(d0, t) (*reinterpret_cast<const LAS bf16x8*>(kb[(d0) & 3] + ((d0) >> 2) * 128 + (t) * 32 * 256))
    bf16x8 f[2][4];
    f[0][0] = NA_KLD(0, 0); f[0][1] = NA_KLD(0, 1); f[0][2] = NA_KLD(1, 0); f[0][3] = NA_KLD(1, 1);
#pragma unroll
    for (int g = 0; g < 4; ++g) { SBAR();
        if (g + 1 < 4) { f[(g + 1) & 1][0] = NA_KLD(2 * g + 2, 0); f[(g + 1) & 1][1] = NA_KLD(2 * g + 2, 1); f[(g + 1) & 1][2] = NA_KLD(2 * g + 3, 0); f[(g + 1) & 1][3] = NA_KLD(2 * g + 3, 1); }
        p0 = __builtin_amdgcn_mfma_f32_32x32x16_bf16(f[g & 1][0], qr[2 * g], p0, 0, 0, 0);
        p1 = __builtin_amdgcn_mfma_f32_32x32x16_bf16(f[g & 1][1], qr[2 * g], p1, 0, 0, 0);
        p0 = __builtin_amdgcn_mfma_f32_32x32x16_bf16(f[g & 1][2], qr[2 * g + 1], p0, 0, 0, 0);
        p1 = __builtin_amdgcn_mfma_f32_32x32x16_bf16(f[g & 1][3], qr[2 * g + 1], p1, 0, 0, 0); }
#undef NA_KLD
}
template <int VOFF>
__device__ __forceinline__ void pv_tile(f32x16* o, int vb0, bf16x8 pa0, bf16x8 pa1, bf16x8 pa2, bf16x8 pa3) {
#define NA_TRRD(dst, off) asm volatile("ds_read_b64_tr_b16 %0, %1 offset:%2" : "=&v"(dst) : "v"(vb0), "i"(off) : "memory")
#define NA_PV_D0(d0) do { s16x4 l0, l1, l2, l3, h0, h1, h2, h3; constexpr int b_ = VOFF + v_rd_off(d0, 0, 0); \
        NA_TRRD(l0, b_); NA_TRRD(h0, b_ + 2048); NA_TRRD(l1, b_ + 4096); NA_TRRD(h1, b_ + 6144); NA_TRRD(l2, b_ + 8192); NA_TRRD(h2, b_ + 10240); NA_TRRD(l3, b_ + 12288); NA_TRRD(h3, b_ + 14336); \
        asm volatile("s_waitcnt lgkmcnt(0)" ::: "memory"); SBAR();   \
        o[d0] = __builtin_amdgcn_mfma_f32_32x32x16_bf16(pa0, (bf16x8){l0[0], l0[1], l0[2], l0[3], h0[0], h0[1], h0[2], h0[3]}, o[d0], 0, 0, 0);   \
        o[d0] = __builtin_amdgcn_mfma_f32_32x32x16_bf16(pa1, (bf16x8){l1[0], l1[1], l1[2], l1[3], h1[0], h1[1], h1[2], h1[3]}, o[d0], 0, 0, 0);   \
        o[d0] = __builtin_amdgcn_mfma_f32_32x32x16_bf16(pa2, (bf16x8){l2[0], l2[1], l2[2], l2[3], h2[0], h2[1], h2[2], h2[3]}, o[d0], 0, 0, 0);   \
        o[d0] = __builtin_amdgcn_mfma_f32_32x32x16_bf16(pa3, (bf16x8){l3[0], l3[1], l3[2], l3[3], h3[0], h3[1], h3[2], h3[3]}, o[d0], 0, 0, 0); } while (0)
    NA_PV_D0(0); NA_PV_D0(1); NA_PV_D0(2); NA_PV_D0(3);
#undef NA_PV_D0
#undef NA_TRRD
}
constexpr int VOFF0 = 0, VOFF1 = 16384, VOFF2 = 32768, KOFF0 = 49152, KOFF1 = 65536, KOFF2 = 81920, IMPW_OFF = 98304, IMPW_P = 33  , WSC_OFF = IMPW_OFF + 8 * 32 * IMPW_P * 4, SELB_OFF = WSC_OFF + 2048;
struct Ctx {
    LAS char* lds; LAS float* li_l; LAS float* al_l; int vb0, r32, hi, wave;
    int krow[2], kcolb[2], vkey[2], vcol[2];
};
__device__ __forceinline__ void dma_coords(Ctx& C, int lane) {
#pragma unroll
    for (int i = 0; i < 2; ++i) { const int L = (C.wave * 2 + i) * 1024 + lane * 16;
        const int row = L >> 8; C.krow[i] = row; C.kcolb[i] = (L & 255) ^ ((row & 7) << 4);
        const int st = L >> 9, within = L & 511, kk = (st >> 2) * 8 + (within >> 6); C.vkey[i] = (kk & ~0xC) | ((kk & 4) << 1) | ((kk & 8) >> 1); C.vcol[i] = (st & 3) * 32 + ((within & 63) >> 1); }
}
#define NA_VMWAIT(n) asm volatile("s_waitcnt vmcnt(" #n ")" ::: "memory")
#define NA_BAR() do { asm volatile("s_waitcnt lgkmcnt(0)" ::: "memory"); __builtin_amdgcn_s_barrier(); asm volatile("" ::: "memory"); } while (0)
#define NA_DMA(Kp, Vp, ld, k0, koff, voff) do { const bf16* kp_ = (Kp) + (size_t)(k0) * (ld); const bf16* vp_ = (Vp) + (size_t)(k0) * (ld); _Pragma("unroll") for (int i_ = 0; i_ < 2; ++i_) { \
        unsigned ok_ = (unsigned)(C.krow[i_] * (ld) + (C.kcolb[i_] >> 1)), ov_ = (unsigned)(C.vkey[i_] * (ld) + C.vcol[i_]); asm volatile("" : "+v"(ok_), "+v"(ov_));     \
        __builtin_amdgcn_global_load_lds((const unsigned*)(kp_ + ok_), (LAS unsigned*)(C.lds + (koff) + (C.wave * 2 + i_) * 1024), 16, 0, 0); \
        __builtin_amdgcn_global_load_lds((const unsigned*)(vp_ + ov_), (LAS unsigned*)(C.lds + (voff) + (C.wave * 2 + i_) * 1024), 16, 0, 0); } } while (0)
#define NA_RESC(a) do { if (__any((a) < 1.f)) { if (C.hi == 0) C.al_l[C.r32] = (a); asm volatile("s_waitcnt lgkmcnt(0)" ::: "memory");              \
                     _Pragma("unroll") for (int d_ = 0; d_ < 4; ++d_) _Pragma("unroll") for (int r = 0; r < 16; ++r) o[d_][r] *= C.al_l[crow(r, C.hi)]; } } while (0)
template <int MODE, bool PRE = false>
__device__ __forceinline__ void tile_loop(f32x16 (&o)[4], float& l_reg, const bf16x8 (&qr)[8], const bf16* Kg, const bf16* Vg, int ld, int NT, int j_lo, const LAS int* TL, unsigned myb, int qb, int pos, int t0, const Ctx& C) {
    float m_reg = -1e30f; l_reg = 0.f;
#pragma unroll
    for (int d = 0; d < 4; ++d) o[d] = f32x16{};
#define NA_KBASE(t) ((MODE == 0 ? TL[t] : (j_lo + (t))) * KVBLK)
    if (!PRE) {
    NA_VMWAIT(0);
    { const int kb = NA_KBASE(0); NA_DMA(Kg, Vg, ld, kb, KOFF0, VOFF0); }
    if (NT > 1) { const int kb = NA_KBASE(1); NA_DMA(Kg, Vg, ld, kb, KOFF1, VOFF1); } }
#define NA_STEP(t, KO, VO, KO2, VO2) do { const int kb = NA_KBASE(t);                                                                              \
        if ((t) + 1 < NT) NA_VMWAIT(4); else NA_VMWAIT(0);                       \
        NA_BAR();                                                              \
        if ((t) + 2 < NT) { const int kn = NA_KBASE((t) + 2); NA_DMA(Kg, Vg, ld, kn, KO2, VO2); }                                                  \
        f32x16 p0, p1; float mn, alpha; bf16x8 pa0, pa1, pa2, pa3;                                                                                 \
        SBAR(); qkt<KO>(p0, p1, C.lds, C.r32, C.hi, qr);                                                                                           \
        if (MODE == 0) { const int n = kb >> 6; const bool ok = (myb >> n) & 1u;                                                                   \
            if (n == qb) mask_tile(p0, p1, pos - kb - 4 * C.hi, 0x7fffffffu);                                                                      \
            if (!__all(ok)) { const float NEG = -__builtin_inff(); _Pragma("unroll") for (int r = 0; r < 16; ++r) { p0[r] = ok ? p0[r] : NEG; p1[r] = ok ? p1[r] : NEG; } } } \
        else { if (kb + KVBLK - 1 > t0 || kb <= t0 + 31 - 512) mask_tile(p0, p1, pos - kb - 4 * C.hi, 512u); }                                     \
        partialSM(p0, p1, m_reg, mn, alpha); NA_RESC(alpha); finishSM(p0, p1, alpha, l_reg, pa0, pa1, pa2, pa3); SBAR();                           \
        pv_tile<VO>(o, C.vb0, pa0, pa1, pa2, pa3); } while (0)
    for (int t = 0; t < NT; t += 3) { NA_STEP(t, KOFF0, VOFF0, KOFF2, VOFF2); if (t + 1 < NT) NA_STEP(t + 1, KOFF1, VOFF1, KOFF0, VOFF0); if (t + 2 < NT) NA_STEP(t + 2, KOFF2, VOFF2, KOFF1, VOFF1); }
    NA_BAR();
#undef NA_STEP
#undef NA_KBASE
}
}

__device__ __forceinline__ void phase_nsa_attn2(const Ptrs& A, int j_layer, LAS unsigned char* lds, int G, int vcu, int wave, int lane, int tid) {
    using namespace na;
    const bf16* P = (const bf16*)(A.ws + WS_P); const float* ROPE = (const float*)(A.ws + WS_ROPE); const bf16* KCb = (const bf16*)(A.ws + WS_KC); const bf16* VCb = (const bf16*)(A.ws + WS_VC);
    bf16* O = (bf16*)(A.ws + WS_O); const float* gb = A.nsa_gate_b + (size_t)j_layer * 48;
    Ctx C; C.lds = (LAS char*)lds; C.li_l = (LAS float*)(lds + WSC_OFF) + wave * 64; C.al_l = C.li_l + 32; C.wave = wave;
    LAS float* IMPW = (LAS float*)(lds + IMPW_OFF);
    LAS unsigned* SELB = (LAS unsigned*)(lds + SELB_OFF);
    LAS int* TL = (LAS int*)(SELB + 32);
    C.r32 = lane & 31; C.hi = lane >> 5; dma_coords(C, lane);
    C.vb0 = (int)(unsigned long long)C.lds + v_rd_base(lane);
    const int r32 = C.r32, hi = C.hi;
    constexpr float C2 = 1.4426950408889634f * SCALE;
    for (int u = vcu; u < 512; u += G) {
        const int w8 = u & 255, rnd = u >> 8, tbase = w8 & 63, tb = rnd ? 63 - tbase : tbase, bg = (w8 >> 6) + 4 * rnd, b = bg >> 1, g = bg & 1;
        const int t0 = tb * 32, qb = t0 >> 6, row0 = b * SEQ + t0, h = g * 8 + wave, pos = t0 + r32;
        const bf16* Prow = P + (size_t)(row0 + r32) * NSA_NP;
        f32x16 o[4]; unsigned otot[4][8];
        bf16x8 qr[8];
        NA_BAR();
        { const bf16* Kc = KCb + (size_t)(b * 2 + g) * 128 * 128; const bf16* Vc = VCb + (size_t)(b * 2 + g) * 128 * 128;
          NA_DMA(Kc, Vc, 128, 0, KOFF0, VOFF0); NA_DMA(Kc, Vc, 128, 64, KOFF1, VOFF1); }
#pragma unroll
        for (int d0 = 0; d0 < 8; ++d0) qr[d0] = *(const bf16x8*)(Prow + PC_Q + h * 128 + d0 * 16 + hi * 8);
        const float gz0 = bf2f(Prow[PC_GATE + h]) + gb[h], gz1 = bf2f(Prow[PC_GATE + 16 + h]) + gb[16 + h], gz2 = bf2f(Prow[PC_GATE + 32 + h]) + gb[32 + h];
        NA_VMWAIT(0); __syncthreads();
        {
            f32x16 pA0, pA1, pB0, pB1;
            qkt<KOFF0>(pA0, pA1, C.lds, r32, hi, qr); qkt<KOFF1>(pB0, pB1, C.lds, r32, hi, qr);
            const int lim = (pos - 31) >> 4;
            mask_tile(pA0, pA1, lim - 4 * hi, 0x7fffffffu); mask_tile(pB0, pB1, lim - 64 - 4 * hi, 0x7fffffffu);
            float mx = -1e30f;
#pragma unroll
            for (int r = 0; r < 16; ++r) mx = fmaxf(fmaxf(mx, fmaxf(pA0[r], pA1[r])), fmaxf(pB0[r], pB1[r]));
            { auto rr = __builtin_amdgcn_permlane32_swap(__float_as_uint(mx), __float_as_uint(mx), false, false); mx = fmaxf(__uint_as_float(rr[0]), __uint_as_float(rr[1])); }
            float ls = 0.f;
#pragma unroll
            for (int r = 0; r < 16; ++r) { pA0[r] = __builtin_amdgcn_exp2f((pA0[r] - mx) * C2); pA1[r] = __builtin_amdgcn_exp2f((pA1[r] - mx) * C2);
                pB0[r] = __builtin_amdgcn_exp2f((pB0[r] - mx) * C2); pB1[r] = __builtin_amdgcn_exp2f((pB1[r] - mx) * C2); ls += (pA0[r] + pA1[r]) + (pB0[r] + pB1[r]); }
            { auto rr = __builtin_amdgcn_permlane32_swap(__float_as_uint(ls), __float_as_uint(ls), false, false); ls = __uint_as_float(rr[0]) + __uint_as_float(rr[1]); }
            const float inv = (ls > 0.f) ? 1.0f / ls : 0.f;
            float recv[4][4], own[4][4];
#pragma unroll
            for (int ti = 0; ti < 4; ++ti)
#pragma unroll
                for (int gq = 0; gq < 4; ++gq) { const f32x16& pt = (ti == 0) ? pA0 : (ti == 1) ? pA1 : (ti == 2) ? pB0 : pB1;
                    const float hh = 0.5f * pt[4 * gq + 3] * inv; own[ti][gq] = (pt[4 * gq] + pt[4 * gq + 1] + pt[4 * gq + 2]) * inv + hh; recv[ti][gq] = __shfl_xor(hh, 32); }
#pragma unroll
            for (int ti = 0; ti < 4; ++ti)
#pragma unroll
                for (int gq = 0; gq < 4; ++gq) { const float pl = (gq > 0) ? recv[ti][gq > 0 ? gq - 1 : 0] : ((ti > 0) ? recv[ti > 0 ? ti - 1 : 0][3] : 0.f);
                    const float prev = hi ? recv[ti][gq] : pl;
                    IMPW[(wave * 32 + r32) * IMPW_P + 8 * ti + 2 * gq + hi] = own[ti][gq] + prev; }
            bf16x8 pa0, pa1, pa2, pa3;
#pragma unroll
            for (int d = 0; d < 4; ++d) o[d] = f32x16{};
            pack_p(pA0, pA1, pa0, pa1, pa2, pa3); SBAR(); pv_tile<VOFF0>(o, C.vb0, pa0, pa1, pa2, pa3);
            pack_p(pB0, pB1, pa0, pa1, pa2, pa3); SBAR(); pv_tile<VOFF1>(o, C.vb0, pa0, pa1, pa2, pa3);
            if (hi == 0) C.li_l[r32] = sigmoidf_(gz0) * inv;
            asm volatile("s_waitcnt lgkmcnt(0)" ::: "memory");
#pragma unroll
            for (int q2 = 0; q2 < 8; ++q2) { const float w0 = C.li_l[crow(2 * q2, hi)], w1 = C.li_l[crow(2 * q2 + 1, hi)];
#pragma unroll
                for (int d = 0; d < 4; ++d) otot[d][q2] = cvtpk(o[d][2 * q2] * w0, o[d][2 * q2 + 1] * w1); }
        }
        __syncthreads();
        const int w_lowk = t0 - 511, w_jlo = w_lowk > 0 ? w_lowk / KVBLK : 0, w_NT = qb + 1 - w_jlo;
        const bf16* KgW = P + (size_t)b * SEQ * NSA_NP + PC_KVW + g * 128;
        { NA_VMWAIT(0); NA_DMA(KgW, KgW + 256, NSA_NP, w_jlo * KVBLK, KOFF0, VOFF0); if (w_NT > 1) NA_DMA(KgW, KgW + 256, NSA_NP, (w_jlo + 1) * KVBLK, KOFF1, VOFF1); }
        if (wave == 0) {
            float imp[32];
#pragma unroll
            for (int n = 0; n < 32; ++n) { float s = 0.f;
#pragma unroll
                for (int w = 0; w < 8; ++w) s += IMPW[(w * 32 + r32) * IMPW_P + n];
                imp[n] = s; }
            unsigned selbits;
            if (qb < 8) selbits = (2u << qb) - 1u;
            else { selbits = 1u | (1u << qb);
                for (int t = 0; t < 6; ++t) { float best = -3.0e38f; int bi = 0;
#pragma unroll
                    for (int n = 1; n < 32; ++n) { const bool c = (n < qb) && !((selbits >> n) & 1u) && (imp[n] > best); best = c ? imp[n] : best; bi = c ? n : bi; }
                    selbits |= 1u << bi; } }
            if (hi == 0) SELB[r32] = selbits;
            unsigned un = selbits;
#pragma unroll
            for (int o_ = 1; o_ < 32; o_ <<= 1) un |= (unsigned)__shfl_xor((int)un, o_);
            if (lane == 0) { int cnt = 0; for (int n = 0; n < 32; ++n) if ((un >> n) & 1u) { TL[cnt] = n; ++cnt; } TL[32] = cnt; }
        }
        __syncthreads();
        { const float* cs = ROPE + (size_t)(row0 + r32) * 32 + hi * 16;
          u32x4 w0, w1; unsigned a0[4], a1[4];
#pragma unroll
          for (int q2 = 0; q2 < 4; ++q2) { const f32x4 t = *(const f32x4*)(cs + 4 * q2);
              const float x1a = bf2f((unsigned short)qr[0][2 * q2]), x1b = bf2f((unsigned short)qr[0][2 * q2 + 1]), x2a = bf2f((unsigned short)qr[1][2 * q2]), x2b = bf2f((unsigned short)qr[1][2 * q2 + 1]);
              a0[q2] = pk2(x1a * t[0] - x2a * t[1], x1b * t[2] - x2b * t[3]); a1[q2] = pk2(x2a * t[0] + x1a * t[1], x2b * t[2] + x1b * t[3]); }
          w0 = (u32x4){a0[0], a0[1], a0[2], a0[3]}; w1 = (u32x4){a1[0], a1[1], a1[2], a1[3]};
          qr[0] = __builtin_bit_cast(bf16x8, w0); qr[1] = __builtin_bit_cast(bf16x8, w1); }
        float l_reg;
        { tile_loop<1, true>(o, l_reg, qr, KgW, KgW + 256, NSA_NP, w_NT, w_jlo, TL, 0u, qb, pos, t0, C);
          if (hi == 0) C.li_l[r32] = sigmoidf_(gz2) / l_reg;
          asm volatile("s_waitcnt lgkmcnt(0)" ::: "memory");
#pragma unroll
          for (int q2 = 0; q2 < 8; ++q2) { const float w0 = C.li_l[crow(2 * q2, hi)], w1 = C.li_l[crow(2 * q2 + 1, hi)];
#pragma unroll
              for (int d = 0; d < 4; ++d) otot[d][q2] = cvtpk(bflo(otot[d][q2]) + o[d][2 * q2] * w0, bfhi(otot[d][q2]) + o[d][2 * q2 + 1] * w1); } }
        { const unsigned myb = SELB[r32]; const int NT = TL[32];
          const bf16* Kg = P + (size_t)b * SEQ * NSA_NP + PC_KVS + g * 128;
          tile_loop<0>(o, l_reg, qr, Kg, Kg + 256, NSA_NP, NT, 0, TL, myb, qb, pos, t0, C);
          if (hi == 0) C.li_l[r32] = sigmoidf_(gz1) / l_reg;
          asm volatile("s_waitcnt lgkmcnt(0)" ::: "memory");
#pragma unroll
          for (int q2 = 0; q2 < 8; ++q2) { const float w0 = C.li_l[crow(2 * q2, hi)], w1 = C.li_l[crow(2 * q2 + 1, hi)];
#pragma unroll
              for (int d = 0; d < 4; ++d) otot[d][q2] = cvtpk(bflo(otot[d][q2]) + o[d][2 * q2] * w0, bfhi(otot[d][q2]) + o[d][2 * q2 + 1] * w1); } }
#pragma unroll
        for (int q2 = 0; q2 < 8; ++q2) { bf16* orow = O + (size_t)(row0 + crow(2 * q2, hi)) * DM + h * 128;
#pragma unroll
            for (int d = 0; d < 4; ++d) { const unsigned mine = otot[d][q2]; const unsigned nb = (unsigned)__shfl_xor((int)mine, 1);
                if ((r32 & 1) == 0) { *(unsigned*)(orow + d * 32 + r32) = (mine & 0xffffu) | (nb << 16); *(unsigned*)(orow + DM + d * 32 + r32) = (mine >> 16) | (nb & 0xffff0000u); } } }
    }
}
namespace ml4 {
using na::bf16x8; using na::s16x4; using na::f32x16; using na::u32x4;
constexpr int NGRP = 8, GCH = 4;
constexpr int BUF = 49152, T_KT = 0, T_V0 = 16384, T_V1 = 32768;
constexpr int B2_K = 2 * BUF, B2_Q = 2 * BUF + 16384;
constexpr int OFF_WS = 3 * BUF, OFF_AQ = OFF_WS + 8192, OFF_BQ = OFF_AQ + 1024, OFF_GI = OFF_BQ + 1024, OFF_EM = OFF_GI + 1024, OFF_DEC = OFF_EM + 1024, OFF_INV = OFF_DEC + 128, OFF_QN = OFF_INV + 2048,
              OFF_END = OFF_QN + 1024;
constexpr int TMP_F = 0, TMP_B = 8192, TMP_DMX = 16384, TMP_W = 24576, TMP_CH = 32768;
static_assert(OFF_END <= MISC_OFF, "mlstm4 LDS map");
#define M4_TRRD(dst, addr, off) asm volatile("ds_read_b64_tr_b16 %0, %1 offset:%2" : "=&v"(dst) : "v"(addr), "i"(off) : "memory")
#define M4_LDSWAIT() do { asm volatile("s_waitcnt lgkmcnt(0)" ::: "memory"); __builtin_amdgcn_sched_barrier(0); } while (0)
#define M4_FRAG(l_, h_) ((bf16x8){l_[0], l_[1], l_[2], l_[3], h_[0], h_[1], h_[2], h_[3]})
__device__ __forceinline__ void state_step(f32x16 (&cst)[4], f32x16& ntile, int vbK, int vbV, const LAS float* wsp, float dec, int wave, int r32) {
#pragma unroll
    for (int kt = 0; kt < 4; ++kt)
#pragma unroll
        for (int r = 0; r < 16; ++r) cst[kt][r] *= dec;
    if (wave < 4) {
#pragma unroll
        for (int r = 0; r < 16; ++r) ntile[r] *= dec; }
#pragma unroll
    for (int ks = 0; ks < 4; ++ks) {
        s16x4 vl, vh, kl0, kh0, kl1, kh1, kl2, kh2, kl3, kh3;
        M4_TRRD(vl, vbV, ks * 4096); M4_TRRD(vh, vbV, ks * 4096 + 2048);
        M4_TRRD(kl0, vbK, ks * 4096); M4_TRRD(kh0, vbK, ks * 4096 + 2048); M4_TRRD(kl1, vbK, 512 + ks * 4096); M4_TRRD(kh1, vbK, 512 + ks * 4096 + 2048);
        M4_TRRD(kl2, vbK, 1024 + ks * 4096); M4_TRRD(kh2, vbK, 1024 + ks * 4096 + 2048); M4_TRRD(kl3, vbK, 1536 + ks * 4096); M4_TRRD(kh3, vbK, 1536 + ks * 4096 + 2048);
        const f32x4 w0 = *(const LAS f32x4*)(wsp + 16 * ks), w1 = *(const LAS f32x4*)(wsp + 16 * ks + 4);
        M4_LDSWAIT();
        u32x4 sv;
        sv.x = na::cvtpk(bf2f((unsigned short)vl[0]) * w0.x, bf2f((unsigned short)vl[1]) * w0.y); sv.y = na::cvtpk(bf2f((unsigned short)vl[2]) * w0.z, bf2f((unsigned short)vl[3]) * w0.w);
        sv.z = na::cvtpk(bf2f((unsigned short)vh[0]) * w1.x, bf2f((unsigned short)vh[1]) * w1.y); sv.w = na::cvtpk(bf2f((unsigned short)vh[2]) * w1.z, bf2f((unsigned short)vh[3]) * w1.w);
        const bf16x8 vs = __builtin_bit_cast(bf16x8, sv);
        const bf16x8 ka0 = M4_FRAG(kl0, kh0), ka1 = M4_FRAG(kl1, kh1), ka2 = M4_FRAG(kl2, kh2), ka3 = M4_FRAG(kl3, kh3);
        cst[0] = __builtin_amdgcn_mfma_f32_32x32x16_bf16(ka0, vs, cst[0], 0, 0, 0);
        cst[1] = __builtin_amdgcn_mfma_f32_32x32x16_bf16(ka1, vs, cst[1], 0, 0, 0);
        cst[2] = __builtin_amdgcn_mfma_f32_32x32x16_bf16(ka2, vs, cst[2], 0, 0, 0);
        cst[3] = __builtin_amdgcn_mfma_f32_32x32x16_bf16(ka3, vs, cst[3], 0, 0, 0);
        if (wave < 4) {
            u32x4 nw; nw.x = na::cvtpk(w0.x, w0.y); nw.y = na::cvtpk(w0.z, w0.w); nw.z = na::cvtpk(w1.x, w1.y); nw.w = na::cvtpk(w1.z, w1.w);
            if (r32 != 0) nw = (u32x4){0u, 0u, 0u, 0u};
            const bf16x8 nb = __builtin_bit_cast(bf16x8, nw);
            if (wave == 0) ntile = __builtin_amdgcn_mfma_f32_32x32x16_bf16(ka0, nb, ntile, 0, 0, 0);
            else if (wave == 1) ntile = __builtin_amdgcn_mfma_f32_32x32x16_bf16(ka1, nb, ntile, 0, 0, 0);
            else if (wave == 2) ntile = __builtin_amdgcn_mfma_f32_32x32x16_bf16(ka2, nb, ntile, 0, 0, 0);
            else ntile = __builtin_amdgcn_mfma_f32_32x32x16_bf16(ka3, nb, ntile, 0, 0, 0);
        }
    }
}
}

__device__ __forceinline__ void phase_ml_rec4(const int PROBE, const Ptrs& A, int jl, LAS unsigned char* lds, int G, int vcu, int wave, int lane_in, int tid_in) {
    using namespace na; using namespace ml4;
    const bf16* P = (const bf16*)(A.ws + WS_P); const float* GT = (const float*)(A.ws + WS_GATES); bf16* HRAW = (bf16*)(A.ws + WS_HRAW);
    LAS float* t_f = (LAS float*)(lds + TMP_F); LAS float* t_b = (LAS float*)(lds + TMP_B); LAS float* t_dmx = (LAS float*)(lds + TMP_DMX); LAS float* t_w = (LAS float*)(lds + TMP_W);
    LAS float* c_fe = (LAS float*)(lds + TMP_CH); LAS float* c_am = c_fe + 32; LAS float* c_m0 = c_am + 32; LAS float* c_inj = c_m0 + 32;
    LAS float* f_ws = (LAS float*)(lds + OFF_WS); LAS float* f_aq = (LAS float*)(lds + OFF_AQ); LAS float* f_bq = (LAS float*)(lds + OFF_BQ); LAS float* f_gi = (LAS float*)(lds + OFF_GI);
    LAS float* f_em = (LAS float*)(lds + OFF_EM); LAS float* f_dec = (LAS float*)(lds + OFF_DEC); LAS float* s_inv = (LAS float*)(lds + OFF_INV) + wave * 64; LAS float* s_qn = (LAS float*)(lds + OFF_QN);
    LAS char* const ldsc = (LAS char*)lds;
#define M4_LANEVARS() int ln_ = lane_in; asm volatile("" : "+v"(ln_)); const int r32 = ln_ & 31, hi = ln_ >> 5; const int vb0 = (int)(unsigned long long)ldsc + v_rd_base(ln_); (void)r32; (void)hi; (void)vb0; \
        Ctx Cc; Cc.wave = wave; dma_coords(Cc, ln_); const unsigned vo0 = (unsigned)(Cc.vkey[0] * ML_NP + Cc.vcol[0]), vo1 = (unsigned)(Cc.vkey[1] * ML_NP + Cc.vcol[1]), \
        ko0 = (unsigned)(Cc.krow[0] * ML_NP + (Cc.kcolb[0] >> 1)), ko1 = (unsigned)(Cc.krow[1] * ML_NP + (Cc.kcolb[1] >> 1)); (void)vo0; (void)vo1; (void)ko0; (void)ko1
    for (int unit = vcu; unit < 32 * NGRP; unit += G) {
        const int bh = unit / NGRP, g = unit % NGRP, b = bh >> 3, h = bh & 7, c0 = g * GCH;
        int lane = lane_in, tid = tid_in; asm volatile("" : "+v"(lane), "+v"(tid));
        __syncthreads();
        const bf16* Pb = P + (size_t)(b * SEQ) * ML_NP; const bf16* Kg = Pb + MC_K + h * 128; const bf16* Qg = Pb + MC_Q + h * 128; const bf16* Vg = Pb + MC_V + h * 256;
#define M4_DMA2(src, row0, ldsoff, o0_, o1_) do { const bf16* s_ = (src) + (size_t)(row0) * ML_NP; LAS char* d_ = ldsc + (ldsoff) + wave * 2048; unsigned o0 = (o0_), o1 = (o1_); asm volatile("" : "+v"(o0), "+v"(o1));     \
            __builtin_amdgcn_global_load_lds((const unsigned*)(s_ + o0), (LAS unsigned*)d_, 16, 0, 0); __builtin_amdgcn_global_load_lds((const unsigned*)(s_ + o1), (LAS unsigned*)(d_ + 1024), 16, 0, 0); } while (0)
#define M4_DMA_VL(src, row0, ldsoff) M4_DMA2(src, row0, ldsoff, vo0, vo1)
#define M4_DMA_KS(src, row0, ldsoff) M4_DMA2(src, row0, ldsoff, ko0, ko1)
#define M4_DMA_STATE(c_, bo_) do { M4_DMA_VL(Kg, (c_) * 64, (bo_) + T_KT); M4_DMA_VL(Vg, (c_) * 64, (bo_) + T_V0); M4_DMA_VL(Vg + 128, (c_) * 64, (bo_) + T_V1); } while (0)
#define M4_DMA_QK(c_) do { M4_DMA_KS(Kg, (c_) * 64, B2_K); M4_DMA_KS(Qg, (c_) * 64, B2_Q); } while (0)
#ifndef M4_XCH
#define M4_XCH 1
#endif
        const bool xch = M4_XCH && (G >= 32 * NGRP);
        const int cs = xch ? c0 : 0, ns = xch ? ((g + 1 < NGRP) ? GCH : 0) : c0;
        const bool early_full = xch && ns == 0;
        NA_VMWAIT(0);
        { M4_LANEVARS();
          if (ns > 0) { M4_DMA_STATE(cs, BUF); if (ns > 1) M4_DMA_STATE(cs + 1, 2 * BUF); }
          else if (early_full) { M4_DMA_STATE(c0, BUF); M4_DMA_QK(c0); } }
        { float li[4], F[4], dm[4], Fend[4], amax[4];
#pragma unroll
          for (int cc = 0; cc < 4; ++cc) { const size_t grow = (size_t)(b * SEQ + (wave * 4 + cc) * 64 + lane) * 16; li[cc] = GT[grow + h]; F[cc] = GT[grow + 8 + h]; }
#pragma unroll
          for (int o = 1; o < 64; o <<= 1) {
#pragma unroll
              for (int cc = 0; cc < 4; ++cc) { const float t = __shfl_up(F[cc], o); if (lane >= o) F[cc] += t; } }
#pragma unroll
          for (int cc = 0; cc < 4; ++cc) { Fend[cc] = __shfl(F[cc], 63); amax[cc] = Fend[cc] - F[cc] + li[cc]; dm[cc] = li[cc] - F[cc]; }
#pragma unroll
          for (int o = 1; o < 64; o <<= 1) {
#pragma unroll
              for (int cc = 0; cc < 4; ++cc) { amax[cc] = fmaxf(amax[cc], __shfl_xor(amax[cc], o)); const float t = __shfl_up(dm[cc], o); if (lane >= o) dm[cc] = fmaxf(dm[cc], t); } }
#pragma unroll
          for (int cc = 0; cc < 4; ++cc) { const int c = wave * 4 + cc, tk = c * 64 + lane; const float a = Fend[cc] - F[cc] + li[cc];
              t_f[tk] = F[cc]; t_b[tk] = li[cc] - F[cc]; t_w[tk] = __expf(a - amax[cc]); t_dmx[tk] = F[cc] + dm[cc];
              if (lane == 0) { c_fe[c] = Fend[cc]; c_am[c] = amax[cc]; } } }
        __syncthreads();
        if (wave == 0) {
            const int c = lane & 31; const float fe = c_fe[c], am = c_am[c]; float sa = fe, sb = am;
#pragma unroll
            for (int o = 1; o < 32; o <<= 1) { const float pa = __shfl_up(sa, o), pb = __shfl_up(sb, o); if (c >= o) { sb = fmaxf(pb + sa, sb); sa = pa + sa; } }
            const float mn = fmaxf(sa, sb);
            float m = __shfl_up(mn, 1); if (c == 0) m = 0.f;
            if (lane < 32) { c_m0[c] = m; f_dec[c] = __expf(fe + m - mn); c_inj[c] = __expf(am - mn); } }
        __syncthreads();
        for (int tk = tid; tk < 2048; tk += NTHREADS) { const int c = tk >> 6; const float F = t_f[tk]; const float inter = F + c_m0[c]; const float mt = fmaxf(inter, t_dmx[tk]);
            f_ws[tk] = t_w[tk] * c_inj[c];
            const int lc = c - c0;
            if ((unsigned)lc < (unsigned)GCH) { const int i = lc * 64 + (tk & 63);
                f_aq[i] = (F - mt) * 1.4426950408889634f - 3.5f  ; f_bq[i] = t_b[tk] * 1.4426950408889634f; f_gi[i] = __expf(inter - mt) * ATT_SCALE; f_em[i] = __expf(-mt); } }
        __syncthreads();
        f32x16 cst[4]; f32x16 ntile = f32x16{};
#pragma unroll
        for (int kt = 0; kt < 4; ++kt) cst[kt] = f32x16{};
        const int vsl = ((wave >> 2) ? T_V1 : T_V0) + (wave & 3) * 512;
        if (ns > 0) {
#pragma unroll 1
            for (int t = 0, bo = BUF; t < ns; ++t) {
                M4_LANEVARS();
                if (t + 1 < ns) NA_VMWAIT(6); else NA_VMWAIT(0);
                NA_BAR();
                if (t + 2 < ns) { const int bn = (bo >= BUF) ? bo - BUF : bo + 2 * BUF; M4_DMA_STATE(cs + t + 2, bn); }
                state_step(cst, ntile, vb0 + bo + T_KT, vb0 + bo + vsl, f_ws + (cs + t) * 64 + 8 * hi, f_dec[cs + t], wave, r32);
                bo = (bo == 2 * BUF) ? 0 : bo + BUF;
            }
            NA_BAR();
        }
        if (xch) {
            unsigned* flags = (unsigned*)(A.ws + WS_CTL + 131072 + jl * 2048);
            float* LX = (float*)(A.ws + WS_U + ((size_t)64 << 20));
            constexpr size_t LX_UNIT = 8 * 20 * 256, LX_WAVE = 20 * 256;
            int lane2 = lane; asm volatile("" : "+v"(lane2));
            if (ns > 0) {
                float* lx = LX + (size_t)unit * LX_UNIT + wave * LX_WAVE + lane2 * 4;
#pragma unroll
                for (int kt = 0; kt < 4; ++kt)
#pragma unroll
                    for (int q = 0; q < 4; ++q) *(f32x4*)(lx + (kt * 4 + q) * 256) = (f32x4){cst[kt][4 * q], cst[kt][4 * q + 1], cst[kt][4 * q + 2], cst[kt][4 * q + 3]};
                if (wave < 4) {
#pragma unroll
                    for (int q = 0; q < 4; ++q) *(f32x4*)(lx + (16 + q) * 256) = (f32x4){ntile[4 * q], ntile[4 * q + 1], ntile[4 * q + 2], ntile[4 * q + 3]}; }
                asm volatile("s_waitcnt vmcnt(0)" ::: "memory");
                __syncthreads();
                if (tid == 0) { __builtin_amdgcn_fence(__ATOMIC_RELEASE, "agent"); asm volatile("s_waitcnt vmcnt(0)" ::: "memory"); __hip_atomic_store(&flags[unit], 1u, __ATOMIC_RELAXED, __HIP_MEMORY_SCOPE_AGENT); }
            }
            if (!early_full) { M4_LANEVARS(); M4_DMA_STATE(c0, BUF); M4_DMA_QK(c0); }
#pragma unroll
            for (int kt = 0; kt < 4; ++kt) cst[kt] = f32x16{};
            ntile = f32x16{};
            if (g > 0) {
                if (tid == 0) {
                    for (int gp = 0; gp < g; ++gp) { unsigned sp = 0u;
                        while (__hip_atomic_load(&flags[unit - g + gp], __ATOMIC_RELAXED, __HIP_MEMORY_SCOPE_AGENT) == 0u) { __builtin_amdgcn_s_sleep(1); if (++sp > (1u << 22)) break; } }
                    __builtin_amdgcn_fence(__ATOMIC_ACQUIRE, "agent"); asm volatile("s_waitcnt vmcnt(0)" ::: "memory"); }
                __syncthreads();
                float coef = 1.f;
#pragma unroll 1
                for (int gp = g - 1; gp >= 0; --gp) { const float* lp = LX + (size_t)(unit - g + gp) * LX_UNIT + wave * LX_WAVE + lane2 * 4;
#pragma unroll
                    for (int kt = 0; kt < 4; ++kt)
#pragma unroll
                        for (int q = 0; q < 4; ++q) { const f32x4 v = *(const f32x4*)(lp + (kt * 4 + q) * 256);
                            cst[kt][4 * q] += coef * v.x; cst[kt][4 * q + 1] += coef * v.y; cst[kt][4 * q + 2] += coef * v.z; cst[kt][4 * q + 3] += coef * v.w; }
                    if (wave < 4) {
#pragma unroll
                        for (int q = 0; q < 4; ++q) { const f32x4 v = *(const f32x4*)(lp + (16 + q) * 256);
                            ntile[4 * q] += coef * v.x; ntile[4 * q + 1] += coef * v.y; ntile[4 * q + 2] += coef * v.z; ntile[4 * q + 3] += coef * v.w; } }
                    coef *= (f_dec[4 * gp] * f_dec[4 * gp + 1]) * (f_dec[4 * gp + 2] * f_dec[4 * gp + 3]); }
            }
        }
        if (!xch) { NA_VMWAIT(0); M4_LANEVARS(); M4_DMA_STATE(c0, BUF); M4_DMA_QK(c0); }
#pragma unroll 1
        for (int j = 0; j < (PROBE == 2 ? 0 : GCH); ++j) { const int c = c0 + j, bo = ((j & 1) ^ 1) * BUF, lt = j * 64;
            NA_VMWAIT(0);
            NA_BAR();
            if (j + 1 < GCH) { M4_LANEVARS(); M4_DMA_STATE(c + 1, BUF - bo); }
            int ln_ = lane_in; asm volatile("" : "+v"(ln_)); const int r32 = ln_ & 31, hi = ln_ >> 5; const int vb0 = (int)(unsigned long long)ldsc + v_rd_base(ln_);
            f32x16 hn0, hn1; float rs0, rs1;
#define M4_KADDR(T, d) (kb4[(d) & 3] + ((d) >> 2) * 128 + (T) * 8192)
#define M4_QADDR(QT, d) (kb4[(d) & 3] + (B2_Q - B2_K) + ((d) >> 2) * 128 + (QT) * 8192)
#define M4_STILE(QT, T, PA0, PA1) do { f32x16 pt = f32x16{}; bf16x8 kf0[4], kf1[4];                                                                              \
                _Pragma("unroll") for (int i = 0; i < 4; ++i) kf0[i] = *(const LAS bf16x8*)M4_KADDR(T, i);                                                        \
                SBAR();                                                                                                                                           \
                _Pragma("unroll") for (int i = 0; i < 4; ++i) kf1[i] = *(const LAS bf16x8*)M4_KADDR(T, 4 + i);                                                    \
                f32x4 bq[4];                                                                                                                                      \
                _Pragma("unroll") for (int g4 = 0; g4 < 4; ++g4) bq[g4] = *(const LAS f32x4*)(f_bq + lt + 32 * (T) + 8 * g4 + 4 * hi);     \
                _Pragma("unroll") for (int i = 0; i < 4; ++i) pt = __builtin_amdgcn_mfma_f32_32x32x16_bf16(kf0[i], qr[i], pt, 0, 0, 0);                           \
                SBAR();                                                                                                                                           \
                _Pragma("unroll") for (int i = 0; i < 4; ++i) pt = __builtin_amdgcn_mfma_f32_32x32x16_bf16(kf1[i], qr[4 + i], pt, 0, 0, 0);                       \
                SBAR();                                                                                                                                           \
                _Pragma("unroll") for (int r = 0; r < 16; ++r) { const float e_ = __builtin_amdgcn_exp2f(aql + bq[r >> 2][r & 3]);                                \
                    const float wgt = ((T) != (QT) || crow(r, hi) <= r32) ? e_ : 0.f; pt[r] *= wgt; rs += pt[r]; }                                                \
                NA_PK4(pt, 0, PA0); NA_PK4(pt, 8, PA1); SBAR(); } while (0)
#define M4_QT(QT, HN, RS) do { const int l = 32 * (QT) + r32; bf16x8 qr[8];                                                                                     \
                _Pragma("unroll") for (int d = 0; d < 8; ++d) qr[d] = *(const LAS bf16x8*)M4_QADDR(QT, d);                                                        \
                const float aql = f_aq[lt + l];                                                                                                                   \
                if (wave < 4) { const bf16x8 qa = *(const LAS bf16x8*)(ldsc + B2_Q + KSWZ(l, 64 * wave + 16 * hi)), qb = *(const LAS bf16x8*)(ldsc + B2_Q + KSWZ(l, 64 * wave + 32 + 16 * hi)); \
                    bf16x8 n0, n1; NA_PK4(ntile, 0, n0); NA_PK4(ntile, 8, n1); f32x16 qn = f32x16{};                                                              \
                    qn = __builtin_amdgcn_mfma_f32_32x32x16_bf16(qa, n0, qn, 0, 0, 0); qn = __builtin_amdgcn_mfma_f32_32x32x16_bf16(qb, n1, qn, 0, 0, 0);        \
                    if (r32 == 0) { _Pragma("unroll") for (int r = 0; r < 16; ++r) s_qn[wave * 64 + 32 * (QT) + crow(r, hi)] = qn[r]; } }                         \
                SBAR(); float rs = 0.f; bf16x8 pa0, pa1, pa2, pa3;                                                                                                \
                M4_STILE(QT, 0, pa0, pa1);                                                                                                                        \
                if ((QT) == 1) M4_STILE(QT, 1, pa2, pa3);                                                                                                         \
                { auto rr = __builtin_amdgcn_permlane32_swap(__float_as_uint(rs), __float_as_uint(rs), false, false); rs = __uint_as_float(rr[0]) + __uint_as_float(rr[1]); } \
                RS = rs;                                                                                                                                          \
                f32x16 o = f32x16{}; const int vbV = vb0 + bo + vsl; s16x4 l0, h0, l1, h1, l2, h2, l3, h3;                                                         \
                M4_TRRD(l0, vbV, 0); M4_TRRD(h0, vbV, 2048); M4_TRRD(l1, vbV, 4096); M4_TRRD(h1, vbV, 6144);                                                      \
                if ((QT) == 1) { M4_TRRD(l2, vbV, 8192); M4_TRRD(h2, vbV, 10240); M4_TRRD(l3, vbV, 12288); M4_TRRD(h3, vbV, 14336); }                             \
                M4_LDSWAIT();                                                                                                                                     \
                o = __builtin_amdgcn_mfma_f32_32x32x16_bf16(pa0, M4_FRAG(l0, h0), o, 0, 0, 0); o = __builtin_amdgcn_mfma_f32_32x32x16_bf16(pa1, M4_FRAG(l1, h1), o, 0, 0, 0); \
                if ((QT) == 1) { o = __builtin_amdgcn_mfma_f32_32x32x16_bf16(pa2, M4_FRAG(l2, h2), o, 0, 0, 0); o = __builtin_amdgcn_mfma_f32_32x32x16_bf16(pa3, M4_FRAG(l3, h3), o, 0, 0, 0); } \
                f32x16 oc = f32x16{}; f32x4 giv[4];                                                                                                               \
                _Pragma("unroll") for (int g4 = 0; g4 < 4; ++g4) giv[g4] = *(const LAS f32x4*)(f_gi + lt + 32 * (QT) + 8 * g4 + 4 * hi);                          \
                _Pragma("unroll") for (int kt = 0; kt < 4; ++kt) { bf16x8 cb0, cb1; NA_PK4(cst[kt], 0, cb0); NA_PK4(cst[kt], 8, cb1);                              \
                    oc = __builtin_amdgcn_mfma_f32_32x32x16_bf16(qr[2 * kt], cb0, oc, 0, 0, 0); oc = __builtin_amdgcn_mfma_f32_32x32x16_bf16(qr[2 * kt + 1], cb1, oc, 0, 0, 0); } \
                SBAR();                                                                                                                                           \
                _Pragma("unroll") for (int r = 0; r < 16; ++r) HN[r] = o[r] + giv[r >> 2][r & 3] * oc[r]; SBAR(); } while (0)
            const LAS char* kb4[4];
#pragma unroll
            for (int dd = 0; dd < 4; ++dd) kb4[dd] = ldsc + B2_K + KSWZ(r32, 32 * dd + 16 * hi);
            asm volatile("s_nop 7\n\ts_nop 7\n\ts_nop 7" ::: "memory");
            M4_QT(0, hn0, rs0);
            M4_QT(1, hn1, rs1);
#undef M4_QT
#undef M4_STILE
#undef M4_KADDR
#undef M4_QADDR
            NA_BAR();
            if (j + 1 < GCH) { M4_LANEVARS(); M4_DMA_QK(c + 1); }
            { const float qn0 = (s_qn[r32] + s_qn[64 + r32]) + (s_qn[128 + r32] + s_qn[192 + r32]), qn1 = (s_qn[32 + r32] + s_qn[96 + r32]) + (s_qn[160 + r32] + s_qn[224 + r32]);
              const float d0 = rs0 + f_gi[lt + r32] * qn0, d1 = rs1 + f_gi[lt + 32 + r32] * qn1;
              const float i0 = 1.0f / fmaxf(fabsf(d0), f_em[lt + r32]), i1 = 1.0f / fmaxf(fabsf(d1), f_em[lt + 32 + r32]);
              if (hi == 0) { s_inv[r32] = i0; s_inv[32 + r32] = i1; } }
#define M4_OUT(QT, HN) do { bf16* hp = HRAW + (size_t)(b * SEQ + c * 64 + 32 * (QT)) * DM + h * 256 + wave * 32 + r32; f32x4 iv[4];     \
              _Pragma("unroll") for (int g4 = 0; g4 < 4; ++g4) iv[g4] = *(const LAS f32x4*)(s_inv + 32 * (QT) + 8 * g4 + 4 * hi);                                  \
              _Pragma("unroll") for (int r = 0; r < 16; r += 2) { const int row = crow(r, hi); const unsigned w0 = cvtpk(HN[r] * iv[r >> 2][r & 3], HN[r + 1] * iv[r >> 2][(r & 3) + 1]); \
                  if (PROBE == 0) { hp[(size_t)row * DM] = (bf16)w0; hp[(size_t)(row + 1) * DM] = (bf16)(w0 >> 16); } else asm volatile("" :: "v"(w0)); } SBAR(); } while (0)
            M4_OUT(0, hn0); M4_OUT(1, hn1);
#undef M4_OUT
            if (j + 1 < GCH) state_step(cst, ntile, vb0 + bo + T_KT, vb0 + bo + vsl, f_ws + c * 64 + 8 * hi, f_dec[c], wave, r32);
        }
        asm volatile("s_waitcnt vmcnt(0)" ::: "memory");
        __syncthreads();
        if (PROBE == 0) { const bf16* HR = HRAW; bf16* Oo = (bf16*)(A.ws + WS_O); const float* hnw = A.ml_head_norm + (size_t)jl * DM + h * 256;
            int t2 = tid_in; asm volatile("" : "+v"(t2)); const int c8 = t2 & 31, rq = t2 >> 5, col = h * 256 + 8 * c8; const f32x4 ga = *(const f32x4*)(hnw + 8 * c8), gb2 = *(const f32x4*)(hnw + 8 * c8 + 4);
#pragma unroll 1
            for (int r0 = 0; r0 < 256; r0 += 64) {
                v4u hrv[4], ogv[4];
#pragma unroll
                for (int u = 0; u < 4; ++u) { const size_t row = (size_t)(b * SEQ + c0 * 64 + r0 + 16 * u + rq); hrv[u] = *(const v4u*)(HR + row * DM + col); ogv[u] = *(const v4u*)(P + row * ML_NP + MC_OG + col); }
#pragma unroll
                for (int u = 0; u < 4; ++u) { const size_t row = (size_t)(b * SEQ + c0 * 64 + r0 + 16 * u + rq); const v4u hr = hrv[u], og = ogv[u];
                    const f32x4 a = (f32x4){bflo(hr.x), bfhi(hr.x), bflo(hr.y), bfhi(hr.y)}, b2 = (f32x4){bflo(hr.z), bfhi(hr.z), bflo(hr.w), bfhi(hr.w)};
                    float ss = ((a.x * a.x + a.y * a.y) + (a.z * a.z + a.w * a.w)) + ((b2.x * b2.x + b2.y * b2.y) + (b2.z * b2.z + b2.w * b2.w));
#pragma unroll
                    for (int o = 1; o < 32; o <<= 1) ss += __shfl_xor(ss, o);
                    const float rstd = 1.0f / sqrtf(ss * (1.0f / 256.0f) + 1e-6f);
                    v4u o;
                    o.x = pk2(a.x * rstd * ga.x * sigmoidf_(bflo(og.x)), a.y * rstd * ga.y * sigmoidf_(bfhi(og.x)));
                    o.y = pk2(a.z * rstd * ga.z * sigmoidf_(bflo(og.y)), a.w * rstd * ga.w * sigmoidf_(bfhi(og.y)));
                    o.z = pk2(b2.x * rstd * gb2.x * sigmoidf_(bflo(og.z)), b2.y * rstd * gb2.y * sigmoidf_(bfhi(og.z)));
                    o.w = pk2(b2.z * rstd * gb2.z * sigmoidf_(bflo(og.w)), b2.w * rstd * gb2.w * sigmoidf_(bfhi(og.w)));
                    *(v4u*)(Oo + row * DM + col) = o; } }
        }
        NA_BAR();
#undef M4_DMA_VL
#undef M4_DMA2
#undef M4_LANEVARS
#undef M4_DMA_KS
#undef M4_DMA_STATE
#undef M4_DMA_QK
    }
}
__device__ __forceinline__ void phase_compress2(const Ptrs& A, int j_layer, LAS unsigned char* lds, int G, int vcu, int wave, int lane, int tid) {
    typedef short bf16x8 __attribute__((ext_vector_type(8))); typedef float f32x16 __attribute__((ext_vector_type(16)));
    const bf16* P = (const bf16*)(A.ws + WS_P); bf16* KC = (bf16*)(A.ws + WS_KC); bf16* VC = (bf16*)(A.ws + WS_VC);
    const float* pe = A.nsa_pe + (size_t)j_layer * 2 * 32 * 128;
    const bf16* W1T = (const bf16*)(A.ws + WS_W1T) + (size_t)j_layer * 2 * 32 * 128 * 128; const bf16* W2T = (const bf16*)(A.ws + WS_W2T) + (size_t)j_layer * 2 * 128 * 128;
    LAS float* part = (LAS float*)lds;
    LAS bf16* hidb = (LAS bf16*)(lds + RSTD_OFF);
    const int r32 = lane & 31, hi = lane >> 5;
    for (int unit = vcu; unit < 64; unit += G) {
        const int jt = unit & 3, g = (unit >> 2) & 1, b = (unit >> 3) & 3, c = unit >> 5, j0 = 32 * jt;
        const int jc = (j0 + r32 < NCMP) ? j0 + r32 : NCMP - 1;
        f32x16 acc[4];
#pragma unroll
        for (int nt = 0; nt < 4; ++nt) acc[nt] = f32x16{};
        for (int li = 0; li < 4; ++li) { const int l = wave * 4 + li;
            const bf16* arow = P + (size_t)(b * SEQ + 16 * jc + l) * NSA_NP + PC_KVC + c * 256 + g * 128 + hi * 8;
            const float* perow = pe + (size_t)(c * 32 + l) * 128 + hi * 8;
            const bf16* brow = W1T + ((size_t)(c * 32 + l) * 128 + r32) * 128 + hi * 8;
#pragma unroll
            for (int k2 = 0; k2 < 8; k2 += 2) {
                v4u xa[2]; f32x4 p0[2], p1[2]; bf16x8 bfr[2][4];
#pragma unroll
                for (int q = 0; q < 2; ++q) { const int ks = k2 + q; xa[q] = *(const v4u*)(arow + ks * 16); p0[q] = *(const f32x4*)(perow + ks * 16); p1[q] = *(const f32x4*)(perow + ks * 16 + 4);
#pragma unroll
                    for (int nt = 0; nt < 4; ++nt) bfr[q][nt] = *(const bf16x8*)(brow + (size_t)nt * 32 * 128 + ks * 16); }
#pragma unroll
                for (int q = 0; q < 2; ++q) {
                    v4u aw; aw.x = pk2(bflo(xa[q].x) + p0[q].x, bfhi(xa[q].x) + p0[q].y); aw.y = pk2(bflo(xa[q].y) + p0[q].z, bfhi(xa[q].y) + p0[q].w); aw.z = pk2(bflo(xa[q].z) + p1[q].x, bfhi(xa[q].z) + p1[q].y); aw.w = pk2(bflo(xa[q].w) + p1[q].z, bfhi(xa[q].w) + p1[q].w);
                    const bf16x8 af = __builtin_bit_cast(bf16x8, aw);
#pragma unroll
                    for (int nt = 0; nt < 4; ++nt) acc[nt] = __builtin_amdgcn_mfma_f32_32x32x16_bf16(af, bfr[q][nt], acc[nt], 0, 0, 0); } } }
        __syncthreads();
#pragma unroll
        for (int nt = 0; nt < 4; ++nt)
#pragma unroll
            for (int r = 0; r < 16; ++r) part[(wave * 32 + (r & 3) + 8 * (r >> 2) + 4 * hi) * 128 + nt * 32 + r32] = acc[nt][r];
        __syncthreads();
        { const int row = tid >> 4, h8 = (tid & 15) * 8; unsigned ow[4];
#pragma unroll
          for (int q = 0; q < 2; ++q) { f32x4 s = (f32x4){0.f, 0.f, 0.f, 0.f};
#pragma unroll
              for (int w = 0; w < 8; ++w) s += *(const LAS f32x4*)(part + (w * 32 + row) * 128 + h8 + 4 * q);
              float e[4];
#pragma unroll
              for (int i = 0; i < 4; ++i) { const float v = s[i]; e[i] = 0.5f * v * (1.0f + tanhf_(0.7978845608028654f * (v + 0.044715f * v * v * v))); }
              ow[2 * q] = pk2(e[0], e[1]); ow[2 * q + 1] = pk2(e[2], e[3]); }
          *(LAS v4u*)(hidb + row * 136 + h8) = (v4u){ow[0], ow[1], ow[2], ow[3]}; }
        __syncthreads();
        if (wave < 4) { const int nt = wave; f32x16 o = f32x16{};
            const bf16* brow = W2T + ((size_t)c * 128 + nt * 32 + r32) * 128 + hi * 8; bf16x8 bfw[8];
#pragma unroll
            for (int ks = 0; ks < 8; ++ks) bfw[ks] = *(const bf16x8*)(brow + ks * 16);
#pragma unroll
            for (int ks = 0; ks < 8; ++ks) { const bf16x8 af = *(const LAS bf16x8*)(hidb + r32 * 136 + ks * 16 + hi * 8); o = __builtin_amdgcn_mfma_f32_32x32x16_bf16(af, bfw[ks], o, 0, 0, 0); }
            bf16* dst = (c == 0 ? KC : VC) + ((size_t)(b * 2 + g) * 128 + j0) * 128 + nt * 32 + r32;
#pragma unroll
            for (int r = 0; r < 16; ++r) { const int row = (r & 3) + 8 * (r >> 2) + 4 * hi; dst[(size_t)row * 128] = (j0 + row < NCMP) ? (bf16)f2bf(o[r]) : (bf16)0; } }
    }
}
__device__ __forceinline__ Ptrs load_ptrs() {
    const void* const* kp = (const void* const*)__builtin_amdgcn_kernarg_segment_ptr();
    int z = 0; asm volatile("" : "+s"(z));
    Ptrs A;
    A.x = (const float*)kp[z + 0]; A.pos = (const int*)kp[z + 1];
    A.nsa_w_in = (const float*)kp[z + 2]; A.nsa_gate_b = (const float*)kp[z + 3]; A.nsa_pe = (const float*)kp[z + 4]; A.nsa_w1 = (const float*)kp[z + 5]; A.nsa_w2 = (const float*)kp[z + 6]; A.nsa_w_out = (const float*)kp[z + 7];
    A.ml_w_in = (const float*)kp[z + 8]; A.ml_gate_b = (const float*)kp[z + 9]; A.ml_head_norm = (const float*)kp[z + 10]; A.ml_w_out = (const float*)kp[z + 11];
    A.norm_mix = (const float*)kp[z + 12]; A.norm_ffn = (const float*)kp[z + 13]; A.w_up = (const float*)kp[z + 14]; A.conv_w = (const float*)kp[z + 15]; A.conv_b = (const float*)kp[z + 16]; A.w_down = (const float*)kp[z + 17]; A.norm_final = (const float*)kp[z + 18];
    A.out = (float*)kp[z + 19]; A.ws = (unsigned char*)kp[z + 20];
    return A;
}
constexpr int NPHASES = 30;
struct Args { const void* in[19]; float* out; unsigned char* ws; int ph_lo, ph_hi; };
__global__ void __launch_bounds__(NTHREADS, 2) fwd_kernel(Args args) {
    extern __shared__ __attribute__((aligned(16))) unsigned char lds_raw[];
    LAS unsigned char* lds = (LAS unsigned char*)lds_raw;
    volatile LAS unsigned* MISC = (volatile LAS unsigned*)(lds + MISC_OFF);
    const int G = gridDim.x; const int bx = blockIdx.x; const int vcu = (G % 8 == 0) ? (bx % 8) * (G / 8) + bx / 8 : bx;
    const int lo = args.ph_lo, hi = args.ph_hi;
    const int wv0 = __builtin_amdgcn_readfirstlane((int)threadIdx.x >> 6);
#define TIDX() ((wv0 << 6) | hw_lane())
    if (TIDX() < 32) MISC[TIDX()] = 0u;
    __syncthreads();
    XcdBarrier bar; bar.bar = (unsigned*)(args.ws + WS_CTL) + CW_BAR; bar.x = 0; bar.st = nullptr; bar.wv = wv0;
    if (hi - lo > 1) bar = xcd_barrier_post((unsigned*)(args.ws + WS_CTL) + CW_BAR, MISC + 8, wv0);
#ifndef DUP_MASK
#define DUP_MASK 0
#endif
#define DUP(bit) for (int rep_ = 0; rep_ < (((DUP_MASK) >> (bit)) & 1 ? 2 : 1); ++rep_)
#define IN(k) (lo <= (k) && (k) < hi)
#define SEAM(k) do { if (IN(k) && IN((k) + 1)) xcd_barrier(bar); } while (0)
#define SITE() const Ptrs A = load_ptrs(); int tid = TIDX(); asm volatile("" : "+v"(tid)); const int lane = tid & 63, wave = __builtin_amdgcn_readfirstlane(tid >> 6); (void)lane; (void)wave; \
    bf16* XB = (bf16*)(A.ws + WS_XB); float* XR = (float*)(A.ws + WS_XR); float* SSP = (float*)(A.ws + WS_SSP); bf16* P = (bf16*)(A.ws + WS_P); bf16* O = (bf16*)(A.ws + WS_O); (void)XB; (void)XR; (void)SSP; (void)P; (void)O

    if (IN(0)) { SITE(); DUP(0) phase_prologue(A, lds, G, vcu, wave, lane, tid); }
    SEAM(0);
    for (int layer = 0; layer < DEPTH; ++layer) {
        const int pb = 1 + 7 * layer; const bool nsa = (layer & 1) == 0; const int jl = layer >> 1;
        if (IN(pb)) { SITE();
            const int N = nsa ? NSA_NP : ML_NP;
            pg8::Gemm g{XB, (const bf16*)(A.ws + (nsa ? WS_WNSA + jl * SZ_WNSA : WS_WML + jl * SZ_WML)), MROWS, N, DM, wave}; pg8::StaticOrder S; S.init(MROWS, N, G, bx);
            LAS float* rtab = (LAS float*)(lds + RSTD_OFF); pg8::prep_rstd(SSP, S, rtab, tid);
            pg8::EpiProj E{P, N, rtab, nsa ? (const float*)(A.ws + WS_ROPE) : nullptr};
            DUP(1) pg8::gemm_phase<pg8::EpiProj, pg8::StaticOrder, true, true>(lds, g, S, E);
            if (!nsa) DUP(8) phase_ml_gates(A, jl, layer, G, vcu, wave, lane);
            if (nsa && layer + 1 < DEPTH) { const int rem = (32 * (NSA_NP / 256)) % G, n = cv_inslot_items(layer + 1, G);
                if (n > 0 && bx >= rem) { __syncthreads(); const int t0 = cv_tail_items(layer + 1, G); convert_layer(A, layer + 1, t0, t0 + n, (bx - rem) * NWAVES + wave, (G - rem) * NWAVES, (LAS float*)(lds + wave * 16640), lane); } }
        }
        SEAM(pb);
        if (IN(pb + 1)) { SITE();
            if (nsa) { DUP(2) phase_compress2(A, jl, lds, G, vcu, wave, lane, tid);
                if (vcu >= 64 && cv_slot_items(layer, G) > 0) convert_layer(A, layer, cv_layer_items(layer) - cv_slot_items(layer, G), cv_layer_items(layer), (vcu - 64) * NWAVES + wave, (G - 64) * NWAVES, (LAS float*)(lds + wave * 16640), lane); }
            else { for (int rep_ = 0; rep_ < (((DUP_MASK >> 13) & 7) ? 2 : 1); ++rep_) phase_ml_rec4(rep_ ? ((DUP_MASK >> 13) & 7) - 1 : 0, A, jl, lds, G, vcu, wave, lane, tid);
            }
        }
        SEAM(pb + 1);
        if (IN(pb + 2)) { SITE();
            if (nsa) DUP(3) phase_nsa_attn2(A, jl, lds, G, vcu, wave, lane, tid);
        }
        if (nsa) SEAM(pb + 2);
        if (IN(pb + 3)) { SITE();
            pg8::Gemm g{O, (const bf16*)(A.ws + WS_WOUT + layer * SZ_WOUT), MROWS, DM, DM, wave}; pg8::StaticOrder S; S.init(MROWS, DM, G, bx);
            pg8::EpiRes E{nullptr, XB, SSP};
            pg8::gemm_phase<pg8::EpiRes, pg8::StaticOrder, true, true>(lds, g, S, E);
        }
        SEAM(pb + 3);
        if (IN(pb + 4)) { SITE();
            pg8::Gemm g{XB, (const bf16*)(A.ws + WS_WUP + layer * SZ_WUP), MROWS, NUP, DM, wave}; pg8::StaticOrder S; S.init(MROWS, NUP, G, bx);
            LAS float* rtab = (LAS float*)(lds + RSTD_OFF); pg8::prep_rstd(SSP, S, rtab, tid);
            pg8::EpiUp E{(bf16*)(A.ws + WS_ACT), (float*)(A.ws + WS_U), A.conv_w + (size_t)layer * 3 * NUP, A.conv_b + (size_t)layer * NUP, rtab};
            DUP(6) pg8::gemm_phase<pg8::EpiUp, pg8::StaticOrder, true, true>(lds, g, S, E);
            {
              const int nwg = (MROWS / 256) * (NUP / 256), rem = nwg % G;
              if (layer + 1 < DEPTH && rem != 0 && bx >= rem) convert_layer(A, layer + 1, 0, cv_tail_items(layer + 1, G), (bx - rem) * NWAVES + wave, (G - rem) * NWAVES, (LAS float*)(lds + wave * 16640), lane); }
#if (DUP_MASK >> 9) & 1
            { pg8::EpiNull EN{(float*)(A.ws + WS_QR) + (A.pos[0] < 0 ? 0 : 0)}; EN.sink = (A.pos[0] == -12345) ? (float*)(A.ws + WS_QR) : nullptr; pg8::gemm_phase<pg8::EpiNull, pg8::StaticOrder, true, true>(lds, g, S, EN); }
#endif
        }
        SEAM(pb + 4);
        if (IN(pb + 5)) { SITE(); DUP(7) phase_fixup(A, layer, G, vcu, tid); }
        SEAM(pb + 5);
        if (IN(pb + 6)) { SITE();
            pg8::Gemm g{(const bf16*)(A.ws + WS_ACT), (const bf16*)(A.ws + WS_WDN + layer * SZ_WDN), MROWS, DM, DFF, wave}; pg8::StaticOrder S; S.init(MROWS, DM, G, bx);
            pg8::EpiRes E{nullptr, XB, SSP};
            pg8::gemm_phase<pg8::EpiRes, pg8::StaticOrder, true, true>(lds, g, S, E);
        }
        SEAM(pb + 6);
    }
#if (DUP_MASK >> 12) & 1
    if (hi - lo > 1) { for (int rep_ = 0; rep_ < 20; ++rep_) xcd_barrier(bar); }
#endif
    if (IN(29)) { SITE(); phase_final(A, G, vcu, wave, lane); }
#undef SITE
#undef IN
#undef SEAM
}

extern "C" void kernel_launch(void* const* d_in, const int* in_sizes, int n_in, void* d_out, int out_size, void* d_ws, size_t ws_size, hipStream_t stream) {
    static int grid = 0;
    if (grid == 0) {
        if (n_in != 19 || out_size != MROWS * DM || ws_size < WS_END) { fprintf(stderr, "kernel_launch: unexpected shapes (n_in %d, out %d, ws %zu, need %zu); nothing launched\n", n_in, out_size, ws_size, (size_t)WS_END); grid = -1; return; }
        int dev = 0, cus = 0, per_cu = 0;
        if (hipGetDevice(&dev) != hipSuccess || hipDeviceGetAttribute(&cus, hipDeviceAttributeMultiprocessorCount, dev) != hipSuccess) { fprintf(stderr, "kernel_launch: device query failed\n"); grid = -1; return; }
        if (hipFuncSetAttribute((const void*)fwd_kernel, hipFuncAttributeMaxDynamicSharedMemorySize, LDS_BYTES) != hipSuccess) { fprintf(stderr, "kernel_launch: hipFuncSetAttribute failed\n"); grid = -1; return; }
        if (hipOccupancyMaxActiveBlocksPerMultiprocessor(&per_cu, (const void*)fwd_kernel, NTHREADS, LDS_BYTES) != hipSuccess || per_cu < 1) fprintf(stderr, "kernel_launch: occupancy query reports %d blocks per CU\n", per_cu);
        (void)hipGetLastError();
        grid = cus;
    }
    if (grid < 0) return;
    (void)hipMemsetAsync((char*)d_ws + WS_CTL, 0, CTL_BYTES, stream);
    Args a{};
    for (int i = 0; i < 19; ++i) a.in[i] = d_in[i];
    a.out = (float*)d_out; a.ws = (unsigned char*)d_ws;
#if MK_ONE_LAUNCH
    a.ph_lo = 0; a.ph_hi = NPHASES;
    hipLaunchKernelGGL(fwd_kernel, dim3(grid), dim3(NTHREADS), LDS_BYTES, stream, a);
#else
    for (int p = 0; p < NPHASES; ++p) { a.ph_lo = p; a.ph_hi = p + 1; hipLaunchKernelGGL(fwd_kernel, dim3(grid), dim3(NTHREADS), LDS_BYTES, stream, a); }
#endif
}
```

```cpp
#include <hip/hip_runtime.h>
#include <cstdio>
#include <cstdint>
#define FIN_XCH_OFF 262144
#define FIN_CNT_OFF 196608
namespace pg8 {
#define PG8_LAS __attribute__((address_space(3)))
typedef unsigned short bf16_t;
typedef short bf16x8 __attribute__((ext_vector_type(8)));
typedef float f32x4 __attribute__((ext_vector_type(4)));
typedef unsigned u32x4 __attribute__((ext_vector_type(4)));
constexpr int BM = 256, BK = 64, HALF = 128, HTB = HALF * BK * 2  , STAGE_BYTES = 8 * HTB, NXCD = 8, WGM = 8;

__host__ __device__ __forceinline__ int lds_byte(int r, int c) { const int st = (r >> 4) * 2 + (c >> 5), rr = r & 15, cc = c & 31, ob = rr * 64 + cc * 2; return st * 1024 + (ob ^ (((ob >> 9) & 1) << 5)); }
__host__ __device__ __forceinline__ void stage_rc(int b, int& R, int& C) { const int st = b / 1024, sb = b % 1024, swz = sb ^ (((sb >> 9) & 1) << 5); R = (st >> 1) * 16 + swz / 64; C = (st & 1) * 32 + (swz % 64) / 2; }
__host__ __device__ __forceinline__ int perm32(int rho) { const int n = rho >> 4, i = rho & 15; return 8 * (i >> 2) + 4 * n + (i & 3); }

struct Unit { int pm, pn, idx; };
struct Gemm { const bf16_t* A; const bf16_t* Bt; int M, N, K, wv; };

struct StaticOrder {
    int nM, nN, nwg, G, c;
    __host__ __device__ void init(int M, int N, int G_, int c_) { nM = M / BM; nN = N / BM; nwg = nM * nN; G = G_; c = c_; }
    __host__ __device__ bool next(int i, Unit& u) const {
        const long L = (long)i * G + c; if (L >= nwg) return false;
        int wgid = (int)L; { const int q = nwg / NXCD, r = nwg % NXCD, xcd = wgid % NXCD, off = wgid / NXCD; wgid = (xcd < r ? xcd * (q + 1) : r * (q + 1) + (xcd - r) * q) + off; }
        const int nig = WGM * nN, gid = wgid / nig, fm = gid * WGM, gsz = (nM - fm) < WGM ? (nM - fm) : WGM;
        u.pm = fm + ((wgid % nig) % gsz); u.pn = (wgid % nig) / gsz; u.idx = i; return true;
    }
    __device__ __forceinline__ void a_ready(const Unit&) const {}
    __device__ __forceinline__ void done(const Unit&) const {}
};
__device__ __forceinline__ unsigned cvt_pk_bf16(float lo, float hi) { unsigned r; asm volatile("v_cvt_pk_bf16_f32 %0, %1, %2" : "=v"(r) : "v"(lo), "v"(hi)); return r; }
typedef float f32x2 __attribute__((ext_vector_type(2)));
constexpr int EP_ROWS = 8192;
template <class Sched> __device__ __forceinline__ void prep_rstd(const float* ssp, const Sched& S, PG8_LAS float* tab, int tid) {
    float pv[3][32]; int slot[3];
#pragma unroll
    for (int q = 0; q < 3; ++q) { const int idx = tid + 512 * q, i = idx >> 8, r = idx & 255; Unit u; slot[q] = -1;
        const bool ok = S.next(i, u); if (ok) slot[q] = idx; const float* p = ssp + (ok ? u.pm * BM + r : 0);
#pragma unroll
        for (int j = 0; j < 32; ++j) pv[q][j] = p[(size_t)j * EP_ROWS]; }
#pragma unroll
    for (int q = 0; q < 3; ++q) { float s[4] = {0.f, 0.f, 0.f, 0.f};
#pragma unroll
        for (int j = 0; j < 32; j += 4) { s[0] += pv[q][j]; s[1] += pv[q][j + 1]; s[2] += pv[q][j + 2]; s[3] += pv[q][j + 3]; }
        if (slot[q] >= 0) tab[slot[q]] = 1.0f / sqrtf(((s[0] + s[1]) + (s[2] + s[3])) * (1.0f / 2048.0f) + 1e-6f); }
    __syncthreads();
}
struct EpiProj {
    static constexpr bool PERM = true, AFTER_DRAIN = false, ROWPERM = false, PREFETCH = false;
    bf16_t* O; int ldc; const PG8_LAS float* rtab; const float* ropetab;
    __device__ __forceinline__ void operator()(const f32x4 (&acc)[2][2][4][2], const Unit& u, int wr, int wc, int fr, int fq) const {
        const int row0 = u.pm * BM + wr * 64 + fr, col0 = u.pn * BM + wc * 32 + 8 * fq;
        const bool rk = (ropetab != nullptr) && (wc == 0) && (u.pn == 10 || u.pn == 12);
#pragma unroll
        for (int ai = 0; ai < 2; ++ai) {
#pragma unroll
          for (int mp = 0; mp < 4; mp += 2) {
            f32x4 tt[2][4];
            if (rk) {
#pragma unroll
                for (int m = 0; m < 2; ++m)
#pragma unroll
                    for (int q = 0; q < 4; ++q) tt[m][q] = *(const f32x4*)(ropetab + (size_t)(row0 + ai * HALF + (mp + m) * 16) * 32 + 16 * (fq & 1) + 4 * q); }
#pragma unroll
            for (int m = mp; m < mp + 2; ++m) { const int row = row0 + ai * HALF + m * 16; bf16_t* rowp = O + (size_t)row * ldc + col0; const float s = rtab[u.idx * 256 + ai * HALF + wr * 64 + m * 16 + fr];
                f32x4 c0, s0, c1, s1;
                if (rk) { const f32x4 t0 = tt[m - mp][0], t1 = tt[m - mp][1], t2 = tt[m - mp][2], t3 = tt[m - mp][3];
                    const float sg = (fq < 2) ? -1.0f : 1.0f;
                    c0 = (f32x4){t0[0], t0[2], t1[0], t1[2]}; s0 = (f32x4){t0[1], t0[3], t1[1], t1[3]} * sg; c1 = (f32x4){t2[0], t2[2], t3[0], t3[2]}; s1 = (f32x4){t2[1], t2[3], t3[1], t3[3]} * sg; }
#pragma unroll
                for (int bj = 0; bj < 2; ++bj) { f32x4 v0 = acc[ai][bj][m][0] * s, v1 = acc[ai][bj][m][1] * s;
                    if (rk) { f32x4 p0, p1;
#pragma unroll
                        for (int j = 0; j < 4; ++j) { p0[j] = __shfl_xor(v0[j], 32); p1[j] = __shfl_xor(v1[j], 32); }
                        v0 = v0 * c0 + p0 * s0; v1 = v1 * c1 + p1 * s1; }
                    u32x4 w; w.x = cvt_pk_bf16(v0[0], v0[1]); w.y = cvt_pk_bf16(v0[2], v0[3]); w.z = cvt_pk_bf16(v1[0], v1[1]); w.w = cvt_pk_bf16(v1[2], v1[3]);
                    *(u32x4*)(rowp + bj * HALF) = w; } } } }
    }
};
struct EpiNull { static constexpr bool PERM = true, AFTER_DRAIN = false, ROWPERM = false, PREFETCH = false; float* sink;
    __device__ __forceinline__ void operator()(const f32x4 (&acc)[2][2][4][2], const Unit& u, int wr, int wc, int fr, int fq) const { if (sink) { f32x4 t = acc[0][0][0][0];
#pragma unroll
        for (int ai = 0; ai < 2; ++ai)
#pragma unroll
            for (int bj = 0; bj < 2; ++bj)
#pragma unroll
                for (int m = 0; m < 4; ++m)
#pragma unroll
                    for (int n = 0; n < 2; ++n) t += acc[ai][bj][m][n];
        *(f32x4*)(sink + (size_t)(u.pm * 32 + u.pn) * 4) = t; } } };
__device__ __forceinline__ float dpp_shr1(float x) { return __builtin_bit_cast(float, __builtin_amdgcn_update_dpp(0, __builtin_bit_cast(int, x), 0x111, 0xf, 0xf, false)); }
__device__ __forceinline__ f32x4 dpp_shr1_4(f32x4 x) { f32x4 r; r[0] = dpp_shr1(x[0]); r[1] = dpp_shr1(x[1]); r[2] = dpp_shr1(x[2]); r[3] = dpp_shr1(x[3]); return r; }
__device__ __forceinline__ f32x4 silu_mul4(f32x4 g, f32x4 v) { f32x4 e = g * (-1.4426950408889634f), d;
    d[0] = __builtin_amdgcn_exp2f(e[0]); d[1] = __builtin_amdgcn_exp2f(e[1]); d[2] = __builtin_amdgcn_exp2f(e[2]); d[3] = __builtin_amdgcn_exp2f(e[3]); d = d + 1.0f;
    f32x4 r; r[0] = __builtin_amdgcn_rcpf(d[0]); r[1] = __builtin_amdgcn_rcpf(d[1]); r[2] = __builtin_amdgcn_rcpf(d[2]); r[3] = __builtin_amdgcn_rcpf(d[3]); return (g * v) * r; }
struct EpiUp {
    static constexpr bool PERM = true, AFTER_DRAIN = false, ROWPERM = true, PREFETCH = true;
    bf16_t* ACT; float* USIDE; const float* cw; const float* cb; const PG8_LAS float* rtab;
    static constexpr int TAPS_F = 6 * 256;
    __device__ __forceinline__ void prefetch(const Unit& u, int wid, int lane) const {
        if (wid < 4) { constexpr int DFF_ = 5632, NUP_ = 11264; const int seg = 2 * wid + (lane >> 5), cg = u.pn * HALF + 4 * (lane & 31);
            const float* src = ((seg < 2) ? cb : cw + (size_t)((seg >> 1) - 1) * NUP_) + ((seg & 1) ? DFF_ : 0) + cg;
            __builtin_amdgcn_global_load_lds((const unsigned*)src, (PG8_LAS unsigned*)(rtab + TAPS_F + (u.idx & 1) * 1024 + wid * 256), 16, 0, 0); } }
    __device__ __forceinline__ void operator()(const f32x4 (&acc)[2][2][4][2], const Unit& u, int wr, int wc, int fr, int fq) const {
        constexpr int DFF_ = 5632, NUP_ = 11264;
        typedef unsigned u32x2 __attribute__((ext_vector_type(2)));
        u32x2 st[2][4];
#pragma unroll
        for (int n = 0; n < 2; ++n) {
            const int cg = u.pn * HALF + wc * 32 + 8 * fq + 4 * n;
            const PG8_LAS float* tp = rtab + TAPS_F + (u.idx & 1) * 1024 + wc * 32 + 8 * fq + 4 * n;
            const f32x4 bg = *(const PG8_LAS f32x4*)(tp), bv = *(const PG8_LAS f32x4*)(tp + 128);
            const f32x4 wg0 = *(const PG8_LAS f32x4*)(tp + 256), wg1 = *(const PG8_LAS f32x4*)(tp + 512), wg2 = *(const PG8_LAS f32x4*)(tp + 768);
            const f32x4 wv0 = *(const PG8_LAS f32x4*)(tp + 384), wv1 = *(const PG8_LAS f32x4*)(tp + 640), wv2 = *(const PG8_LAS f32x4*)(tp + 896);
#pragma unroll
            for (int ai = 0; ai < 2; ++ai) {
                const int rl0 = ai * HALF + wr * 64 + 4 * fr, row0 = u.pm * BM + rl0;
                const f32x4 sc = *(const PG8_LAS f32x4*)(rtab + u.idx * 256 + rl0);
                const f32x4 g0 = acc[ai][0][0][n] * sc[0], g1 = acc[ai][0][1][n] * sc[1], g2 = acc[ai][0][2][n] * sc[2], g3 = acc[ai][0][3][n] * sc[3];
                const f32x4 v0 = acc[ai][1][0][n] * sc[0], v1 = acc[ai][1][1][n] * sc[1], v2 = acc[ai][1][2][n] * sc[2], v3 = acc[ai][1][3][n] * sc[3];
                const f32x4 gp3 = dpp_shr1_4(g3), gp2 = dpp_shr1_4(g2), vp3 = dpp_shr1_4(v3), vp2 = dpp_shr1_4(v2);
                if (fr == 15) { float* sp = USIDE + ((size_t)(row0 >> 6) * 4) * NUP_ + cg;
                    *(f32x4*)(sp) = g2; *(f32x4*)(sp + DFF_) = v2; *(f32x4*)(sp + NUP_) = g3; *(f32x4*)(sp + NUP_ + DFF_) = v3; }
                if (fr == 0) { float* sp = USIDE + ((size_t)(row0 >> 6) * 4 + 2) * NUP_ + cg;
                    *(f32x4*)(sp) = g0; *(f32x4*)(sp + DFF_) = v0; *(f32x4*)(sp + NUP_) = g1; *(f32x4*)(sp + NUP_ + DFF_) = v1; }
                const f32x4 a0 = silu_mul4(bg + wg0 * gp2 + wg1 * gp3 + wg2 * g0, bv + wv0 * vp2 + wv1 * vp3 + wv2 * v0);
                const f32x4 a1 = silu_mul4(bg + wg0 * gp3 + wg1 * g0 + wg2 * g1, bv + wv0 * vp3 + wv1 * v0 + wv2 * v1);
                const f32x4 a2 = silu_mul4(bg + wg0 * g0 + wg1 * g1 + wg2 * g2, bv + wv0 * v0 + wv1 * v1 + wv2 * v2);
                const f32x4 a3 = silu_mul4(bg + wg0 * g1 + wg1 * g2 + wg2 * g3, bv + wv0 * v1 + wv1 * v2 + wv2 * v3);
                u32x2 w0_, w1_, w2_, w3_;
                w0_.x = cvt_pk_bf16(a0[0], a0[1]); w0_.y = cvt_pk_bf16(a0[2], a0[3]); w1_.x = cvt_pk_bf16(a1[0], a1[1]); w1_.y = cvt_pk_bf16(a1[2], a1[3]);
                w2_.x = cvt_pk_bf16(a2[0], a2[1]); w2_.y = cvt_pk_bf16(a2[2], a2[3]); w3_.x = cvt_pk_bf16(a3[0], a3[1]); w3_.y = cvt_pk_bf16(a3[2], a3[3]);
                if (n == 0) { st[ai][0] = w0_; st[ai][1] = w1_; st[ai][2] = w2_; st[ai][3] = w3_; }
                else { bf16_t* op = ACT + (size_t)row0 * DFF_ + cg - 4;
                    if (fr != 0) { *(u32x4*)(op) = (u32x4){st[ai][0].x, st[ai][0].y, w0_.x, w0_.y}; *(u32x4*)(op + DFF_) = (u32x4){st[ai][1].x, st[ai][1].y, w1_.x, w1_.y}; }
                    *(u32x4*)(op + 2 * DFF_) = (u32x4){st[ai][2].x, st[ai][2].y, w2_.x, w2_.y}; *(u32x4*)(op + 3 * DFF_) = (u32x4){st[ai][3].x, st[ai][3].y, w3_.x, w3_.y}; }
            }
        }
    }
};
#ifndef FIN_XCH_OFF
#error FIN_XCH_OFF / FIN_CNT_OFF (byte offsets of the final norm's exchange slots and counters in the workspace) must be defined before this point
#endif
struct EpiRes {
    static constexpr bool PERM = true, AFTER_DRAIN = false, ROWPERM = false, PREFETCH = false;
    const float* basef; bf16_t* xb; float* ssp;
    PG8_LAS float* ltab;
    __device__ __forceinline__ void operator()(f32x4 (&acc)[2][2][4][2], const Unit& u, int wr, int wc, int fr, int fq) const {
        const int row0 = u.pm * BM + wr * 64 + fr, col0 = u.pn * BM + wc * 32 + 8 * fq;
        if (ltab) {
            f32x4 (&a)[2][2][4][2] = acc;
            const void* const* kp_ = (const void* const*)__builtin_amdgcn_kernarg_segment_ptr(); int z_ = 0; asm volatile("" : "+s"(z_));
            float* const fout = (float*)kp_[z_ + 19]; const float* const fgain = (const float*)kp_[z_ + 18]; unsigned char* const ws_ = (unsigned char*)kp_[z_ + 20];
            float* const xch = (float*)(ws_ + FIN_XCH_OFF); unsigned* const cnt = (unsigned*)(ws_ + FIN_CNT_OFF);
            PG8_LAS float* Pt = ltab; PG8_LAS float* St = ltab + 1024; PG8_LAS unsigned* fl = (PG8_LAS unsigned*)(ltab + 1280);
            u32x4 pr[2][4][2];
#pragma unroll
            for (int ai = 0; ai < 2; ++ai)
#pragma unroll
                for (int m = 0; m < 4; ++m)
#pragma unroll
                    for (int bj = 0; bj < 2; ++bj) pr[ai][m][bj] = *(const u32x4*)(xb + (size_t)(row0 + ai * HALF + m * 16) * 2048 + col0 + bj * HALF);
#pragma unroll
            for (int ai = 0; ai < 2; ++ai)
#pragma unroll
                for (int m = 0; m < 4; ++m) { float ss = 0.f;
#pragma unroll
                    for (int bj = 0; bj < 2; ++bj) { const u32x4 pb = pr[ai][m][bj];
                        const f32x4 b0 = (f32x4){__builtin_bit_cast(float, pb.x << 16), __builtin_bit_cast(float, pb.x & 0xffff0000u), __builtin_bit_cast(float, pb.y << 16), __builtin_bit_cast(float, pb.y & 0xffff0000u)};
                        const f32x4 b1 = (f32x4){__builtin_bit_cast(float, pb.z << 16), __builtin_bit_cast(float, pb.z & 0xffff0000u), __builtin_bit_cast(float, pb.w << 16), __builtin_bit_cast(float, pb.w & 0xffff0000u)};
                        const f32x4 v0 = a[ai][bj][m][0] + b0, v1 = a[ai][bj][m][1] + b1; a[ai][bj][m][0] = v0; a[ai][bj][m][1] = v1;
                        ss += (v0[0] * v0[0] + v0[1] * v0[1]) + (v0[2] * v0[2] + v0[3] * v0[3]) + (v1[0] * v1[0] + v1[1] * v1[1]) + (v1[2] * v1[2] + v1[3] * v1[3]); }
                    ss += __shfl_xor(ss, 16); ss += __shfl_xor(ss, 32);
                    if (fq == 0) Pt[(ai * HALF + wr * 64 + m * 16 + fr) * 4 + wc] = ss; }
            asm volatile("s_waitcnt lgkmcnt(0)" ::: "memory"); __builtin_amdgcn_s_barrier(); asm volatile("" ::: "memory");
            unsigned z2 = 0u; asm volatile("" : "+v"(z2));
            const int wid = wr * 4 + wc, lane = (int)__builtin_amdgcn_mbcnt_hi(~0u, __builtin_amdgcn_mbcnt_lo(~0u, z2)), row = wid * 32 + (lane & 31);
            if (lane < 32) { const f32x4 p = *(const PG8_LAS f32x4*)(Pt + row * 4);
                __hip_atomic_store(xch + (size_t)(u.pm * BM + row) * 8 + u.pn, (p[0] + p[1]) + (p[2] + p[3]), __ATOMIC_RELAXED, __HIP_MEMORY_SCOPE_AGENT); }
            asm volatile("s_waitcnt vmcnt(0)" ::: "memory");
            if (lane == 0) __hip_atomic_fetch_add(cnt + 64 * u.pm, 1u, __ATOMIC_RELAXED, __HIP_MEMORY_SCOPE_AGENT);
            if (wid == 0) {
                unsigned sp = 0u;
                while ((unsigned)__builtin_amdgcn_readfirstlane(__hip_atomic_load(cnt + 64 * u.pm, __ATOMIC_RELAXED, __HIP_MEMORY_SCOPE_AGENT)) < 64u) { __builtin_amdgcn_s_sleep(2); if (++sp > (1u << 22)) break; }
                __builtin_amdgcn_fence(__ATOMIC_ACQUIRE, "agent");
                if (lane == 0) fl[0] = 0u; }
            asm volatile("s_waitcnt vmcnt(0) lgkmcnt(0)" ::: "memory"); __builtin_amdgcn_s_barrier(); asm volatile("" ::: "memory");
            if (lane < 32) { const float* xp = xch + (size_t)(u.pm * BM + row) * 8; float t = 0.f;
#pragma unroll
                for (int q = 0; q < 8; ++q) t += __hip_atomic_load(xp + q, __ATOMIC_RELAXED, __HIP_MEMORY_SCOPE_AGENT);
                St[row] = 1.0f / sqrtf(t * (1.0f / 2048.0f) + 1e-6f); }
            asm volatile("s_waitcnt lgkmcnt(0)" ::: "memory"); __builtin_amdgcn_s_barrier(); asm volatile("" ::: "memory");
            f32x4 gv[2][2];
#pragma unroll
            for (int bj = 0; bj < 2; ++bj) { gv[bj][0] = *(const f32x4*)(fgain + col0 + bj * HALF); gv[bj][1] = *(const f32x4*)(fgain + col0 + bj * HALF + 4); }
#pragma unroll
            for (int ai = 0; ai < 2; ++ai)
#pragma unroll
                for (int m = 0; m < 4; ++m) { const float r = St[ai * HALF + wr * 64 + m * 16 + fr]; float* op = fout + (size_t)(row0 + ai * HALF + m * 16) * 2048 + col0;
#pragma unroll
                    for (int bj = 0; bj < 2; ++bj) { *(f32x4*)(op + bj * HALF) = a[ai][bj][m][0] * r * gv[bj][0]; *(f32x4*)(op + bj * HALF + 4) = a[ai][bj][m][1] * r * gv[bj][1]; } }
            return;
        }
        u32x4 pbv[2][4][2];
        if (!basef) {
#pragma unroll
            for (int ai = 0; ai < 2; ++ai)
#pragma unroll
                for (int m = 0; m < 4; ++m)
#pragma unroll
                    for (int bj = 0; bj < 2; ++bj) pbv[ai][m][bj] = *(const u32x4*)(xb + (size_t)(row0 + ai * HALF + m * 16) * 2048 + col0 + bj * HALF);
        }
#pragma unroll
        for (int ai = 0; ai < 2; ++ai)
#pragma unroll
            for (int m = 0; m < 4; ++m) { const int row = row0 + ai * HALF + m * 16; const size_t off = (size_t)row * 2048 + col0; float ss = 0.f;
#pragma unroll
                for (int bj = 0; bj < 2; ++bj) { f32x4 b0, b1;
                    if (basef) { b0 = *(const f32x4*)(basef + off + bj * HALF); b1 = *(const f32x4*)(basef + off + bj * HALF + 4); }
                    else { const u32x4 pb = pbv[ai][m][bj];
                        b0 = (f32x4){__builtin_bit_cast(float, pb.x << 16), __builtin_bit_cast(float, pb.x & 0xffff0000u), __builtin_bit_cast(float, pb.y << 16), __builtin_bit_cast(float, pb.y & 0xffff0000u)};
                        b1 = (f32x4){__builtin_bit_cast(float, pb.z << 16), __builtin_bit_cast(float, pb.z & 0xffff0000u), __builtin_bit_cast(float, pb.w << 16), __builtin_bit_cast(float, pb.w & 0xffff0000u)}; }
                    const f32x4 v0 = acc[ai][bj][m][0] + b0, v1 = acc[ai][bj][m][1] + b1;
                    ss += (v0[0] * v0[0] + v0[1] * v0[1]) + (v0[2] * v0[2] + v0[3] * v0[3]) + (v1[0] * v1[0] + v1[1] * v1[1]) + (v1[2] * v1[2] + v1[3] * v1[3]);
                    u32x4 w; w.x = cvt_pk_bf16(v0[0], v0[1]); w.y = cvt_pk_bf16(v0[2], v0[3]); w.z = cvt_pk_bf16(v1[0], v1[1]); w.w = cvt_pk_bf16(v1[2], v1[3]);
                    *(u32x4*)(xb + off + bj * HALF) = w; }
                ss += __shfl_xor(ss, 16); ss += __shfl_xor(ss, 32);
                if (fq == 0) ssp[(size_t)(u.pn * 4 + wc) * EP_ROWS + row] = ss; }
    }
};
template <class Epi, class Sched, bool ALIGN_EPI = false, bool SP2 = false>
__device__ __forceinline__ void gemm_phase(PG8_LAS unsigned char* lds, const Gemm g, const Sched& S, const Epi& E) {
    int tid_; { unsigned z_ = 0u; asm volatile("" : "+v"(z_)); tid_ = (g.wv << 6) | (int)__builtin_amdgcn_mbcnt_hi(~0u, __builtin_amdgcn_mbcnt_lo(~0u, z_)); } asm volatile("" : "+v"(tid_));
    const int tid = tid_, wid = __builtin_amdgcn_readfirstlane(tid >> 6), lane = tid & 63, wr = wid >> 2, wc = wid & 3, fr = lane & 15, fq = lane >> 4;
    const int K = g.K, nt = K / BK;
    unsigned voffA[2], voffB[2];
#pragma unroll
    for (int i = 0; i < 2; ++i) { int R, C; stage_rc(tid * 16 + i * 8192, R, C); const int Rb = Epi::PERM ? ((R & ~31) + perm32(R & 31)) : R;
        const int Ra = Epi::ROWPERM ? ((R & 64) + 4 * (R & 15) + ((R >> 4) & 3)) : R;
        voffA[i] = (unsigned)(Ra * K + C) * 2u; voffB[i] = (unsigned)(Rb * K + C) * 2u; }
    const size_t kstep = (size_t)(BK * 2);
    const size_t hstep = (size_t)HALF * K * 2;
    const size_t tstep = 2 * hstep;
    const unsigned ldsw = (unsigned)wid * 1024u;
    const int aoff = lds_byte(wr * 64 + fr, fq * 8), boff = lds_byte(wc * 32 + fr, fq * 8);
#define PG8_SA(b, h) (((b) * 2 + (h)) * HTB)
#define PG8_SB(b, h) ((4 + (b) * 2 + (h)) * HTB)
#define PG8_STAGE(bufoff, gbase, voff) do { _Pragma("unroll") for (int _i = 0; _i < 2; ++_i) \
        __builtin_amdgcn_global_load_lds((const unsigned*)((const char*)(gbase) + (voff)[_i]), (PG8_LAS unsigned*)(lds + (bufoff) + ldsw + _i * 8192), 16, 0, 0); } while (0)
#define PG8_LDA(dst, b, h) do { _Pragma("unroll") for (int m = 0; m < 4; ++m) _Pragma("unroll") for (int k = 0; k < 2; ++k) dst[m][k] = *(const PG8_LAS bf16x8*)(lds + PG8_SA(b, h) + aoff + m * 2048 + k * 1024); } while (0)
#define PG8_LDB(dst, b, h) do { _Pragma("unroll") for (int n = 0; n < 2; ++n) _Pragma("unroll") for (int k = 0; k < 2; ++k) dst[n][k] = *(const PG8_LAS bf16x8*)(lds + PG8_SB(b, h) + boff + n * 2048 + k * 1024); } while (0)
#define PG8_MMA(ai, bj, At, Bt) do { __builtin_amdgcn_s_setprio(1); _Pragma("unroll") for (int m = 0; m < 4; ++m) _Pragma("unroll") for (int n = 0; n < 2; ++n) _Pragma("unroll") for (int k = 0; k < 2; ++k) \
        acc[ai][bj][m][n] = __builtin_amdgcn_mfma_f32_16x16x32_bf16(Bt[n][k], At[m][k], acc[ai][bj][m][n], 0, 0, 0); __builtin_amdgcn_s_setprio(0); } while (0)
#define PG8_WAIT_V(n) asm volatile("s_waitcnt vmcnt(" #n ")" ::: "memory")
#define PG8_WAIT_L(n) asm volatile("s_waitcnt lgkmcnt(" #n ")" ::: "memory")
#define PG8_BAR __builtin_amdgcn_s_barrier()
#define PG8_SCHED __builtin_amdgcn_sched_barrier(0)
    Unit cur, nxt; int ui = 0;
    if (!S.next(0, cur)) return;
    f32x4 acc[2][2][4][2];
#pragma unroll
    for (int a = 0; a < 2; ++a)
#pragma unroll
        for (int b = 0; b < 2; ++b)
#pragma unroll
            for (int m = 0; m < 4; ++m)
#pragma unroll
                for (int n = 0; n < 2; ++n) acc[a][b][m][n] = (f32x4){0.f, 0.f, 0.f, 0.f};
    bf16x8 At[4][2], B0[2][2], B1[2][2];
    const char* cA = (const char*)g.A + (size_t)cur.pm * tstep; const char* cB = (const char*)g.Bt + (size_t)cur.pn * tstep;
    S.a_ready(cur);
    if constexpr (SP2) {
        PG8_STAGE(PG8_SB(0, 0), cB, voffB); PG8_STAGE(PG8_SB(0, 1), cB + hstep, voffB); PG8_STAGE(PG8_SA(0, 0), cA, voffA); PG8_STAGE(PG8_SA(0, 1), cA + hstep, voffA);
        if (wr == 1) PG8_BAR;
        PG8_WAIT_V(2); PG8_BAR;
        PG8_STAGE(PG8_SB(1, 0), cB + kstep, voffB); PG8_STAGE(PG8_SA(1, 0), cA + kstep, voffA); PG8_STAGE(PG8_SB(1, 1), cB + hstep + kstep, voffB);
        PG8_WAIT_V(6); PG8_BAR;
    } else {
        PG8_STAGE(PG8_SB(0, 0), cB, voffB); PG8_STAGE(PG8_SA(0, 0), cA, voffA); PG8_STAGE(PG8_SB(0, 1), cB + hstep, voffB); PG8_STAGE(PG8_SA(0, 1), cA + hstep, voffA);
        if (wr == 1) PG8_BAR;
        PG8_WAIT_V(4); PG8_BAR;
        PG8_STAGE(PG8_SB(1, 0), cB + kstep, voffB); PG8_STAGE(PG8_SA(1, 0), cA + kstep, voffA); PG8_STAGE(PG8_SB(1, 1), cB + hstep + kstep, voffB);
        PG8_WAIT_V(6); PG8_BAR;
    }
    for (;;) {
        const bool has_next = S.next(ui + 1, nxt);
        const char* nA = has_next ? (const char*)g.A + (size_t)nxt.pm * tstep : cA; const char* nB = has_next ? (const char*)g.Bt + (size_t)nxt.pn * tstep : cB;
        if constexpr (Epi::PREFETCH) E.prefetch(cur, wid, lane);
        for (int t = 0; t < nt; t += 2) {
            const bool last = (t == nt - 2);
            const char* a1 = cA + (size_t)(t + 1) * kstep;
            const char* a2 = last ? nA : cA + (size_t)(t + 2) * kstep; const char* b2 = last ? nB : cB + (size_t)(t + 2) * kstep;
            const char* a3 = a2 + kstep; const char* b3 = b2 + kstep;
            if (last && has_next) S.a_ready(nxt);
            if constexpr (SP2) {
            PG8_LDB(B0, 0, 0); PG8_LDB(B1, 0, 1); PG8_SCHED; PG8_LDA(At, 0, 0); PG8_STAGE(PG8_SA(1, 1), a1 + hstep, voffA);
            PG8_WAIT_V(8); PG8_WAIT_L(0); PG8_BAR; PG8_MMA(0, 0, At, B0); PG8_MMA(0, 1, At, B1); PG8_BAR; PG8_SCHED;
            PG8_LDA(At, 0, 1); PG8_STAGE(PG8_SB(0, 0), b2, voffB); PG8_STAGE(PG8_SB(0, 1), b2 + hstep, voffB); PG8_STAGE(PG8_SA(0, 0), a2, voffA);
            PG8_WAIT_V(8); PG8_WAIT_L(0); PG8_BAR; PG8_MMA(1, 0, At, B0); PG8_MMA(1, 1, At, B1); PG8_BAR; PG8_SCHED;
            PG8_LDB(B0, 1, 0); PG8_LDB(B1, 1, 1); PG8_SCHED; PG8_LDA(At, 1, 0); PG8_STAGE(PG8_SA(0, 1), a2 + hstep, voffA);
            PG8_WAIT_V(8); PG8_WAIT_L(0); PG8_BAR; PG8_MMA(0, 0, At, B0); PG8_MMA(0, 1, At, B1); PG8_BAR; PG8_SCHED;
            PG8_LDA(At, 1, 1); PG8_STAGE(PG8_SB(1, 0), b3, voffB); PG8_STAGE(PG8_SB(1, 1), b3 + hstep, voffB); PG8_STAGE(PG8_SA(1, 0), a3, voffA);
            PG8_WAIT_V(8); PG8_WAIT_L(0); PG8_BAR; PG8_MMA(1, 0, At, B0); PG8_MMA(1, 1, At, B1); PG8_BAR; PG8_SCHED;
            } else {
            PG8_LDB(B0, 0, 0); PG8_SCHED; PG8_LDA(At, 0, 0); PG8_STAGE(PG8_SA(1, 1), a1 + hstep, voffA);
            PG8_WAIT_L(8); PG8_BAR; PG8_WAIT_L(0); PG8_MMA(0, 0, At, B0); PG8_BAR; PG8_SCHED;
            PG8_LDB(B1, 0, 1); PG8_STAGE(PG8_SB(0, 0), b2, voffB);
            PG8_BAR; PG8_WAIT_L(0); PG8_MMA(0, 1, At, B1); PG8_BAR;
            PG8_LDA(At, 0, 1); PG8_STAGE(PG8_SA(0, 0), a2, voffA);
            PG8_BAR; PG8_WAIT_L(0); PG8_MMA(1, 0, At, B0); PG8_BAR; PG8_SCHED;
            PG8_STAGE(PG8_SB(0, 1), b2 + hstep, voffB);
            PG8_WAIT_V(6); PG8_BAR; PG8_MMA(1, 1, At, B1); PG8_BAR;
            PG8_LDB(B0, 1, 0); PG8_SCHED; PG8_LDA(At, 1, 0); PG8_STAGE(PG8_SA(0, 1), a2 + hstep, voffA);
            PG8_WAIT_L(8); PG8_BAR; PG8_WAIT_L(0); PG8_MMA(0, 0, At, B0); PG8_BAR; PG8_SCHED;
            PG8_LDB(B1, 1, 1); PG8_STAGE(PG8_SB(1, 0), b3, voffB);
            PG8_BAR; PG8_WAIT_L(0); PG8_MMA(0, 1, At, B1); PG8_BAR;
            PG8_LDA(At, 1, 1); PG8_STAGE(PG8_SA(1, 0), a3, voffA);
            PG8_BAR; PG8_WAIT_L(0); PG8_MMA(1, 0, At, B0); PG8_BAR; PG8_SCHED;
            PG8_STAGE(PG8_SB(1, 1), b3 + hstep, voffB);
            PG8_WAIT_V(6); PG8_BAR; PG8_MMA(1, 1, At, B1); PG8_BAR;
            }
        }
        if constexpr (ALIGN_EPI) { if (wr == 0) PG8_BAR; }
        if constexpr (!Epi::AFTER_DRAIN) { E(acc, cur, wr, wc, fr, fq); S.done(cur); }
        if (!has_next) break;
#pragma unroll
        for (int a = 0; a < 2; ++a)
#pragma unroll
            for (int b = 0; b < 2; ++b)
#pragma unroll
                for (int m = 0; m < 4; ++m)
#pragma unroll
                    for (int n = 0; n < 2; ++n) acc[a][b][m][n] = (f32x4){0.f, 0.f, 0.f, 0.f};
        cur = nxt; cA = nA; cB = nB; ++ui;
        if constexpr (ALIGN_EPI) { if (wr == 1) PG8_BAR; }
    }
    PG8_WAIT_V(0);
    if constexpr (!ALIGN_EPI) { if (wr == 0) PG8_BAR; }
    PG8_BAR;
    if constexpr (Epi::AFTER_DRAIN) { E.fused(acc, cur, wr, wc, fr, fq, lds, wid, lane); S.done(cur); }
#undef PG8_SA
#undef PG8_SB
#undef PG8_STAGE
#undef PG8_LDA
#undef PG8_LDB
#undef PG8_MMA
#undef PG8_WAIT_V
#undef PG8_WAIT_L
#undef PG8_BAR
#undef PG8_SCHED
}
}
#ifndef MK_ONE_LAUNCH
#define MK_ONE_LAUNCH 1
#endif
constexpr int NWAVES = 8, NTHREADS = 512;
constexpr int NB = 4, SEQ = 2048, DM = 2048, MROWS = NB * SEQ, DEPTH = 4;
constexpr int NSA_N = 3632, NSA_NP = 3840;
constexpr int PC_Q = 0, PC_KVC = 2048, PC_KVS = 2560, PC_KVW = 3072, PC_GATE = 3584;
constexpr int ML_N = 6160, ML_NP = 6144;
constexpr int MC_Q = 0, MC_K = 1024, MC_V = 2048, MC_OG = 4096;
constexpr int DFF = 5632, NUP = 2 * DFF;
constexpr int NCMP = 127;
constexpr float ATT_SCALE = 0.08838834764831845f;
constexpr size_t al256(size_t x) { return (x + 255) & ~(size_t)255; }
constexpr size_t WS_CTL = 0, CTL_BYTES = 1u << 20;
constexpr size_t SZ_WNSA = (size_t)NSA_NP * DM * 2, SZ_WML = (size_t)ML_NP * DM * 2, SZ_WOUT = (size_t)DM * DM * 2, SZ_WUP = (size_t)NUP * DM * 2, SZ_WDN = (size_t)DM * DFF * 2;
constexpr size_t WS_WNSA = WS_CTL + CTL_BYTES;
constexpr size_t WS_WML = WS_WNSA + 2 * SZ_WNSA;
constexpr size_t WS_WOUT = WS_WML + 2 * SZ_WML;
constexpr size_t WS_WUP = WS_WOUT + 4 * SZ_WOUT;
constexpr size_t WS_WDN = WS_WUP + 4 * SZ_WUP;
constexpr size_t WS_XR = WS_WDN + 4 * SZ_WDN;
constexpr size_t WS_XB = WS_XR + (size_t)MROWS * DM * 4;
constexpr size_t WS_SSP = WS_XB + (size_t)MROWS * DM * 2;
constexpr size_t WS_P = WS_SSP + (size_t)32 * MROWS * 4;
constexpr size_t WS_QR = WS_P + (size_t)MROWS * ML_NP * 2;
constexpr size_t WS_KC = WS_QR + (size_t)MROWS * DM * 2;
constexpr size_t WS_VC = WS_KC + (size_t)NB * 2 * 128 * 128 * 4;
constexpr size_t WS_O = WS_VC + (size_t)NB * 2 * 128 * 128 * 4;
constexpr size_t WS_U = WS_O + (size_t)MROWS * DM * 2;
constexpr size_t WS_ACT = WS_U + (size_t)MROWS * NUP * 2;
constexpr size_t WS_ROPE = WS_ACT + (size_t)MROWS * DFF * 2;
constexpr size_t WS_GATES = WS_ROPE + (size_t)MROWS * 32 * 4;
constexpr size_t WS_HRAW = WS_GATES + (size_t)MROWS * 16 * 4;
constexpr size_t WS_HSS = WS_HRAW + (size_t)MROWS * DM * 4;
constexpr size_t WS_W1T = WS_HSS + (size_t)MROWS * 64 * 4;
constexpr size_t WS_W2T = WS_W1T + (size_t)2 * 2 * 32 * 128 * 128 * 2;
constexpr size_t WS_WGT = WS_W2T + (size_t)2 * 2 * 128 * 128 * 2;
constexpr size_t WS_END = WS_WGT + (size_t)2 * 16 * DM * 2;
constexpr int CW_BAR = 4096;
constexpr int RING_BYTES = 131072, LDS_BYTES = 163840, MISC_OFF = LDS_BYTES - 256, RSTD_OFF = 135168;

#define GAS __attribute__((address_space(1)))
#define LAS __attribute__((address_space(3)))
typedef unsigned short bf16;
typedef unsigned v4u __attribute__((ext_vector_type(4)));
typedef unsigned v2u __attribute__((ext_vector_type(2)));
typedef float f32x4 __attribute__((ext_vector_type(4)));
typedef float f32x2 __attribute__((ext_vector_type(2)));
#define LDS_WAIT() asm volatile("s_waitcnt lgkmcnt(0)" ::: "memory")
__device__ __forceinline__ unsigned f2bf(float f) { unsigned u = __builtin_bit_cast(unsigned, f); return (u + 0x7fffu + ((u >> 16) & 1u)) >> 16; }
__device__ __forceinline__ unsigned pk2(float lo, float hi) { return f2bf(lo) | (f2bf(hi) << 16); }
__device__ __forceinline__ float bf2f(unsigned short b) { return __builtin_bit_cast(float, (unsigned)b << 16); }
__device__ __forceinline__ float bflo(unsigned w) { return __builtin_bit_cast(float, w << 16); }
__device__ __forceinline__ float bfhi(unsigned w) { return __builtin_bit_cast(float, w & 0xffff0000u); }
__device__ __forceinline__ int hw_lane() { unsigned z = 0u; asm volatile("" : "+v"(z)); return (int)__builtin_amdgcn_mbcnt_hi(~0u, __builtin_amdgcn_mbcnt_lo(~0u, z)); }
__device__ __forceinline__ float wave_sum(float v) {
#pragma unroll
    for (int o = 1; o < 64; o <<= 1) v += __shfl_xor(v, o);
    return v;
}
__device__ __forceinline__ float wave_max(float v) {
#pragma unroll
    for (int o = 1; o < 64; o <<= 1) v = fmaxf(v, __shfl_xor(v, o));
    return v;
}
__device__ __forceinline__ float sigmoidf_(float x) { return 1.0f / (1.0f + __expf(-x)); }
__device__ __forceinline__ float tanhf_(float y) { return 1.0f - 2.0f / (__expf(2.0f * y) + 1.0f); }
#define XB_TMO      128
#define XB_XCNT(j)  (256  + 64 * (j))
#define XB_XSUB(j)  (1280 + 64 * (j))
#define XB_XGEN(j)  (2304 + 64 * (j))
#define XB_TOP      3328
#define XB_TOPGEN   3392
#define XCD_BAR_WORDS 3456
#define XB_SPIN_CAP (1u << 18)

__device__ __forceinline__ unsigned xb_ld(unsigned* p)              { return __hip_atomic_load(p, __ATOMIC_RELAXED, __HIP_MEMORY_SCOPE_AGENT); }
__device__ __forceinline__ unsigned xb_add(unsigned* p, unsigned v) { return __hip_atomic_fetch_add(p, v, __ATOMIC_RELAXED, __HIP_MEMORY_SCOPE_AGENT); }
__device__ __forceinline__ unsigned xb_xcc_id() { return (unsigned)__builtin_amdgcn_s_getreg((3 << 11) | 20) & 0xFu; }
#define XB_SPIN(cond, bar) do { unsigned _sp = 0; while (cond) { __builtin_amdgcn_s_sleep(1); \
    if ((++_sp & 255u) == 0u) { if (xb_ld(&(bar)[XB_TMO])) break; if (_sp > XB_SPIN_CAP) { atomicAdd(&(bar)[XB_TMO], 1u); break; } } } } while (0)

struct XcdBarrier {
    unsigned* bar; unsigned x; int wv;
    volatile LAS unsigned* st;
};

__device__ __forceinline__ bool xb_thread0(int wv) { return wv == 0 && hw_lane() == 0; }
__device__ __forceinline__ XcdBarrier xcd_barrier_post(unsigned* bar, volatile LAS unsigned* st, int wv) {
    XcdBarrier b; b.bar = bar; b.x = xb_xcc_id(); b.st = st; b.wv = wv;
    if (xb_thread0(wv)) (void)xb_add(&bar[XB_XCNT(b.x)], 1u);
    return b;
}
__device__ __forceinline__ void xcd_barrier_complete(unsigned* bar, unsigned x, unsigned& nloc, unsigned& nx) {
    const unsigned G = gridDim.x * gridDim.y * gridDim.z;
    unsigned sum, cnt, mine, sp = 0u;
    for (;;) {
        sum = 0u; cnt = 0u; mine = 0u;
#pragma unroll
        for (unsigned j = 0; j < 16; ++j) { const unsigned c = xb_ld(&bar[XB_XCNT(j)]); sum += c; cnt += (c > 0u) ? 1u : 0u; mine = (j == x) ? c : mine; }
        if (sum == G) break;
        __builtin_amdgcn_s_sleep(1);
        if ((++sp & 255u) == 0u) { if (xb_ld(&bar[XB_TMO])) break; if (sp > XB_SPIN_CAP) { atomicAdd(&bar[XB_TMO], 1u); break; } }
    }
    nloc = mine > 0u ? mine : 1u; nx = cnt > 0u ? cnt : 1u;
}

__device__ __forceinline__ void xcd_barrier(const XcdBarrier& b) {
    asm volatile("s_waitcnt vmcnt(0)" ::: "memory");
    __syncthreads();
    if (xb_thread0(b.wv)) {
        unsigned* bar = b.bar;
        __builtin_amdgcn_s_waitcnt(0);
        unsigned nloc = b.st[0], nx = b.st[1];
        if (nloc == 0u) { xcd_barrier_complete(bar, b.x, nloc, nx); b.st[0] = nloc; b.st[1] = nx; }
        const unsigned old = xb_add(&bar[XB_XSUB(b.x)], 1u);
        const unsigned gen = old / nloc;
        if (old + 1u == (gen + 1u) * nloc) {
            __builtin_amdgcn_fence(__ATOMIC_RELEASE, "agent");
            asm volatile("s_waitcnt vmcnt(0)" ::: "memory");
            const unsigned og = xb_add(&bar[XB_TOP], 1u);
            const unsigned tg = og / nx;
            if (og + 1u == (tg + 1u) * nx) xb_add(&bar[XB_TOPGEN], 1u);
            else XB_SPIN(xb_ld(&bar[XB_TOPGEN]) == tg, bar);
            __builtin_amdgcn_fence(__ATOMIC_ACQUIRE, "agent");
            xb_add(&bar[XB_XGEN(b.x)], 1u);
            asm volatile("s_waitcnt vmcnt(0)" ::: "memory");
        } else {
            XB_SPIN(xb_ld(&bar[XB_XGEN(b.x)]) == gen, bar);
            __builtin_amdgcn_fence(__ATOMIC_ACQUIRE, "agent");
            asm volatile("s_waitcnt vmcnt(0)" ::: "memory");
        }
    }
    __syncthreads();
}
__constant__ double c_rope_inv[16] = {1.0, 0.44036660267178046, 0.19392274474868576, 0.08539710028576561, 0.03760603093086393, 0.016560440080994446, 0.007292664737217109, 0.003211445994752591,
    0.001414213562373095, 0.000622772421914596, 0.0002742481756762073, 0.00012076973741146504, 5.318295896944988e-05, 2.341999896140934e-05, 1.031338537721246e-05, 4.5416704806078695e-06};

__device__ __forceinline__ void cvt_item(const float* W, int ldw, int nvalid, const float* gain, bf16* WT, int K, int npad, int mode, LAS float* scr, int item, int lane) {
    const int nblk = npad / 64, kb = item / nblk, nb = item - kb * nblk, k0 = 64 * kb, n0 = 64 * nb;
    const int kl = lane >> 4, nl = (lane & 15) * 4; const bool ok = (n0 + nl) < nvalid;
    f32x4 v[16]; const int c = lane & 7;
    const int ncol = ok ? n0 + nl : 0;
#pragma unroll
    for (int i = 0; i < 16; ++i) v[i] = __builtin_nontemporal_load((const GAS f32x4*)(W + (size_t)(k0 + kl + 4 * i) * ldw + ncol));
    if (!ok) {
#pragma unroll
        for (int i = 0; i < 16; ++i) v[i] = (f32x4){0.f, 0.f, 0.f, 0.f}; }
#pragma unroll
    for (int i = 0; i < 16; ++i) { const int kk = kl + 4 * i; LAS float* d = scr + kk * 65 + nl; d[0] = v[i].x; d[1] = v[i].y; d[2] = v[i].z; d[3] = v[i].w; }
    f32x4 g0 = (f32x4){1.f, 1.f, 1.f, 1.f}, g1 = g0;
    if (gain) { g0 = *(const f32x4*)(gain + k0 + 8 * c); g1 = *(const f32x4*)(gain + k0 + 8 * c + 4); }
    LDS_WAIT(); asm volatile("" ::: "memory");
#pragma unroll
    for (int j = 0; j < 8; ++j) { const int n = (lane >> 3) + 8 * j; const LAS float* sp = scr + (8 * c) * 65 + n;
        v4u o; o.x = pk2(sp[0 * 65] * g0.x, sp[1 * 65] * g0.y); o.y = pk2(sp[2 * 65] * g0.z, sp[3 * 65] * g0.w); o.z = pk2(sp[4 * 65] * g1.x, sp[5 * 65] * g1.y); o.w = pk2(sp[6 * 65] * g1.z, sp[7 * 65] * g1.w);
        const int nn = n0 + n; int row = nn;
        if (mode == 1) { row = (nn < DFF) ? (256 * (nn >> 7) + (nn & 127)) : (256 * ((nn - DFF) >> 7) + 128 + ((nn - DFF) & 127)); }
        *(GAS v4u*)(WT + (size_t)row * K + k0 + 8 * c) = o; }
    LDS_WAIT(); asm volatile("" ::: "memory");
}

struct Ptrs {
    const float *x; const int* pos;
    const float *nsa_w_in, *nsa_gate_b, *nsa_pe, *nsa_w1, *nsa_w2, *nsa_w_out;
    const float *ml_w_in, *ml_gate_b, *ml_head_norm, *ml_w_out;
    const float *norm_mix, *norm_ffn, *w_up, *conv_w, *conv_b, *w_down, *norm_final;
    float* out; unsigned char* ws;
};

constexpr int CV_NSA_IN = 32 * (NSA_NP / 64), CV_ML_IN = 32 * (ML_NP / 64), CV_OUT = 32 * 32, CV_UP = 32 * (NUP / 64), CV_DN = (DFF / 64) * 32;
__device__ __forceinline__ int cv_layer_items(int layer) { return ((layer & 1) ? CV_ML_IN : CV_NSA_IN) + CV_OUT + CV_UP + CV_DN; }
__device__ __forceinline__ void convert_layer(const Ptrs& A, int layer, int it_lo, int it_hi, int rank, int nranks, LAS float* scr, int lane) {
    const bool ml = layer & 1; const int jl = layer >> 1; const int n_in = ml ? CV_ML_IN : CV_NSA_IN;
    for (int it = it_lo + rank; it < it_hi; it += nranks) {
        if (it < n_in) {
            if (ml) cvt_item(A.ml_w_in + (size_t)jl * DM * ML_N, ML_N, ML_NP, A.norm_mix + (size_t)layer * DM, (bf16*)(A.ws + WS_WML + jl * SZ_WML), DM, ML_NP, 0, scr, it, lane);
            else cvt_item(A.nsa_w_in + (size_t)jl * DM * NSA_N, NSA_N, NSA_N, A.norm_mix + (size_t)layer * DM, (bf16*)(A.ws + WS_WNSA + jl * SZ_WNSA), DM, NSA_NP, 0, scr, it, lane);
        } else if (it < n_in + CV_OUT) cvt_item((ml ? A.ml_w_out : A.nsa_w_out) + (size_t)jl * DM * DM, DM, DM, nullptr, (bf16*)(A.ws + WS_WOUT + layer * SZ_WOUT), DM, DM, 0, scr, it - n_in, lane);
        else if (it < n_in + CV_OUT + CV_UP) cvt_item(A.w_up + (size_t)layer * DM * NUP, NUP, NUP, A.norm_ffn + (size_t)layer * DM, (bf16*)(A.ws + WS_WUP + layer * SZ_WUP), DM, NUP, 1, scr, it - n_in - CV_OUT, lane);
        else cvt_item(A.w_down + (size_t)layer * DFF * DM, DM, DM, nullptr, (bf16*)(A.ws + WS_WDN + layer * SZ_WDN), DFF, DM, 0, scr, it - n_in - CV_OUT - CV_UP, lane);
    }
}
#ifndef CV_TAIL_PCT
#define CV_TAIL_PCT 35
#endif
__device__ __forceinline__ int cv_tail_items(int layer, int G) { const int nwg = (MROWS / 256) * (NUP / 256); const int idle = (nwg % G) ? G - nwg % G : 0; return (layer >= 1 && idle >= 64) ? (int)((long)cv_layer_items(layer) * CV_TAIL_PCT / 100) : 0; }

#ifndef CV_SLOT_ITEMS
#define CV_SLOT_ITEMS 2800
#endif
__device__ __forceinline__ int cv_slot_items(int layer, int G) { return (!(layer & 1) && G >= 128) ? CV_SLOT_ITEMS : 0; }
#ifndef CV_INSLOT_ITEMS
#define CV_INSLOT_ITEMS 2048
#endif
__device__ __forceinline__ int cv_inslot_items(int layer, int G) { return ((layer & 1) && G == 256) ? CV_INSLOT_ITEMS : 0; }

__device__ __forceinline__ void phase_prologue(const Ptrs& A, LAS unsigned char* lds, int G, int vcu, int wave, int lane, int tid) {
    LAS float* scr = (LAS float*)(lds + wave * 16640);
    const int gw = vcu * NWAVES + wave, NGW = G * NWAVES;
    for (int layer = 0; layer < DEPTH; ++layer) convert_layer(A, layer, cv_tail_items(layer, G) + cv_inslot_items(layer, G), cv_layer_items(layer) - cv_slot_items(layer, G), gw, NGW, scr, lane);
    for (int it = gw; it < 132 * 4; it += NGW) { const int m = it >> 2;
        if (m < 128) cvt_item(A.nsa_w1 + (size_t)m * 128 * 128, 128, 128, nullptr, (bf16*)(A.ws + WS_W1T) + (size_t)m * 128 * 128, 128, 128, 0, scr, it & 3, lane);
        else cvt_item(A.nsa_w2 + (size_t)(m - 128) * 128 * 128, 128, 128, nullptr, (bf16*)(A.ws + WS_W2T) + (size_t)(m - 128) * 128 * 128, 128, 128, 0, scr, it & 3, lane); }
    for (int idx = vcu * NTHREADS + tid; idx < 2 * 16 * DM; idx += G * NTHREADS) { const int k = idx & (DM - 1), c = (idx >> 11) & 15, j = idx >> 15;
        ((bf16*)(A.ws + WS_WGT))[idx] = (bf16)f2bf(A.ml_w_in[((size_t)j * DM + k) * ML_N + ML_NP + c] * A.norm_mix[(size_t)(2 * j + 1) * DM + k]); }
    bf16* XB = (bf16*)(A.ws + WS_XB); float* SSP = (float*)(A.ws + WS_SSP);
    for (int m = gw; m < MROWS; m += NGW) {
        const GAS f32x4* xr = (const GAS f32x4*)(A.x + (size_t)m * DM) + lane; float s = 0.f;
        GAS v2u* o8 = (GAS v2u*)(XB + (size_t)m * DM) + lane;
#pragma unroll
        for (int j = 0; j < 8; ++j) { const f32x4 v = xr[64 * j]; s += (v.x * v.x + v.y * v.y) + (v.z * v.z + v.w * v.w); v2u w; w.x = pk2(v.x, v.y); w.y = pk2(v.z, v.w); o8[64 * j] = w; }
        s = wave_sum(s);
        if (lane < 32) SSP[(size_t)lane * MROWS + m] = (lane == 0) ? s : 0.f;
    }
    float* ROPE = (float*)(A.ws + WS_ROPE);
    for (int idx = (vcu * NTHREADS + tid); idx < MROWS * 16; idx += G * NTHREADS) {
        const int row = idx >> 4, i = idx & 15; const double rev = (double)A.pos[row] * c_rope_inv[i] * 0.15915494309189535; const float fr = (float)(rev - floor(rev));
        ROPE[2 * idx] = __builtin_amdgcn_cosf(fr); ROPE[2 * idx + 1] = __builtin_amdgcn_sinf(fr);
    }
}

__device__ __forceinline__ void phase_ml_gates(const Ptrs& A, int j, int layer, int G, int vcu, int wave, int lane) {
    typedef short bf16x8 __attribute__((ext_vector_type(8)));
    const bf16* WG = (const bf16*)(A.ws + WS_WGT) + (size_t)j * 16 * DM; const float* gb = A.ml_gate_b + (size_t)j * 16;
    const bf16* XB = (const bf16*)(A.ws + WS_XB); const float* SSP = (const float*)(A.ws + WS_SSP); float* GT = (float*)(A.ws + WS_GATES);
    const int gw = vcu * NWAVES + wave, NGW = G * NWAVES, r16 = lane & 15, kq = lane >> 4;
    for (int r0 = gw * 16; r0 < MROWS; r0 += NGW * 16) {
        f32x4 acc = (f32x4){0.f, 0.f, 0.f, 0.f};
        const bf16* ap = XB + (size_t)(r0 + r16) * DM + 8 * kq; const bf16* bp = WG + (size_t)r16 * DM + 8 * kq;
#pragma unroll 1
        for (int k8 = 0; k8 < 64; k8 += 8) { bf16x8 af[8], bfv[8];
#pragma unroll
            for (int i = 0; i < 8; ++i) { af[i] = *(const bf16x8*)(ap + 32 * (k8 + i)); bfv[i] = *(const bf16x8*)(bp + 32 * (k8 + i)); }
#pragma unroll
            for (int i = 0; i < 8; ++i) acc = __builtin_amdgcn_mfma_f32_16x16x32_bf16(af[i], bfv[i], acc, 0, 0, 0); }
        float ss = 0.f;
        { float sp[8];
#pragma unroll
          for (int p = 0; p < 8; ++p) sp[p] = SSP[(size_t)(8 * kq + p) * MROWS + r0 + r16];
          ss = ((sp[0] + sp[1]) + (sp[2] + sp[3])) + ((sp[4] + sp[5]) + (sp[6] + sp[7])); }
        ss += __shfl_xor(ss, 16); ss += __shfl_xor(ss, 32);
        const float rstd = 1.0f / sqrtf(ss * (1.0f / 2048.0f) + 1e-6f);
        const float bias = gb[r16];
#pragma unroll
        for (int e = 0; e < 4; ++e) { const int row = 4 * kq + e; const float rs = __shfl(rstd, row);
            const float pre = acc[e] * rs + bias; const float z = 15.0f * tanhf_(pre * (1.0f / 15.0f));
            float o;
            if (r16 < 8) o = z; else o = (z > 0.f) ? -__logf(1.0f + __expf(-z)) : (z - __logf(1.0f + __expf(z)));
            GT[(size_t)(r0 + row) * 16 + r16] = o; }
    }
}

__device__ __forceinline__ void rope_pair(v4u a, v4u b, const float* cs, v4u& oa, v4u& ob) {
    const unsigned aw[4] = {a.x, a.y, a.z, a.w}, bw[4] = {b.x, b.y, b.z, b.w}; unsigned ra[4], rb[4];
#pragma unroll
    for (int q = 0; q < 4; ++q) {
        const float x1l = bflo(aw[q]), x1h = bfhi(aw[q]), x2l = bflo(bw[q]), x2h = bfhi(bw[q]);
        const float cl = cs[4 * q], sl = cs[4 * q + 1], ch = cs[4 * q + 2], sh = cs[4 * q + 3];
        ra[q] = pk2(x1l * cl - x2l * sl, x1h * ch - x2h * sh); rb[q] = pk2(x2l * cl + x1l * sl, x2h * ch + x1h * sh); }
    oa = (v4u){ra[0], ra[1], ra[2], ra[3]}; ob = (v4u){rb[0], rb[1], rb[2], rb[3]};
}
__device__ __forceinline__ void phase_rope(const Ptrs& A, int G, int vcu, int tid) {
    bf16* P = (bf16*)(A.ws + WS_P); bf16* QR = (bf16*)(A.ws + WS_QR); const float* ROPE = (const float*)(A.ws + WS_ROPE);
    const int gt = vcu * NTHREADS + tid, NGT = G * NTHREADS;
    for (int idx = gt; idx < MROWS * 16 * 8; idx += NGT) {
        const int pc = idx & 7, h = (idx >> 3) & 15, row = idx >> 7;
        const bf16* src = P + (size_t)row * NSA_NP + PC_Q + h * 128; bf16* dst = QR + (size_t)row * DM + h * 128;
        if (pc < 2) { const v4u a = *(const v4u*)(src + 8 * pc), b = *(const v4u*)(src + 16 + 8 * pc); float cs[16];
#pragma unroll
            for (int e = 0; e < 4; ++e) { const f32x4 t = *(const f32x4*)(ROPE + (size_t)row * 32 + pc * 16 + 4 * e); cs[4 * e] = t.x; cs[4 * e + 1] = t.y; cs[4 * e + 2] = t.z; cs[4 * e + 3] = t.w; }
            v4u oa, ob; rope_pair(a, b, cs, oa, ob); *(v4u*)(dst + 8 * pc) = oa; *(v4u*)(dst + 16 + 8 * pc) = ob; }
        else { const int c0 = 32 + (pc - 2) * 16; *(v4u*)(dst + c0) = *(const v4u*)(src + c0); *(v4u*)(dst + c0 + 8) = *(const v4u*)(src + c0 + 8); }
    }
    for (int idx = gt; idx < MROWS * 8; idx += NGT) {
        const int pc = idx & 1, g = (idx >> 1) & 1, wh = (idx >> 2) & 1, row = idx >> 3;
        bf16* p = P + (size_t)row * NSA_NP + (wh ? PC_KVW : PC_KVS) + g * 128;
        const v4u a = *(const v4u*)(p + 8 * pc), b = *(const v4u*)(p + 16 + 8 * pc); float cs[16];
#pragma unroll
        for (int e = 0; e < 4; ++e) { const f32x4 t = *(const f32x4*)(ROPE + (size_t)row * 32 + pc * 16 + 4 * e); cs[4 * e] = t.x; cs[4 * e + 1] = t.y; cs[4 * e + 2] = t.z; cs[4 * e + 3] = t.w; }
        v4u oa, ob; rope_pair(a, b, cs, oa, ob); *(v4u*)(p + 8 * pc) = oa; *(v4u*)(p + 16 + 8 * pc) = ob;
    }
}

__device__ __forceinline__ void phase_compress(const Ptrs& A, int j_layer, LAS unsigned char* lds, int G, int vcu, int tid) {
    const bf16* P = (const bf16*)(A.ws + WS_P); bf16* KC = (bf16*)(A.ws + WS_KC); bf16* VC = (bf16*)(A.ws + WS_VC);
    const float* pe = A.nsa_pe + (size_t)j_layer * 2 * 32 * 128; const float* w1 = A.nsa_w1 + (size_t)j_layer * 2 * 32 * 128 * 128; const float* w2 = A.nsa_w2 + (size_t)j_layer * 2 * 128 * 128;
    LAS float* blk = (LAS float*)lds; LAS float* part = blk + 4096; LAS float* hid = part + 512;
    for (int item = vcu; item < NB * NCMP * 4; item += G) {
        const int g = item & 1, c = (item >> 1) & 1, bj = item >> 2, j = bj % NCMP, b = bj / NCMP;
        __syncthreads();
        for (int idx = tid; idx < 4096; idx += NTHREADS) { const int l = idx >> 7, d = idx & 127; const int row = b * SEQ + 16 * j + l;
            blk[idx] = bf2f(P[(size_t)row * NSA_NP + PC_KVC + c * 256 + g * 128 + d]) + pe[(c * 32 + l) * 128 + d]; }
        __syncthreads();
        { const int h = tid & 127, pt = tid >> 7; float acc = 0.f;
          for (int l = pt * 8; l < pt * 8 + 8; ++l) { const float* wp = w1 + ((size_t)(c * 32 + l) * 128) * 128 + h; const LAS float* bp = blk + l * 128;
#pragma unroll 8
              for (int d = 0; d < 128; ++d) acc += bp[d] * wp[(size_t)d * 128]; }
          part[pt * 128 + h] = acc; }
        __syncthreads();
        if (tid < 128) { const float v = (part[tid] + part[128 + tid]) + (part[256 + tid] + part[384 + tid]);
            hid[tid] = 0.5f * v * (1.0f + tanhf_(0.7978845608028654f * (v + 0.044715f * v * v * v))); }
        __syncthreads();
        if (tid < 128) { float o = 0.f; const float* wp = w2 + (size_t)c * 128 * 128 + tid;
#pragma unroll 8
            for (int h = 0; h < 128; ++h) o += hid[h] * wp[(size_t)h * 128];
            bf16* dstp = (c == 0 ? KC : VC) + ((size_t)(b * 2 + g) * 128 + j) * 128 + tid; *dstp = (bf16)f2bf(o);
            if (j == NCMP - 1) dstp[128] = 0; }
    }
}

__device__ __forceinline__ void key_dots(const bf16* krow, const LAS float* q, float (&acc)[8]) {
#pragma unroll
    for (int r = 0; r < 8; ++r) acc[r] = 0.f;
#pragma unroll 4
    for (int c = 0; c < 16; ++c) { const v4u kv = *(const v4u*)(krow + 8 * c);
        const float k0 = bflo(kv.x), k1 = bfhi(kv.x), k2 = bflo(kv.y), k3 = bfhi(kv.y), k4 = bflo(kv.z), k5 = bfhi(kv.z), k6 = bflo(kv.w), k7 = bfhi(kv.w);
#pragma unroll
        for (int r = 0; r < 8; ++r) { const f32x4 qa = *(const LAS f32x4*)(q + r * 128 + 8 * c), qb = *(const LAS f32x4*)(q + r * 128 + 8 * c + 4);
            acc[r] += (k0 * qa.x + k1 * qa.y) + (k2 * qa.z + k3 * qa.w) + (k4 * qb.x + k5 * qb.y) + (k6 * qb.z + k7 * qb.w); } }
}
__device__ __forceinline__ void softmax512(LAS float* scr, int lane) {
    float v[8]; float m = -3.0e38f;
#pragma unroll
    for (int i = 0; i < 8; ++i) { v[i] = scr[lane + 64 * i]; m = fmaxf(m, v[i]); }
    m = wave_max(m); float s = 0.f;
#pragma unroll
    for (int i = 0; i < 8; ++i) { v[i] = __expf(v[i] - m); s += v[i]; }
    s = 1.0f / wave_sum(s);
#pragma unroll
    for (int i = 0; i < 8; ++i) scr[lane + 64 * i] = v[i] * s;
}
__device__ __forceinline__ void phase_nsa_attn(const Ptrs& A, int j_layer, LAS unsigned char* lds, int G, int vcu, int wave, int lane, int tid) {
    const bf16* P = (const bf16*)(A.ws + WS_P); const bf16* QR = (const bf16*)(A.ws + WS_QR); const float* KC = (const float*)(A.ws + WS_KC); const float* VC = (const float*)(A.ws + WS_VC);
    bf16* O = (bf16*)(A.ws + WS_O); const float* gb = A.nsa_gate_b + (size_t)j_layer * 48;
    LAS float* qs = (LAS float*)lds; LAS float* qrs = qs + 1024; LAS float* sc = qrs + 1024; LAS float* pc = sc + 4096; LAS float* imp = pc + 1024; LAS int* sel = (LAS int*)(imp + 32);
    for (int item = vcu; item < NB * 2 * SEQ; item += G) {
        const int b = item >> 12, g = (item >> 11) & 1, s = item & 2047, row = b * SEQ + s, r = wave;
        __syncthreads();
        for (int idx = tid; idx < 1024; idx += NTHREADS) { qs[idx] = bf2f(P[(size_t)row * NSA_NP + PC_Q + g * 1024 + idx]); qrs[idx] = bf2f(QR[(size_t)row * DM + g * 1024 + idx]); }
        __syncthreads();
        const int nvis = (s < 31) ? 0 : (((s - 31) >> 4) + 1 > NCMP ? NCMP : ((s - 31) >> 4) + 1);
        const float* kcb = KC + (size_t)(b * 2 + g) * 128 * 128; const float* vcb = VC + (size_t)(b * 2 + g) * 128 * 128;
        { float v[2];
#pragma unroll
          for (int jr = 0; jr < 2; ++jr) { const int j = lane + 64 * jr; float d = 0.f;
              if (j < nvis) { const float* kp = kcb + (size_t)j * 128;
#pragma unroll 8
                  for (int e = 0; e < 128; e += 4) { const f32x4 kk = *(const f32x4*)(kp + e); const f32x4 qq = *(const LAS f32x4*)(qs + r * 128 + e); d += (kk.x * qq.x + kk.y * qq.y) + (kk.z * qq.z + kk.w * qq.w); }
                  v[jr] = d * ATT_SCALE; } else v[jr] = -1e30f; }
          const float m = wave_max(fmaxf(v[0], v[1]));
          const float e0 = (lane < nvis) ? __expf(v[0] - m) : 0.f, e1 = (lane + 64 < nvis) ? __expf(v[1] - m) : 0.f;
          const float ssum = wave_sum(e0 + e1); const float inv = (nvis > 0) ? 1.0f / ssum : 0.f;
          pc[r * 128 + lane] = e0 * inv; pc[r * 128 + 64 + lane] = e1 * inv; }
        __syncthreads();
        float oc0 = 0.f, oc1 = 0.f;
        for (int j = 0; j < nvis; ++j) { const float p = pc[r * 128 + j]; const f32x2 vv = *(const f32x2*)(vcb + (size_t)j * 128 + 2 * lane); oc0 += p * vv.x; oc1 += p * vv.y; }
        if (tid < 32) { const int n = tid; float a = 0.f;
            for (int rr = 0; rr < 8; ++rr) { const LAS float* pp = pc + rr * 128 + 4 * n; a += pp[0] + pp[1] + pp[2] + 0.5f * pp[3] + ((n > 0) ? 0.5f * pp[-1] : 0.f); }
            imp[n] = a; }
        __syncthreads();
        const int qb = s >> 6;
        if (wave == 0) {
            if (qb < 8) { if (lane < 8) sel[lane] = lane; if (lane == 8) sel[8] = qb + 1; }
            else { float scv = (lane >= 1 && lane < qb) ? imp[lane & 31] : -3.0e38f;
                if (lane == 0) { sel[0] = 0; sel[1] = qb; sel[8] = 8; }
                for (int t = 0; t < 6; ++t) { const float best = wave_max(scv); const unsigned long long bal = __ballot(scv == best); const int idx = __ffsll((long long)bal) - 1;
                    if (lane == idx) { sel[2 + t] = idx; scv = -3.0e38f; } } }
        }
        __syncthreads();
        const int nsel = sel[8];
        { const int kb = tid >> 6; float acc[8]; bool valid = false;
          if (kb < nsel) { const int kpos = sel[kb] * 64 + (tid & 63); valid = (kpos <= s);
              if (valid) key_dots(P + (size_t)(b * SEQ + kpos) * NSA_NP + PC_KVS + g * 128, qrs, acc); }
#pragma unroll
          for (int rr = 0; rr < 8; ++rr) sc[rr * 512 + tid] = valid ? acc[rr] * ATT_SCALE : -1e30f; }
        __syncthreads();
        softmax512(sc + r * 512, lane);
        float os0 = 0.f, os1 = 0.f;
        for (int k = 0; k < nsel * 64; ++k) { const float p = sc[r * 512 + k]; const int kpos = sel[k >> 6] * 64 + (k & 63);
            const unsigned vv = *(const unsigned*)(P + (size_t)(b * SEQ + kpos) * NSA_NP + PC_KVS + 256 + g * 128 + 2 * lane); os0 += p * bflo(vv); os1 += p * bfhi(vv); }
        __syncthreads();
        const int nk = (s + 1 < 512) ? s + 1 : 512;
        { float acc[8]; const bool valid = tid < nk;
          if (valid) key_dots(P + (size_t)(row - tid) * NSA_NP + PC_KVW + g * 128, qrs, acc);
#pragma unroll
          for (int rr = 0; rr < 8; ++rr) sc[rr * 512 + tid] = valid ? acc[rr] * ATT_SCALE : -1e30f; }
        __syncthreads();
        softmax512(sc + r * 512, lane);
        float ow0 = 0.f, ow1 = 0.f;
        for (int k = 0; k < nk; ++k) { const float p = sc[r * 512 + k];
            const unsigned vv = *(const unsigned*)(P + (size_t)(row - k) * NSA_NP + PC_KVW + 256 + g * 128 + 2 * lane); ow0 += p * bflo(vv); ow1 += p * bfhi(vv); }
        const int h = g * 8 + r; const bf16* gp = P + (size_t)row * NSA_NP + PC_GATE + h;
        const float g0 = sigmoidf_(bf2f(gp[0]) + gb[h]), g1 = sigmoidf_(bf2f(gp[16]) + gb[16 + h]), g2 = sigmoidf_(bf2f(gp[32]) + gb[32 + h]);
        *(unsigned*)(O + (size_t)row * DM + h * 128 + 2 * lane) = pk2(g0 * oc0 + g1 * os0 + g2 * ow0, g0 * oc1 + g1 * os1 + g2 * ow1);
    }
}

__device__ __forceinline__ void phase_ml_rec(const Ptrs& A, LAS unsigned char* lds, int G, int vcu, int wave, int lane, int tid) {
    const bf16* P = (const bf16*)(A.ws + WS_P); const float* GT = (const float*)(A.ws + WS_GATES); float* HRAW = (float*)(A.ws + WS_HRAW); float* HSS = (float*)(A.ws + WS_HSS);
    LAS float* qf = (LAS float*)lds; LAS float* kf = qf + 64 * 129; LAS float* vf = kf + 64 * 129; LAS float* Cs = vf + 64 * 32; LAS float* Sq = Cs + 128 * 32;
    LAS float* Fs = Sq + 64 * 65; LAS float* lis = Fs + 64; LAS float* ws_ = lis + 64; LAS float* mts = ws_ + 64; LAS float* gis = mts + 64; LAS float* dns = gis + 64; LAS float* qns = dns + 64; LAS float* nv = qns + 64; LAS float* scal = nv + 128;
    for (int unit = vcu; unit < 256; unit += G) {
        const int b = unit >> 6, h = (unit >> 3) & 7, sl = unit & 7;
        float Creg[8];
#pragma unroll
        for (int v = 0; v < 8; ++v) Creg[v] = 0.f;
        float nreg = 0.f, mrun = 0.f;
        const int kC = tid >> 2, vg = tid & 3;
        __syncthreads();
        for (int idx = tid; idx < 128 * 32; idx += NTHREADS) Cs[idx] = 0.f;
        if (tid < 128) nv[tid] = 0.f;
        for (int c = 0; c < 32; ++c) {
            const int t0 = b * SEQ + c * 64;
            __syncthreads();
            for (int idx = tid; idx < 64 * 128; idx += NTHREADS) { const int l = idx >> 7, d = idx & 127; const bf16* pr = P + (size_t)(t0 + l) * ML_NP;
                qf[l * 129 + d] = bf2f(pr[MC_Q + h * 128 + d]) * ATT_SCALE; kf[l * 129 + d] = bf2f(pr[MC_K + h * 128 + d]); }
            for (int idx = tid; idx < 64 * 32; idx += NTHREADS) { const int l = idx >> 5, v = idx & 31; vf[idx] = bf2f(P[(size_t)(t0 + l) * ML_NP + MC_V + h * 256 + sl * 32 + v]); }
            if (wave == 0) {
                const float li = GT[(size_t)(t0 + lane) * 16 + h], lf = GT[(size_t)(t0 + lane) * 16 + 8 + h];
                float F = lf;
#pragma unroll
                for (int o = 1; o < 64; o <<= 1) { const float t = __shfl_up(F, o); if (lane >= o) F += t; }
                const float Fend = __shfl(F, 63);
                const float a = Fend - F + li; const float amax = wave_max(a);
                float dm = li - F;
#pragma unroll
                for (int o = 1; o < 64; o <<= 1) { const float t = __shfl_up(dm, o); if (lane >= o) dm = fmaxf(dm, t); }
                const float inter = F + mrun, mt = fmaxf(inter, F + dm);
                Fs[lane] = F; lis[lane] = li; ws_[lane] = __expf(a - amax); mts[lane] = mt; gis[lane] = __expf(inter - mt);
                if (lane == 0) { scal[0] = Fend; scal[1] = amax; }
            }
            __syncthreads();
            const float Fend = scal[0], amax = scal[1];
            { const int l = tid >> 3, s0 = (tid & 7) * 8; const float Fl = Fs[l], mtl = mts[l];
#pragma unroll
              for (int e = 0; e < 8; ++e) { const int s = s0 + e; float val = 0.f;
                  if (s <= l) { float d = 0.f;
#pragma unroll 8
                      for (int k = 0; k < 128; ++k) d += qf[l * 129 + k] * kf[s * 129 + k];
                      val = d * __expf(Fl - Fs[s] + lis[s] - mtl); }
                  Sq[l * 65 + s] = val; }
              if ((tid & 7) == 0) { float d = 0.f;
#pragma unroll 8
                  for (int k = 0; k < 128; ++k) d += qf[l * 129 + k] * nv[k];
                  qns[l] = d; } }
            __syncthreads();
            if (tid < 64) { float rs = 0.f;
#pragma unroll 8
                for (int s = 0; s < 64; ++s) rs += Sq[tid * 65 + s];
                const float den = rs + gis[tid] * qns[tid]; dns[tid] = fmaxf(fabsf(den), __expf(-mts[tid])); }
            f32x4 num = (f32x4){0.f, 0.f, 0.f, 0.f};
            { const int l = tid >> 3, v4 = (tid & 7) * 4; f32x4 inter4 = (f32x4){0.f, 0.f, 0.f, 0.f};
              for (int s = 0; s <= l; ++s) num += Sq[l * 65 + s] * *(const LAS f32x4*)(vf + s * 32 + v4);
#pragma unroll 8
              for (int k = 0; k < 128; ++k) inter4 += qf[l * 129 + k] * *(const LAS f32x4*)(Cs + k * 32 + v4);
              num += gis[l] * inter4; }
            __syncthreads();
            { const int l = tid >> 3, v4 = (tid & 7) * 4; const float inv = 1.0f / dns[l]; const f32x4 hv = num * inv;
              *(f32x4*)(HRAW + (size_t)(t0 + l) * DM + h * 256 + sl * 32 + v4) = hv;
              float ss = (hv.x * hv.x + hv.y * hv.y) + (hv.z * hv.z + hv.w * hv.w);
              ss += __shfl_xor(ss, 1); ss += __shfl_xor(ss, 2); ss += __shfl_xor(ss, 4);
              if ((tid & 7) == 0) HSS[((size_t)(t0 + l) * 8 + h) * 8 + sl] = ss; }
            const float mnew = fmaxf(Fend + mrun, amax), decay = __expf(Fend + mrun - mnew), inject = __expf(amax - mnew);
            { float dC[8];
#pragma unroll
              for (int v = 0; v < 8; ++v) dC[v] = 0.f;
              float dn = 0.f;
              for (int l = 0; l < 64; ++l) { const float wk = ws_[l] * kf[l * 129 + kC]; dn += wk; const f32x4 va = *(const LAS f32x4*)(vf + l * 32 + vg * 8), vb = *(const LAS f32x4*)(vf + l * 32 + vg * 8 + 4);
                  dC[0] += wk * va.x; dC[1] += wk * va.y; dC[2] += wk * va.z; dC[3] += wk * va.w; dC[4] += wk * vb.x; dC[5] += wk * vb.y; dC[6] += wk * vb.z; dC[7] += wk * vb.w; }
#pragma unroll
              for (int v = 0; v < 8; ++v) { Creg[v] = decay * Creg[v] + inject * dC[v]; Cs[kC * 32 + vg * 8 + v] = Creg[v]; }
              nreg = decay * nreg + inject * dn; if (vg == 0) nv[kC] = nreg; }
            mrun = mnew;
        }
    }
}

__device__ __forceinline__ void phase_ml_norm(const Ptrs& A, int j_layer, int G, int vcu, int tid) {
    const bf16* P = (const bf16*)(A.ws + WS_P); const bf16* HRAW = (const bf16*)(A.ws + WS_HRAW); bf16* O = (bf16*)(A.ws + WS_O);
    const float* hn = A.ml_head_norm + (size_t)j_layer * DM;
    const int t0 = vcu * NTHREADS + tid, c8 = t0 & 255, col = c8 * 8, rstep = (G * NTHREADS) >> 8;
    const f32x4 ga = *(const f32x4*)(hn + col), gb2 = *(const f32x4*)(hn + col + 4);
    for (int r0 = t0 >> 8; r0 < MROWS; r0 += 4 * rstep) {
        v4u hrv[4], ogv[4];
#pragma unroll
        for (int u = 0; u < 4; ++u) { const int row = r0 + u * rstep; const bool ok = row < MROWS; const int rr = ok ? row : r0;
            hrv[u] = *(const v4u*)(HRAW + (size_t)rr * DM + col); ogv[u] = *(const v4u*)(P + (size_t)rr * ML_NP + MC_OG + col); }
#pragma unroll
        for (int u = 0; u < 4; ++u) { const int row = r0 + u * rstep; const v4u hr = hrv[u], og = ogv[u];
            const f32x4 a = (f32x4){bflo(hr.x), bfhi(hr.x), bflo(hr.y), bfhi(hr.y)}, b2 = (f32x4){bflo(hr.z), bfhi(hr.z), bflo(hr.w), bfhi(hr.w)};
            float ss = ((a.x * a.x + a.y * a.y) + (a.z * a.z + a.w * a.w)) + ((b2.x * b2.x + b2.y * b2.y) + (b2.z * b2.z + b2.w * b2.w));
#pragma unroll
            for (int o = 1; o < 32; o <<= 1) ss += __shfl_xor(ss, o);
            const float rstd = 1.0f / sqrtf(ss * (1.0f / 256.0f) + 1e-6f);
            v4u o;
            o.x = pk2(a.x * rstd * ga.x * sigmoidf_(bflo(og.x)), a.y * rstd * ga.y * sigmoidf_(bfhi(og.x)));
            o.y = pk2(a.z * rstd * ga.z * sigmoidf_(bflo(og.y)), a.w * rstd * ga.w * sigmoidf_(bfhi(og.y)));
            o.z = pk2(b2.x * rstd * gb2.x * sigmoidf_(bflo(og.z)), b2.y * rstd * gb2.y * sigmoidf_(bfhi(og.z)));
            o.w = pk2(b2.z * rstd * gb2.z * sigmoidf_(bflo(og.w)), b2.w * rstd * gb2.w * sigmoidf_(bfhi(og.w)));
            if (row < MROWS) *(v4u*)(O + (size_t)row * DM + col) = o; }
    }
}

__device__ __forceinline__ void phase_fixup(const Ptrs& A, int layer, int G, int vcu, int tid) {
    const float* US = (const float*)(A.ws + WS_U); bf16* ACT = (bf16*)(A.ws + WS_ACT);
    const float* cw = A.conv_w + (size_t)layer * 3 * NUP; const float* cb = A.conv_b + (size_t)layer * NUP;
    for (int idx = vcu * NTHREADS + tid; idx < 128 * 2 * (DFF / 8); idx += G * NTHREADS) {
        const int c8 = idx % (DFF / 8), rr = (idx / (DFF / 8)) & 1, ch = idx / (2 * (DFF / 8)), cg = c8 * 8; const bool bs = (ch & 31) == 0;
        const int chp = bs ? ch : ch - 1;
        const float* u2p = US + ((size_t)ch * 4 + 2 + rr) * NUP + cg;
        const float* u1p = rr ? US + ((size_t)ch * 4 + 2) * NUP + cg : US + ((size_t)chp * 4 + 1) * NUP + cg; const bool z1 = (rr == 0) && bs;
        const float* u0p = rr ? US + ((size_t)chp * 4 + 1) * NUP + cg : US + ((size_t)chp * 4 + 0) * NUP + cg; const bool z0 = bs;
        f32x4 g2[2], v2[2], g1[2], v1[2], g0[2], v0[2], bg[2], bv[2], wg[3][2], wv[3][2];
#pragma unroll
        for (int q = 0; q < 2; ++q) { g2[q] = *(const f32x4*)(u2p + 4 * q); v2[q] = *(const f32x4*)(u2p + DFF + 4 * q); g1[q] = *(const f32x4*)(u1p + 4 * q); v1[q] = *(const f32x4*)(u1p + DFF + 4 * q);
            g0[q] = *(const f32x4*)(u0p + 4 * q); v0[q] = *(const f32x4*)(u0p + DFF + 4 * q); bg[q] = *(const f32x4*)(cb + cg + 4 * q); bv[q] = *(const f32x4*)(cb + DFF + cg + 4 * q);
#pragma unroll
            for (int t = 0; t < 3; ++t) { wg[t][q] = *(const f32x4*)(cw + (size_t)t * NUP + cg + 4 * q); wv[t][q] = *(const f32x4*)(cw + (size_t)t * NUP + DFF + cg + 4 * q); } }
        unsigned ow[4];
#pragma unroll
        for (int q = 0; q < 2; ++q) {
            const f32x4 zero = (f32x4){0.f, 0.f, 0.f, 0.f};
            const f32x4 a1 = z1 ? zero : g1[q], b1 = z1 ? zero : v1[q], a0 = z0 ? zero : g0[q], b0 = z0 ? zero : v0[q];
            const f32x4 cgv = bg[q] + wg[0][q] * a0 + wg[1][q] * a1 + wg[2][q] * g2[q];
            const f32x4 cvv = bv[q] + wv[0][q] * b0 + wv[1][q] * b1 + wv[2][q] * v2[q];
            ow[2 * q] = pk2(cgv.x * sigmoidf_(cgv.x) * cvv.x, cgv.y * sigmoidf_(cgv.y) * cvv.y); ow[2 * q + 1] = pk2(cgv.z * sigmoidf_(cgv.z) * cvv.z, cgv.w * sigmoidf_(cgv.w) * cvv.w); }
        *(v4u*)(ACT + (size_t)(ch * 64 + rr) * DFF + cg) = (v4u){ow[0], ow[1], ow[2], ow[3]};
    }
}

__device__ __forceinline__ void phase_final(const Ptrs& A, int G, int vcu, int wave, int lane) {
    const bf16* XB = (const bf16*)(A.ws + WS_XB); const float* SSP = (const float*)(A.ws + WS_SSP);
    const int gw = vcu * NWAVES + wave, NGW = G * NWAVES;
    const f32x4* gr = (const f32x4*)A.norm_final + 2 * lane; f32x4 gv[8];
#pragma unroll
    for (int j = 0; j < 4; ++j) { gv[2 * j] = gr[128 * j]; gv[2 * j + 1] = gr[128 * j + 1]; }
    for (int m0 = gw; m0 < MROWS; m0 += 2 * NGW) {
        float ssv[2]; v4u xv[2][4];
#pragma unroll
        for (int u = 0; u < 2; ++u) { const int m = (m0 + u * NGW < MROWS) ? m0 + u * NGW : m0; ssv[u] = (lane < 32) ? SSP[(size_t)lane * MROWS + m] : 0.f;
            const v4u* xr = (const v4u*)(XB + (size_t)m * DM) + lane;
#pragma unroll
            for (int j = 0; j < 4; ++j) xv[u][j] = xr[64 * j]; }
#pragma unroll
        for (int u = 0; u < 2; ++u) { const int m = m0 + u * NGW; const float rstd = 1.0f / sqrtf(wave_sum(ssv[u]) * (1.0f / 2048.0f) + 1e-6f);
            if (m < MROWS) { f32x4* o = (f32x4*)(A.out + (size_t)m * DM) + 2 * lane;
#pragma unroll
                for (int j = 0; j < 4; ++j) { const v4u x = xv[u][j];
                    o[128 * j] = (f32x4){bflo(x.x), bfhi(x.x), bflo(x.y), bfhi(x.y)} * rstd * gv[2 * j]; o[128 * j + 1] = (f32x4){bflo(x.z), bfhi(x.z), bflo(x.w), bfhi(x.w)} * rstd * gv[2 * j + 1]; } } }
    }
}
namespace na {
typedef short bf16x8 __attribute__((ext_vector_type(8)));
typedef short s16x4 __attribute__((ext_vector_type(4)));
typedef float f32x16 __attribute__((ext_vector_type(16)));
typedef unsigned u32x4 __attribute__((ext_vector_type(4)));
constexpr int KVBLK = 64, SHM_K = 16384, SHM_V = 16384;
constexpr float THR = 8.f, SCALE = 0.08838834764831845f;
#define KSWZ(row, colB) ((row) * 256 + ((colB) ^ (((row) & 7) << 4)))
#define SBAR() __builtin_amdgcn_sched_barrier(0)
__device__ __forceinline__ int v_st(int k, int c) { const int kk = (k & ~0xC) | ((k & 4) << 1) | ((k & 8) >> 1); return ((kk >> 3) * 4 + (c >> 5)) * 512 + ((kk & 7) * 32 + (c & 31)) * 2; }
__device__ __forceinline__ int v_rd_base(int lane) { return ((lane & 3) << 3) | (((lane >> 2) & 3) << 6) | (((lane >> 4) & 1) << 5) | (((lane >> 5) & 1) << 8); }
constexpr int v_rd_off(int d0, int ks, int half) { return d0 * 512 + ks * 4096 + half * 2048; }
__device__ __forceinline__ int crow(int r, int hi) { return (r & 3) + 8 * (r >> 2) + 4 * hi; }
__device__ __forceinline__ unsigned cvtpk(float lo, float hi) { unsigned r; asm volatile("v_cvt_pk_bf16_f32 %0, %1, %2" : "=v"(r) : "v"(lo), "v"(hi)); return r; }
__device__ __forceinline__ void mask_tile(f32x16& p0, f32x16& p1, int dq, unsigned W) {
    const float NEG = -__builtin_inff();
#pragma unroll
    for (int r = 0; r < 16; ++r) { const int c = (r & 3) + 8 * (r >> 2);
        if ((unsigned)(dq - c) >= W) p0[r] = NEG;
        if ((unsigned)(dq - c - 32) >= W) p1[r] = NEG; }
}
__device__ __forceinline__ void partialSM(f32x16& p0, f32x16& p1, float& m_reg, float& mn, float& alpha) {
    float pmax = p0[0];
#pragma unroll
    for (int r = 1; r < 16; ++r) pmax = fmaxf(pmax, p0[r]);
#pragma unroll
    for (int r = 0; r < 16; ++r) pmax = fmaxf(pmax, p1[r]);
    { auto rr = __builtin_amdgcn_permlane32_swap(__float_as_uint(pmax), __float_as_uint(pmax), false, false);
      pmax = fmaxf(__uint_as_float(rr[0]), __uint_as_float(rr[1])); }
    constexpr float C2 = 1.4426950408889634f * SCALE;
    if (__builtin_expect(__all((pmax - m_reg) * SCALE <= THR), 1)) { mn = m_reg; alpha = 1.f; }
    else { mn = fmaxf(m_reg, pmax); alpha = __builtin_amdgcn_exp2f((m_reg - mn) * C2); m_reg = mn; }
    const float mnL = -mn * C2;
#pragma unroll
    for (int r = 0; r < 16; ++r) p0[r] = fmaf(p0[r], C2, mnL);
#pragma unroll
    for (int r = 0; r < 16; ++r) p1[r] = fmaf(p1[r], C2, mnL);
#pragma unroll
    for (int r = 0; r < 16; ++r) p0[r] = __builtin_amdgcn_exp2f(p0[r]);
}
#define NA_PK4(P, B_, OUT) do { unsigned a0 = cvtpk(P[B_+0], P[B_+1]), a1 = cvtpk(P[B_+2], P[B_+3]);                          \
        unsigned b0 = cvtpk(P[B_+4], P[B_+5]), b1 = cvtpk(P[B_+6], P[B_+7]);                                             \
        auto r0 = __builtin_amdgcn_permlane32_swap(a0, b0, false, false); auto r1 = __builtin_amdgcn_permlane32_swap(a1, b1, false, false); \
        u32x4 w = {r0[0], r1[0], r0[1], r1[1]}; OUT = *reinterpret_cast<bf16x8*>(&w); } while (0)
__device__ __forceinline__ void pack_p(const f32x16& p0, const f32x16& p1, bf16x8& pa0, bf16x8& pa1, bf16x8& pa2, bf16x8& pa3) {
    NA_PK4(p0, 0, pa0); NA_PK4(p0, 8, pa1); NA_PK4(p1, 0, pa2); NA_PK4(p1, 8, pa3);
}
__device__ __forceinline__ void finishSM(f32x16& p0, f32x16& p1, float alpha, float& l_reg, bf16x8& pa0, bf16x8& pa1, bf16x8& pa2, bf16x8& pa3) {
#pragma unroll
    for (int r = 0; r < 16; ++r) p1[r] = __builtin_amdgcn_exp2f(p1[r]);
    float ps = 0;
#pragma unroll
    for (int r = 0; r < 16; ++r) ps += p0[r];
#pragma unroll
    for (int r = 0; r < 16; ++r) ps += p1[r];
    { auto rr = __builtin_amdgcn_permlane32_swap(__float_as_uint(ps), __float_as_uint(ps), false, false);
      ps = __uint_as_float(rr[0]) + __uint_as_float(rr[1]); }
    l_reg = l_reg * alpha + ps;
    pack_p(p0, p1, pa0, pa1, pa2, pa3);
}
template <int KOFF>
__device__ __forceinline__ void qkt(f32x16& p0, f32x16& p1, const LAS char* K_lds, int r32, int hi, const bf16x8* qr) {
    p0 = f32x16{}; p1 = f32x16{};
    const LAS char* kb[4];
#pragma unroll
    for (int dd = 0; dd < 4; ++dd) kb[dd] = K_lds + KOFF + KSWZ(r32, (dd * 16 + hi * 8) * 2);
#define NA_KLD(d0, t) (*reinterpret_cast<const LAS bf16x8*>(kb[(d0) & 3] + ((d0) >> 2) * 128 + (t) * 32 * 256))
    bf16x8 f[2][4];
    f[0][0] = NA_KLD(0, 0); f[0][1] = NA_KLD(0, 1); f[0][2] = NA_KLD(1, 0); f[0][3] = NA_KLD(1, 1);
#pragma unroll
    for (int g = 0; g < 4; ++g) { SBAR();
        if (g + 1 < 4) { f[(g + 1) & 1][0] = NA_KLD(2 * g + 2, 0); f[(g + 1) & 1][1] = NA_KLD(2 * g + 2, 1); f[(g + 1) & 1][2] = NA_KLD(2 * g + 3, 0); f[(g + 1) & 1][3] = NA_KLD(2 * g + 3, 1); }
        p0 = __builtin_amdgcn_mfma_f32_32x32x16_bf16(f[g & 1][0], qr[2 * g], p0, 0, 0, 0);
        p1 = __builtin_amdgcn_mfma_f32_32x32x16_bf16(f[g & 1][1], qr[2 * g], p1, 0, 0, 0);
        p0 = __builtin_amdgcn_mfma_f32_32x32x16_bf16(f[g & 1][2], qr[2 * g + 1], p0, 0, 0, 0);
        p1 = __builtin_amdgcn_mfma_f32_32x32x16_bf16(f[g & 1][3], qr[2 * g + 1], p1, 0, 0, 0); }
#undef NA_KLD
}
template <int VOFF>
__device__ __forceinline__ void pv_tile(f32x16* o, int vb0, bf16x8 pa0, bf16x8 pa1, bf16x8 pa2, bf16x8 pa3) {
#define NA_TRRD(dst, off) asm volatile("ds_read_b64_tr_b16 %0, %1 offset:%2" : "=&v"(dst) : "v"(vb0), "i"(off) : "memory")
#define NA_PV_D0(d0) do { s16x4 l0, l1, l2, l3, h0, h1, h2, h3; constexpr int b_ = VOFF + v_rd_off(d0, 0, 0); \
        NA_TRRD(l0, b_); NA_TRRD(h0, b_ + 2048); NA_TRRD(l1, b_ + 4096); NA_TRRD(h1, b_ + 6144); NA_TRRD(l2, b_ + 8192); NA_TRRD(h2, b_ + 10240); NA_TRRD(l3, b_ + 12288); NA_TRRD(h3, b_ + 14336); \
        asm volatile("s_waitcnt lgkmcnt(0)" ::: "memory"); SBAR();   \
        o[d0] = __builtin_amdgcn_mfma_f32_32x32x16_bf16(pa0, (bf16x8){l0[0], l0[1], l0[2], l0[3], h0[0], h0[1], h0[2], h0[3]}, o[d0], 0, 0, 0);   \
        o[d0] = __builtin_amdgcn_mfma_f32_32x32x16_bf16(pa1, (bf16x8){l1[0], l1[1], l1[2], l1[3], h1[0], h1[1], h1[2], h1[3]}, o[d0], 0, 0, 0);   \
        o[d0] = __builtin_amdgcn_mfma_f32_32x32x16_bf16(pa2, (bf16x8){l2[0], l2[1], l2[2], l2[3], h2[0], h2[1], h2[2], h2[3]}, o[d0], 0, 0, 0);   \
        o[d0] = __builtin_amdgcn_mfma_f32_32x32x16_bf16(pa3, (bf16x8){l3[0], l3[1], l3[2], l3[3], h3[0], h3[1], h3[2], h3[3]}, o[d0], 0, 0, 0); } while (0)
    NA_PV_D0(0); NA_PV_D0(1); NA_PV_D0(2); NA_PV_D0(3);
#undef NA_PV_D0
#undef NA_TRRD
}
constexpr int VOFF0 = 0, VOFF1 = 16384, VOFF2 = 32768, VOFF3 = 49152, KOFF0 = 65536, KOFF1 = 81920, KOFF2 = 98304, IMPW_OFF = 114688, IMPW_P = 33  , WSC_OFF = IMPW_OFF + 8 * 32 * IMPW_P * 4, SELB_OFF = WSC_OFF + 2048;
struct Ctx {
    LAS char* lds; LAS float* li_l; LAS float* al_l; int vb0, r32, hi, wave;
    int krow[2], kcolb[2], vkey[2], vcol[2];
};
__device__ __forceinline__ void dma_coords(Ctx& C, int lane) {
#pragma unroll
    for (int i = 0; i < 2; ++i) { const int L = (C.wave * 2 + i) * 1024 + lane * 16;
        const int row = L >> 8; C.krow[i] = row; C.kcolb[i] = (L & 255) ^ ((row & 7) << 4);
        const int st = L >> 9, within = L & 511, kk = (st >> 2) * 8 + (within >> 6); C.vkey[i] = (kk & ~0xC) | ((kk & 4) << 1) | ((kk & 8) >> 1); C.vcol[i] = (st & 3) * 32 + ((within & 63) >> 1); }
}
#define NA_VMWAIT(n) asm volatile("s_waitcnt vmcnt(" #n ")" ::: "memory")
#define NA_BAR() do { asm volatile("s_waitcnt lgkmcnt(0)" ::: "memory"); __builtin_amdgcn_s_barrier(); asm volatile("" ::: "memory"); } while (0)
#define NA_DMA(Kp, Vp, ld, k0, koff, voff) do { const bf16* kp_ = (Kp) + (size_t)(k0) * (ld); const bf16* vp_ = (Vp) + (size_t)(k0) * (ld); _Pragma("unroll") for (int i_ = 0; i_ < 2; ++i_) { \
        unsigned ok_ = (unsigned)(C.krow[i_] * (ld) + (C.kcolb[i_] >> 1)), ov_ = (unsigned)(C.vkey[i_] * (ld) + C.vcol[i_]); asm volatile("" : "+v"(ok_), "+v"(ov_));     \
        __builtin_amdgcn_global_load_lds((const unsigned*)(kp_ + ok_), (LAS unsigned*)(C.lds + (koff) + (C.wave * 2 + i_) * 1024), 16, 0, 0); \
        __builtin_amdgcn_global_load_lds((const unsigned*)(vp_ + ov_), (LAS unsigned*)(C.lds + (voff) + (C.wave * 2 + i_) * 1024), 16, 0, 0); } } while (0)
#define NA_RESC(a) do { if (__any((a) < 1.f)) { if (C.hi == 0) C.al_l[C.r32] = (a); asm volatile("s_waitcnt lgkmcnt(0)" ::: "memory");              \
                     _Pragma("unroll") for (int d_ = 0; d_ < 4; ++d_) _Pragma("unroll") for (int r = 0; r < 16; ++r) o[d_][r] *= C.al_l[crow(r, C.hi)]; } } while (0)
template <int MODE, bool PRE = false>
__device__ __forceinline__ void tile_loop(f32x16 (&o)[4], float& l_reg, const bf16x8 (&qr)[8], const bf16* Kg, const bf16* Vg, int ld, int NT, int j_lo, const LAS int* TL, unsigned myb, int qb, int pos, int t0, const Ctx& C) {
    float m_reg = -1e30f; l_reg = 0.f;
#pragma unroll
    for (int d = 0; d < 4; ++d) o[d] = f32x16{};
#define NA_KBASE(t) ((MODE == 0 ? TL[t] : (j_lo + (t))) * KVBLK)
    const bool lag = C.wave >= 4;
    if (!PRE) {
    NA_VMWAIT(0);
    { const int kb = NA_KBASE(0); NA_DMA(Kg, Vg, ld, kb, KOFF0, VOFF0); }
    if (NT > 1) { const int kb = NA_KBASE(1); NA_DMA(Kg, Vg, ld, kb, KOFF1, VOFF1); } }
    f32x16 p0 = f32x16{}, p1 = f32x16{};
#define NA_STAGE_A(kb_, kofs_) do { SBAR(); qkt<0>(p0, p1, C.lds + (kofs_), C.r32, C.hi, qr);                                                      \
        if (MODE == 0) { const int n = (kb_) >> 6; const bool ok = (myb >> n) & 1u;                                                                \
            if (n == qb) mask_tile(p0, p1, pos - (kb_) - 4 * C.hi, 0x7fffffffu);                                                                   \
            if (!__all(ok)) { const float NEG = -__builtin_inff(); _Pragma("unroll") for (int r = 0; r < 16; ++r) { p0[r] = ok ? p0[r] : NEG; p1[r] = ok ? p1[r] : NEG; } } } \
        else { if ((kb_) + KVBLK - 1 > t0 || (kb_) <= t0 + 31 - 512) mask_tile(p0, p1, pos - (kb_) - 4 * C.hi, 512u); } } while (0)
#define NA_STAGE_B(vofs_) do { float mn, alpha; bf16x8 pa0, pa1, pa2, pa3;                                                                         \
        partialSM(p0, p1, m_reg, mn, alpha); NA_RESC(alpha); finishSM(p0, p1, alpha, l_reg, pa0, pa1, pa2, pa3); SBAR();                           \
        pv_tile<0>(o, C.vb0 + (vofs_), pa0, pa1, pa2, pa3); } while (0)
    int k3 = 0;
#pragma unroll 1
    for (int t = 0; t < NT; ++t) { const int kb = NA_KBASE(t);
        if (t + 1 < NT) NA_VMWAIT(4); else NA_VMWAIT(0);
        NA_BAR();
        if (t + 2 < NT) { const int kn = NA_KBASE(t + 2); const int k2 = (k3 == 0) ? 2 : k3 - 1; NA_DMA(Kg, Vg, ld, kn, KOFF0 + k2 * 16384, VOFF0 + ((t + 2) & 3) * 16384); }
        if (lag && t > 0) NA_STAGE_B(VOFF0 + ((t - 1) & 3) * 16384);
        NA_STAGE_A(kb, KOFF0 + k3 * 16384);
        if (!lag) NA_STAGE_B(VOFF0 + (t & 3) * 16384);
        k3 = (k3 == 2) ? 0 : k3 + 1;
    }
    if (lag && NT > 0) NA_STAGE_B(VOFF0 + ((NT - 1) & 3) * 16384);
    NA_BAR();
#undef NA_STAGE_A
#undef NA_STAGE_B
#undef NA_KBASE
}
}

__device__ __forceinline__ void phase_nsa_attn2(const Ptrs& A, int j_layer, LAS unsigned char* lds, int G, int vcu, int wave, int lane, int tid) {
    using namespace na;
    const bf16* P = (const bf16*)(A.ws + WS_P); const float* ROPE = (const float*)(A.ws + WS_ROPE); const bf16* KCb = (const bf16*)(A.ws + WS_KC); const bf16* VCb = (const bf16*)(A.ws + WS_VC);
    bf16* O = (bf16*)(A.ws + WS_O); const float* gb = A.nsa_gate_b + (size_t)j_layer * 48;
    Ctx C; C.lds = (LAS char*)lds; C.li_l = (LAS float*)(lds + WSC_OFF) + wave * 64; C.al_l = C.li_l + 32; C.wave = wave;
    LAS float* IMPW = (LAS float*)(lds + IMPW_OFF);
    LAS unsigned* SELB = (LAS unsigned*)(lds + SELB_OFF);
    LAS int* TL = (LAS int*)(SELB + 32);
    C.r32 = lane & 31; C.hi = lane >> 5; dma_coords(C, lane);
    C.vb0 = (int)(unsigned long long)C.lds + v_rd_base(lane);
    const int r32 = C.r32, hi = C.hi;
    constexpr float C2 = 1.4426950408889634f * SCALE;
    if (wave >= 4) __builtin_amdgcn_s_setprio(1);
    for (int u = vcu; u < 512; u += G) {
        const int w8 = u & 255, rnd = u >> 8, tbase = w8 & 63, tb = rnd ? 63 - tbase : tbase, bg = (w8 >> 6) + 4 * rnd, b = bg >> 1, g = bg & 1;
        const int t0 = tb * 32, qb = t0 >> 6, row0 = b * SEQ + t0, h = g * 8 + wave, pos = t0 + r32;
        const bf16* Prow = P + (size_t)(row0 + r32) * NSA_NP;
        f32x16 o[4]; unsigned otot[4][8];
        bf16x8 qr[8];
        NA_BAR();
        { const bf16* Kc = KCb + (size_t)(b * 2 + g) * 128 * 128; const bf16* Vc = VCb + (size_t)(b * 2 + g) * 128 * 128;
          NA_DMA(Kc, Vc, 128, 0, KOFF0, VOFF0); NA_DMA(Kc, Vc, 128, 64, KOFF1, VOFF1); }
#pragma unroll
        for (int d0 = 0; d0 < 8; ++d0) qr[d0] = *(const bf16x8*)(Prow + PC_Q + h * 128 + d0 * 16 + hi * 8);
        const float gz0 = bf2f(Prow[PC_GATE + h]) + gb[h], gz1 = bf2f(Prow[PC_GATE + 16 + h]) + gb[16 + h], gz2 = bf2f(Prow[PC_GATE + 32 + h]) + gb[32 + h];
        NA_VMWAIT(0); __syncthreads();
        {
            f32x16 pA0, pA1, pB0, pB1;
            qkt<KOFF0>(pA0, pA1, C.lds, r32, hi, qr); qkt<KOFF1>(pB0, pB1, C.lds, r32, hi, qr);
            const int lim = (pos - 31) >> 4;
            mask_tile(pA0, pA1, lim - 4 * hi, 0x7fffffffu); mask_tile(pB0, pB1, lim - 64 - 4 * hi, 0x7fffffffu);
            float mx = -1e30f;
#pragma unroll
            for (int r = 0; r < 16; ++r) mx = fmaxf(fmaxf(mx, fmaxf(pA0[r], pA1[r])), fmaxf(pB0[r], pB1[r]));
            { auto rr = __builtin_amdgcn_permlane32_swap(__float_as_uint(mx), __float_as_uint(mx), false, false); mx = fmaxf(__uint_as_float(rr[0]), __uint_as_float(rr[1])); }
            float ls = 0.f;
#pragma unroll
            for (int r = 0; r < 16; ++r) { pA0[r] = __builtin_amdgcn_exp2f((pA0[r] - mx) * C2); pA1[r] = __builtin_amdgcn_exp2f((pA1[r] - mx) * C2);
                pB0[r] = __builtin_amdgcn_exp2f((pB0[r] - mx) * C2); pB1[r] = __builtin_amdgcn_exp2f((pB1[r] - mx) * C2); ls += (pA0[r] + pA1[r]) + (pB0[r] + pB1[r]); }
            { auto rr = __builtin_amdgcn_permlane32_swap(__float_as_uint(ls), __float_as_uint(ls), false, false); ls = __uint_as_float(rr[0]) + __uint_as_float(rr[1]); }
            const float inv = (ls > 0.f) ? 1.0f / ls : 0.f;
            float recv[4][4], own[4][4];
#pragma unroll
            for (int ti = 0; ti < 4; ++ti)
#pragma unroll
                for (int gq = 0; gq < 4; ++gq) { const f32x16& pt = (ti == 0) ? pA0 : (ti == 1) ? pA1 : (ti == 2) ? pB0 : pB1;
                    const float hh = 0.5f * pt[4 * gq + 3] * inv; own[ti][gq] = (pt[4 * gq] + pt[4 * gq + 1] + pt[4 * gq + 2]) * inv + hh; recv[ti][gq] = __shfl_xor(hh, 32); }
#pragma unroll
            for (int ti = 0; ti < 4; ++ti)
#pragma unroll
                for (int gq = 0; gq < 4; ++gq) { const float pl = (gq > 0) ? recv[ti][gq > 0 ? gq - 1 : 0] : ((ti > 0) ? recv[ti > 0 ? ti - 1 : 0][3] : 0.f);
                    const float prev = hi ? recv[ti][gq] : pl;
                    IMPW[(wave * 32 + r32) * IMPW_P + 8 * ti + 2 * gq + hi] = own[ti][gq] + prev; }
            bf16x8 pa0, pa1, pa2, pa3;
#pragma unroll
            for (int d = 0; d < 4; ++d) o[d] = f32x16{};
            pack_p(pA0, pA1, pa0, pa1, pa2, pa3); SBAR(); pv_tile<VOFF0>(o, C.vb0, pa0, pa1, pa2, pa3);
            pack_p(pB0, pB1, pa0, pa1, pa2, pa3); SBAR(); pv_tile<VOFF1>(o, C.vb0, pa0, pa1, pa2, pa3);
            if (hi == 0) C.li_l[r32] = sigmoidf_(gz0) * inv;
            asm volatile("s_waitcnt lgkmcnt(0)" ::: "memory");
#pragma unroll
            for (int q2 = 0; q2 < 8; ++q2) { const float w0 = C.li_l[crow(2 * q2, hi)], w1 = C.li_l[crow(2 * q2 + 1, hi)];
#pragma unroll
                for (int d = 0; d < 4; ++d) otot[d][q2] = cvtpk(o[d][2 * q2] * w0, o[d][2 * q2 + 1] * w1); }
        }
        __syncthreads();
        const int w_lowk = t0 - 511, w_jlo = w_lowk > 0 ? w_lowk / KVBLK : 0, w_NT = qb + 1 - w_jlo;
        const bf16* KgW = P + (size_t)b * SEQ * NSA_NP + PC_KVW + g * 128;
        { NA_VMWAIT(0); NA_DMA(KgW, KgW + 256, NSA_NP, w_jlo * KVBLK, KOFF0, VOFF0); if (w_NT > 1) NA_DMA(KgW, KgW + 256, NSA_NP, (w_jlo + 1) * KVBLK, KOFF1, VOFF1); }
        if (wave == 0) {
            float imp[32];
#pragma unroll
            for (int n = 0; n < 32; ++n) { float s = 0.f;
#pragma unroll
                for (int w = 0; w < 8; ++w) s += IMPW[(w * 32 + r32) * IMPW_P + n];
                imp[n] = s; }
            unsigned selbits;
            if (qb < 8) selbits = (2u << qb) - 1u;
            else { selbits = 1u | (1u << qb);
                for (int t = 0; t < 6; ++t) { float best = -3.0e38f; int bi = 0;
#pragma unroll
                    for (int n = 1; n < 32; ++n) { const bool c = (n < qb) && !((selbits >> n) & 1u) && (imp[n] > best); best = c ? imp[n] : best; bi = c ? n : bi; }
                    selbits |= 1u << bi; } }
            if (hi == 0) SELB[r32] = selbits;
            unsigned un = selbits;
#pragma unroll
            for (int o_ = 1; o_ < 32; o_ <<= 1) un |= (unsigned)__shfl_xor((int)un, o_);
            if (lane == 0) { int cnt = 0; for (int n = 0; n < 32; ++n) if ((un >> n) & 1u) { TL[cnt] = n; ++cnt; } TL[32] = cnt; }
        }
        __syncthreads();
        { const float* cs = ROPE + (size_t)(row0 + r32) * 32 + hi * 16;
          u32x4 w0, w1; unsigned a0[4], a1[4];
#pragma unroll
          for (int q2 = 0; q2 < 4; ++q2) { const f32x4 t = *(const f32x4*)(cs + 4 * q2);
              const float x1a = bf2f((unsigned short)qr[0][2 * q2]), x1b = bf2f((unsigned short)qr[0][2 * q2 + 1]), x2a = bf2f((unsigned short)qr[1][2 * q2]), x2b = bf2f((unsigned short)qr[1][2 * q2 + 1]);
              a0[q2] = pk2(x1a * t[0] - x2a * t[1], x1b * t[2] - x2b * t[3]); a1[q2] = pk2(x2a * t[0] + x1a * t[1], x2b * t[2] + x1b * t[3]); }
          w0 = (u32x4){a0[0], a0[1], a0[2], a0[3]}; w1 = (u32x4){a1[0], a1[1], a1[2], a1[3]};
          qr[0] = __builtin_bit_cast(bf16x8, w0); qr[1] = __builtin_bit_cast(bf16x8, w1); }
        float l_reg;
        { tile_loop<1, true>(o, l_reg, qr, KgW, KgW + 256, NSA_NP, w_NT, w_jlo, TL, 0u, qb, pos, t0, C);
          if (hi == 0) C.li_l[r32] = sigmoidf_(gz2) / l_reg;
          asm volatile("s_waitcnt lgkmcnt(0)" ::: "memory");
#pragma unroll
          for (int q2 = 0; q2 < 8; ++q2) { const float w0 = C.li_l[crow(2 * q2, hi)], w1 = C.li_l[crow(2 * q2 + 1, hi)];
#pragma unroll
              for (int d = 0; d < 4; ++d) otot[d][q2] = cvtpk(bflo(otot[d][q2]) + o[d][2 * q2] * w0, bfhi(otot[d][q2]) + o[d][2 * q2 + 1] * w1); } }
        { const unsigned myb = SELB[r32]; const int NT = TL[32];
          const bf16* Kg = P + (size_t)b * SEQ * NSA_NP + PC_KVS + g * 128;
          tile_loop<0>(o, l_reg, qr, Kg, Kg + 256, NSA_NP, NT, 0, TL, myb, qb, pos, t0, C);
          if (hi == 0) C.li_l[r32] = sigmoidf_(gz1) / l_reg;
          asm volatile("s_waitcnt lgkmcnt(0)" ::: "memory");
#pragma unroll
          for (int q2 = 0; q2 < 8; ++q2) { const float w0 = C.li_l[crow(2 * q2, hi)], w1 = C.li_l[crow(2 * q2 + 1, hi)];
#pragma unroll
              for (int d = 0; d < 4; ++d) otot[d][q2] = cvtpk(bflo(otot[d][q2]) + o[d][2 * q2] * w0, bfhi(otot[d][q2]) + o[d][2 * q2 + 1] * w1); } }
#pragma unroll
        for (int q2 = 0; q2 < 8; ++q2) { bf16* orow = O + (size_t)(row0 + crow(2 * q2, hi)) * DM + h * 128;
#pragma unroll
            for (int d = 0; d < 4; ++d) { const unsigned mine = otot[d][q2]; const unsigned nb = (unsigned)__shfl_xor((int)mine, 1);
                if ((r32 & 1) == 0) { *(unsigned*)(orow + d * 32 + r32) = (mine & 0xffffu) | (nb << 16); *(unsigned*)(orow + DM + d * 32 + r32) = (mine >> 16) | (nb & 0xffff0000u); } } }
    }
    __builtin_amdgcn_s_setprio(0);
}
namespace ml4 {
using na::bf16x8; using na::s16x4; using na::f32x16; using na::u32x4;
constexpr int NGRP = 8, GCH = 4;
constexpr int BUF = 49152, T_KT = 0, T_V0 = 16384, T_V1 = 32768;
constexpr int B2_K = 2 * BUF, B2_Q = 2 * BUF + 16384;
constexpr int OFF_WS = 3 * BUF, OFF_AQ = OFF_WS + 8192, OFF_BQ = OFF_AQ + 1024, OFF_GI = OFF_BQ + 1024, OFF_EM = OFF_GI + 1024, OFF_DEC = OFF_EM + 1024, OFF_INV = OFF_DEC + 128, OFF_QN = OFF_INV + 2048,
              OFF_END = OFF_QN + 1024;
constexpr int TMP_F = 0, TMP_B = 8192, TMP_DMX = 16384, TMP_W = 24576, TMP_CH = 32768;
static_assert(OFF_END <= MISC_OFF, "mlstm4 LDS map");
#define M4_TRRD(dst, addr, off) asm volatile("ds_read_b64_tr_b16 %0, %1 offset:%2" : "=&v"(dst) : "v"(addr), "i"(off) : "memory")
#define M4_LDSWAIT() do { asm volatile("s_waitcnt lgkmcnt(0)" ::: "memory"); __builtin_amdgcn_sched_barrier(0); } while (0)
#define M4_FRAG(l_, h_) ((bf16x8){l_[0], l_[1], l_[2], l_[3], h_[0], h_[1], h_[2], h_[3]})
__device__ __forceinline__ void state_step(f32x16 (&cst)[4], f32x16& ntile, int vbK, int vbV, const LAS float* wsp, float dec, int wave, int r32) {
#pragma unroll
    for (int kt = 0; kt < 4; ++kt)
#pragma unroll
        for (int r = 0; r < 16; ++r) cst[kt][r] *= dec;
    if (wave < 4) {
#pragma unroll
        for (int r = 0; r < 16; ++r) ntile[r] *= dec; }
#pragma unroll
    for (int ks = 0; ks < 4; ++ks) {
        s16x4 vl, vh, kl0, kh0, kl1, kh1, kl2, kh2, kl3, kh3;
        M4_TRRD(vl, vbV, ks * 4096); M4_TRRD(vh, vbV, ks * 4096 + 2048);
        M4_TRRD(kl0, vbK, ks * 4096); M4_TRRD(kh0, vbK, ks * 4096 + 2048); M4_TRRD(kl1, vbK, 512 + ks * 4096); M4_TRRD(kh1, vbK, 512 + ks * 4096 + 2048);
        M4_TRRD(kl2, vbK, 1024 + ks * 4096); M4_TRRD(kh2, vbK, 1024 + ks * 4096 + 2048); M4_TRRD(kl3, vbK, 1536 + ks * 4096); M4_TRRD(kh3, vbK, 1536 + ks * 4096 + 2048);
        const f32x4 w0 = *(const LAS f32x4*)(wsp + 16 * ks), w1 = *(const LAS f32x4*)(wsp + 16 * ks + 4);
        M4_LDSWAIT();
        u32x4 sv;
        sv.x = na::cvtpk(bf2f((unsigned short)vl[0]) * w0.x, bf2f((unsigned short)vl[1]) * w0.y); sv.y = na::cvtpk(bf2f((unsigned short)vl[2]) * w0.z, bf2f((unsigned short)vl[3]) * w0.w);
        sv.z = na::cvtpk(bf2f((unsigned short)vh[0]) * w1.x, bf2f((unsigned short)vh[1]) * w1.y); sv.w = na::cvtpk(bf2f((unsigned short)vh[2]) * w1.z, bf2f((unsigned short)vh[3]) * w1.w);
        const bf16x8 vs = __builtin_bit_cast(bf16x8, sv);
        const bf16x8 ka0 = M4_FRAG(kl0, kh0), ka1 = M4_FRAG(kl1, kh1), ka2 = M4_FRAG(kl2, kh2), ka3 = M4_FRAG(kl3, kh3);
        cst[0] = __builtin_amdgcn_mfma_f32_32x32x16_bf16(ka0, vs, cst[0], 0, 0, 0);
        cst[1] = __builtin_amdgcn_mfma_f32_32x32x16_bf16(ka1, vs, cst[1], 0, 0, 0);
        cst[2] = __builtin_amdgcn_mfma_f32_32x32x16_bf16(ka2, vs, cst[2], 0, 0, 0);
        cst[3] = __builtin_amdgcn_mfma_f32_32x32x16_bf16(ka3, vs, cst[3], 0, 0, 0);
        if (wave < 4) {
            u32x4 nw; nw.x = na::cvtpk(w0.x, w0.y); nw.y = na::cvtpk(w0.z, w0.w); nw.z = na::cvtpk(w1.x, w1.y); nw.w = na::cvtpk(w1.z, w1.w);
            if (r32 != 0) nw = (u32x4){0u, 0u, 0u, 0u};
            const bf16x8 nb = __builtin_bit_cast(bf16x8, nw);
            if (wave == 0) ntile = __builtin_amdgcn_mfma_f32_32x32x16_bf16(ka0, nb, ntile, 0, 0, 0);
            else if (wave == 1) ntile = __builtin_amdgcn_mfma_f32_32x32x16_bf16(ka1, nb, ntile, 0, 0, 0);
            else if (wave == 2) ntile = __builtin_amdgcn_mfma_f32_32x32x16_bf16(ka2, nb, ntile, 0, 0, 0);
            else ntile = __builtin_amdgcn_mfma_f32_32x32x16_bf16(ka3, nb, ntile, 0, 0, 0);
        }
    }
}
}

__device__ __forceinline__ void phase_ml_rec4(const int PROBE, const Ptrs& A, int jl, LAS unsigned char* lds, int G, int vcu, int wave, int lane_in, int tid_in) {
    using namespace na; using namespace ml4;
    const bf16* P = (const bf16*)(A.ws + WS_P); const float* GT = (const float*)(A.ws + WS_GATES); bf16* HRAW = (bf16*)(A.ws + WS_HRAW);
    LAS float* t_f = (LAS float*)(lds + TMP_F); LAS float* t_b = (LAS float*)(lds + TMP_B); LAS float* t_dmx = (LAS float*)(lds + TMP_DMX); LAS float* t_w = (LAS float*)(lds + TMP_W);
    LAS float* c_fe = (LAS float*)(lds + TMP_CH); LAS float* c_am = c_fe + 32; LAS float* c_m0 = c_am + 32; LAS float* c_inj = c_m0 + 32;
    LAS float* f_ws = (LAS float*)(lds + OFF_WS); LAS float* f_aq = (LAS float*)(lds + OFF_AQ); LAS float* f_bq = (LAS float*)(lds + OFF_BQ); LAS float* f_gi = (LAS float*)(lds + OFF_GI);
    LAS float* f_em = (LAS float*)(lds + OFF_EM); LAS float* f_dec = (LAS float*)(lds + OFF_DEC); LAS float* s_inv = (LAS float*)(lds + OFF_INV) + wave * 64; LAS float* s_qn = (LAS float*)(lds + OFF_QN);
    LAS char* const ldsc = (LAS char*)lds;
#define M4_LANEVARS() int ln_ = lane_in; asm volatile("" : "+v"(ln_)); const int r32 = ln_ & 31, hi = ln_ >> 5; const int vb0 = (int)(unsigned long long)ldsc + v_rd_base(ln_); (void)r32; (void)hi; (void)vb0; \
        Ctx Cc; Cc.wave = wave; dma_coords(Cc, ln_); const unsigned vo0 = (unsigned)(Cc.vkey[0] * ML_NP + Cc.vcol[0]), vo1 = (unsigned)(Cc.vkey[1] * ML_NP + Cc.vcol[1]), \
        ko0 = (unsigned)(Cc.krow[0] * ML_NP + (Cc.kcolb[0] >> 1)), ko1 = (unsigned)(Cc.krow[1] * ML_NP + (Cc.kcolb[1] >> 1)); (void)vo0; (void)vo1; (void)ko0; (void)ko1
    if (wave >= 4) __builtin_amdgcn_s_setprio(1);
    for (int unit = vcu; unit < 32 * NGRP; unit += G) {
        const int bh = unit / NGRP, g = unit % NGRP, b = bh >> 3, h = bh & 7, c0 = g * GCH;
        int lane = lane_in, tid = tid_in; asm volatile("" : "+v"(lane), "+v"(tid));
        __syncthreads();
        const bf16* Pb = P + (size_t)(b * SEQ) * ML_NP; const bf16* Kg = Pb + MC_K + h * 128; const bf16* Qg = Pb + MC_Q + h * 128; const bf16* Vg = Pb + MC_V + h * 256;
#define M4_DMA2(src, row0, ldsoff, o0_, o1_) do { const bf16* s_ = (src) + (size_t)(row0) * ML_NP; LAS char* d_ = ldsc + (ldsoff) + wave * 2048; unsigned o0 = (o0_), o1 = (o1_); asm volatile("" : "+v"(o0), "+v"(o1));     \
            __builtin_amdgcn_global_load_lds((const unsigned*)(s_ + o0), (LAS unsigned*)d_, 16, 0, 0); __builtin_amdgcn_global_load_lds((const unsigned*)(s_ + o1), (LAS unsigned*)(d_ + 1024), 16, 0, 0); } while (0)
#define M4_DMA_VL(src, row0, ldsoff) M4_DMA2(src, row0, ldsoff, vo0, vo1)
#define M4_DMA_KS(src, row0, ldsoff) M4_DMA2(src, row0, ldsoff, ko0, ko1)
#define M4_DMA_STATE(c_, bo_) do { M4_DMA_VL(Kg, (c_) * 64, (bo_) + T_KT); M4_DMA_VL(Vg, (c_) * 64, (bo_) + T_V0); M4_DMA_VL(Vg + 128, (c_) * 64, (bo_) + T_V1); } while (0)
#define M4_DMA_QK(c_) do { M4_DMA_KS(Kg, (c_) * 64, B2_K); M4_DMA_KS(Qg, (c_) * 64, B2_Q); } while (0)
#ifndef M4_XCH
#define M4_XCH 1
#endif
        const bool xch = M4_XCH && (G >= 32 * NGRP);
        const int cs = xch ? c0 : 0, ns = xch ? ((g + 1 < NGRP) ? GCH : 0) : c0;
        const bool early_full = xch && ns == 0;
        NA_VMWAIT(0);
        { M4_LANEVARS();
          if (ns > 0) { M4_DMA_STATE(cs, BUF); if (ns > 1) M4_DMA_STATE(cs + 1, 2 * BUF); }
          else if (early_full) { M4_DMA_STATE(c0, BUF); M4_DMA_QK(c0); } }
        { float li[4], F[4], dm[4], Fend[4], amax[4];
#pragma unroll
          for (int cc = 0; cc < 4; ++cc) { const size_t grow = (size_t)(b * SEQ + (wave * 4 + cc) * 64 + lane) * 16; li[cc] = GT[grow + h]; F[cc] = GT[grow + 8 + h]; }
#pragma unroll
          for (int o = 1; o < 64; o <<= 1) {
#pragma unroll
              for (int cc = 0; cc < 4; ++cc) { const float t = __shfl_up(F[cc], o); if (lane >= o) F[cc] += t; } }
#pragma unroll
          for (int cc = 0; cc < 4; ++cc) { Fend[cc] = __shfl(F[cc], 63); amax[cc] = Fend[cc] - F[cc] + li[cc]; dm[cc] = li[cc] - F[cc]; }
#pragma unroll
          for (int o = 1; o < 64; o <<= 1) {
#pragma unroll
              for (int cc = 0; cc < 4; ++cc) { amax[cc] = fmaxf(amax[cc], __shfl_xor(amax[cc], o)); const float t = __shfl_up(dm[cc], o); if (lane >= o) dm[cc] = fmaxf(dm[cc], t); } }
#pragma unroll
          for (int cc = 0; cc < 4; ++cc) { const int c = wave * 4 + cc, tk = c * 64 + lane; const float a = Fend[cc] - F[cc] + li[cc];
              t_f[tk] = F[cc]; t_b[tk] = li[cc] - F[cc]; t_w[tk] = __expf(a - amax[cc]); t_dmx[tk] = F[cc] + dm[cc];
              if (lane == 0) { c_fe[c] = Fend[cc]; c_am[c] = amax[cc]; } } }
        __syncthreads();
        if (wave == 0) {
            const int c = lane & 31; const float fe = c_fe[c], am = c_am[c]; float sa = fe, sb = am;
#pragma unroll
            for (int o = 1; o < 32; o <<= 1) { const float pa = __shfl_up(sa, o), pb = __shfl_up(sb, o); if (c >= o) { sb = fmaxf(pb + sa, sb); sa = pa + sa; } }
            const float mn = fmaxf(sa, sb);
            float m = __shfl_up(mn, 1); if (c == 0) m = 0.f;
            if (lane < 32) { c_m0[c] = m; f_dec[c] = __expf(fe + m - mn); c_inj[c] = __expf(am - mn); } }
        __syncthreads();
        for (int tk = tid; tk < 2048; tk += NTHREADS) { const int c = tk >> 6; const float F = t_f[tk]; const float inter = F + c_m0[c]; const float mt = fmaxf(inter, t_dmx[tk]);
            f_ws[tk] = t_w[tk] * c_inj[c];
            const int lc = c - c0;
            if ((unsigned)lc < (unsigned)GCH) { const int i = lc * 64 + (tk & 63);
                f_aq[i] = (F - mt) * 1.4426950408889634f - 3.5f  ; f_bq[i] = t_b[tk] * 1.4426950408889634f; f_gi[i] = __expf(inter - mt) * ATT_SCALE; f_em[i] = __expf(-mt); } }
        __syncthreads();
        f32x16 cst[4]; f32x16 ntile = f32x16{};
#pragma unroll
        for (int kt = 0; kt < 4; ++kt) cst[kt] = f32x16{};
        const int vsl = ((wave >> 2) ? T_V1 : T_V0) + (wave & 3) * 512;
        if (ns > 0) {
#pragma unroll 1
            for (int t = 0, bo = BUF; t < ns; ++t) {
                M4_LANEVARS();
                if (t + 1 < ns) NA_VMWAIT(6); else NA_VMWAIT(0);
                NA_BAR();
                if (t + 2 < ns) { const int bn = (bo >= BUF) ? bo - BUF : bo + 2 * BUF; M4_DMA_STATE(cs + t + 2, bn); }
                state_step(cst, ntile, vb0 + bo + T_KT, vb0 + bo + vsl, f_ws + (cs + t) * 64 + 8 * hi, f_dec[cs + t], wave, r32);
                bo = (bo == 2 * BUF) ? 0 : bo + BUF;
            }
            NA_BAR();
        }
        if (xch) {
            unsigned* flags = (unsigned*)(A.ws + WS_CTL + 131072 + jl * 2048);
            float* LX = (float*)(A.ws + WS_U + ((size_t)64 << 20));
            constexpr size_t LX_UNIT = 8 * 20 * 256, LX_WAVE = 20 * 256;
            int lane2 = lane; asm volatile("" : "+v"(lane2));
            if (ns > 0) {
                float* lx = LX + (size_t)unit * LX_UNIT + wave * LX_WAVE + lane2 * 4;
#pragma unroll
                for (int kt = 0; kt < 4; ++kt)
#pragma unroll
                    for (int q = 0; q < 4; ++q) *(f32x4*)(lx + (kt * 4 + q) * 256) = (f32x4){cst[kt][4 * q], cst[kt][4 * q + 1], cst[kt][4 * q + 2], cst[kt][4 * q + 3]};
                if (wave < 4) {
#pragma unroll
                    for (int q = 0; q < 4; ++q) *(f32x4*)(lx + (16 + q) * 256) = (f32x4){ntile[4 * q], ntile[4 * q + 1], ntile[4 * q + 2], ntile[4 * q + 3]}; }
                asm volatile("s_waitcnt vmcnt(0)" ::: "memory");
                __syncthreads();
                if (tid == 0) { __builtin_amdgcn_fence(__ATOMIC_RELEASE, "agent"); asm volatile("s_waitcnt vmcnt(0)" ::: "memory"); __hip_atomic_store(&flags[unit], 1u, __ATOMIC_RELAXED, __HIP_MEMORY_SCOPE_AGENT); }
            }
            if (!early_full) { M4_LANEVARS(); M4_DMA_STATE(c0, BUF); M4_DMA_QK(c0); }
#pragma unroll
            for (int kt = 0; kt < 4; ++kt) cst[kt] = f32x16{};
            ntile = f32x16{};
            if (g > 0) {
                if (tid == 0) {
                    for (int gp = 0; gp < g; ++gp) { unsigned sp = 0u;
                        while (__hip_atomic_load(&flags[unit - g + gp], __ATOMIC_RELAXED, __HIP_MEMORY_SCOPE_AGENT) == 0u) { __builtin_amdgcn_s_sleep(1); if (++sp > (1u << 22)) break; } }
                    __builtin_amdgcn_fence(__ATOMIC_ACQUIRE, "agent"); asm volatile("s_waitcnt vmcnt(0)" ::: "memory"); }
                __syncthreads();
                float coef = 1.f;
#pragma unroll 1
                for (int gp = g - 1; gp >= 0; --gp) { const float* lp = LX + (size_t)(unit - g + gp) * LX_UNIT + wave * LX_WAVE + lane2 * 4;
#pragma unroll
                    for (int kt = 0; kt < 4; ++kt)
#pragma unroll
                        for (int q = 0; q < 4; ++q) { const f32x4 v = *(const f32x4*)(lp + (kt * 4 + q) * 256);
                            cst[kt][4 * q] += coef * v.x; cst[kt][4 * q + 1] += coef * v.y; cst[kt][4 * q + 2] += coef * v.z; cst[kt][4 * q + 3] += coef * v.w; }
                    if (wave < 4) {
#pragma unroll
                        for (int q = 0; q < 4; ++q) { const f32x4 v = *(const f32x4*)(lp + (16 + q) * 256);
                            ntile[4 * q] += coef * v.x; ntile[4 * q + 1] += coef * v.y; ntile[4 * q + 2] += coef * v.z; ntile[4 * q + 3] += coef * v.w; } }
                    coef *= (f_dec[4 * gp] * f_dec[4 * gp + 1]) * (f_dec[4 * gp + 2] * f_dec[4 * gp + 3]); }
            }
        }
        if (!xch) { NA_VMWAIT(0); M4_LANEVARS(); M4_DMA_STATE(c0, BUF); M4_DMA_QK(c0); }
#pragma unroll 1
        for (int j = 0; j < (PROBE == 2 ? 0 : GCH); ++j) { const int c = c0 + j, bo = ((j & 1) ^ 1) * BUF, lt = j * 64;
            NA_VMWAIT(0);
            NA_BAR();
            if (j + 1 < GCH) { M4_LANEVARS(); M4_DMA_STATE(c + 1, BUF - bo); }
            int ln_ = lane_in; asm volatile("" : "+v"(ln_)); const int r32 = ln_ & 31, hi = ln_ >> 5; const int vb0 = (int)(unsigned long long)ldsc + v_rd_base(ln_);
            f32x16 hn0, hn1; float rs0, rs1;
#define M4_KADDR(T, d) (kb4[(d) & 3] + ((d) >> 2) * 128 + (T) * 8192)
#define M4_QADDR(QT, d) (kb4[(d) & 3] + (B2_Q - B2_K) + ((d) >> 2) * 128 + (QT) * 8192)
#define M4_STILE(QT, T, PA0, PA1) do { f32x16 pt = f32x16{}; bf16x8 kf0[4], kf1[4];                                                                              \
                _Pragma("unroll") for (int i = 0; i < 4; ++i) kf0[i] = *(const LAS bf16x8*)M4_KADDR(T, i);                                                        \
                SBAR();                                                                                                                                           \
                _Pragma("unroll") for (int i = 0; i < 4; ++i) kf1[i] = *(const LAS bf16x8*)M4_KADDR(T, 4 + i);                                                    \
                f32x4 bq[4];                                                                                                                                      \
                _Pragma("unroll") for (int g4 = 0; g4 < 4; ++g4) bq[g4] = *(const LAS f32x4*)(f_bq + lt + 32 * (T) + 8 * g4 + 4 * hi);     \
                _Pragma("unroll") for (int i = 0; i < 4; ++i) pt = __builtin_amdgcn_mfma_f32_32x32x16_bf16(kf0[i], qr[i], pt, 0, 0, 0);                           \
                SBAR();                                                                                                                                           \
                _Pragma("unroll") for (int i = 0; i < 4; ++i) pt = __builtin_amdgcn_mfma_f32_32x32x16_bf16(kf1[i], qr[4 + i], pt, 0, 0, 0);                       \
                SBAR();                                                                                                                                           \
                _Pragma("unroll") for (int r = 0; r < 16; ++r) { const float e_ = __builtin_amdgcn_exp2f(aql + bq[r >> 2][r & 3]);                                \
                    const float wgt = ((T) != (QT) || crow(r, hi) <= r32) ? e_ : 0.f; pt[r] *= wgt; rs += pt[r]; }                                                \
                NA_PK4(pt, 0, PA0); NA_PK4(pt, 8, PA1); SBAR(); } while (0)
#define M4_QT(QT, HN, RS) do { const int l = 32 * (QT) + r32; bf16x8 qr[8];                                                                                     \
                _Pragma("unroll") for (int d = 0; d < 8; ++d) qr[d] = *(const LAS bf16x8*)M4_QADDR(QT, d);                                                        \
                const float aql = f_aq[lt + l];                                                                                                                   \
                if (wave < 4) { const bf16x8 qa = *(const LAS bf16x8*)(ldsc + B2_Q + KSWZ(l, 64 * wave + 16 * hi)), qb = *(const LAS bf16x8*)(ldsc + B2_Q + KSWZ(l, 64 * wave + 32 + 16 * hi)); \
                    bf16x8 n0, n1; NA_PK4(ntile, 0, n0); NA_PK4(ntile, 8, n1); f32x16 qn = f32x16{};                                                              \
                    qn = __builtin_amdgcn_mfma_f32_32x32x16_bf16(qa, n0, qn, 0, 0, 0); qn = __builtin_amdgcn_mfma_f32_32x32x16_bf16(qb, n1, qn, 0, 0, 0);        \
                    if (r32 == 0) { _Pragma("unroll") for (int r = 0; r < 16; ++r) s_qn[wave * 64 + 32 * (QT) + crow(r, hi)] = qn[r]; } }                         \
                SBAR(); float rs = 0.f; bf16x8 pa0, pa1, pa2, pa3;                                                                                                \
                M4_STILE(QT, 0, pa0, pa1);                                                                                                                        \
                if ((QT) == 1) M4_STILE(QT, 1, pa2, pa3);                                                                                                         \
                { auto rr = __builtin_amdgcn_permlane32_swap(__float_as_uint(rs), __float_as_uint(rs), false, false); rs = __uint_as_float(rr[0]) + __uint_as_float(rr[1]); } \
                RS = rs;                                                                                                                                          \
                f32x16 o = f32x16{}; const int vbV = vb0 + bo + vsl; s16x4 l0, h0, l1, h1, l2, h2, l3, h3;                                                         \
                M4_TRRD(l0, vbV, 0); M4_TRRD(h0, vbV, 2048); M4_TRRD(l1, vbV, 4096); M4_TRRD(h1, vbV, 6144);                                                      \
                if ((QT) == 1) { M4_TRRD(l2, vbV, 8192); M4_TRRD(h2, vbV, 10240); M4_TRRD(l3, vbV, 12288); M4_TRRD(h3, vbV, 14336); }                             \
                M4_LDSWAIT();                                                                                                                                     \
                o = __builtin_amdgcn_mfma_f32_32x32x16_bf16(pa0, M4_FRAG(l0, h0), o, 0, 0, 0); o = __builtin_amdgcn_mfma_f32_32x32x16_bf16(pa1, M4_FRAG(l1, h1), o, 0, 0, 0); \
                if ((QT) == 1) { o = __builtin_amdgcn_mfma_f32_32x32x16_bf16(pa2, M4_FRAG(l2, h2), o, 0, 0, 0); o = __builtin_amdgcn_mfma_f32_32x32x16_bf16(pa3, M4_FRAG(l3, h3), o, 0, 0, 0); } \
                f32x16 oc = f32x16{}; f32x4 giv[4];                                                                                                               \
                _Pragma("unroll") for (int g4 = 0; g4 < 4; ++g4) giv[g4] = *(const LAS f32x4*)(f_gi + lt + 32 * (QT) + 8 * g4 + 4 * hi);                          \
                _Pragma("unroll") for (int kt = 0; kt < 4; ++kt) { bf16x8 cb0, cb1; NA_PK4(cst[kt], 0, cb0); NA_PK4(cst[kt], 8, cb1);                              \
                    oc = __builtin_amdgcn_mfma_f32_32x32x16_bf16(qr[2 * kt], cb0, oc, 0, 0, 0); oc = __builtin_amdgcn_mfma_f32_32x32x16_bf16(qr[2 * kt + 1], cb1, oc, 0, 0, 0); } \
                SBAR();                                                                                                                                           \
                _Pragma("unroll") for (int r = 0; r < 16; ++r) HN[r] = o[r] + giv[r >> 2][r & 3] * oc[r]; SBAR(); } while (0)
            const LAS char* kb4[4];
#pragma unroll
            for (int dd = 0; dd < 4; ++dd) kb4[dd] = ldsc + B2_K + KSWZ(r32, 32 * dd + 16 * hi);
            asm volatile("s_nop 7\n\ts_nop 7\n\ts_nop 7" ::: "memory");
            M4_QT(0, hn0, rs0);
            M4_QT(1, hn1, rs1);
#undef M4_QT
#undef M4_STILE
#undef M4_KADDR
#undef M4_QADDR
            NA_BAR();
            if (j + 1 < GCH) { M4_LANEVARS(); M4_DMA_QK(c + 1); }
            { const float qn0 = (s_qn[r32] + s_qn[64 + r32]) + (s_qn[128 + r32] + s_qn[192 + r32]), qn1 = (s_qn[32 + r32] + s_qn[96 + r32]) + (s_qn[160 + r32] + s_qn[224 + r32]);
              const float d0 = rs0 + f_gi[lt + r32] * qn0, d1 = rs1 + f_gi[lt + 32 + r32] * qn1;
              const float i0 = 1.0f / fmaxf(fabsf(d0), f_em[lt + r32]), i1 = 1.0f / fmaxf(fabsf(d1), f_em[lt + 32 + r32]);
              if (hi == 0) { s_inv[r32] = i0; s_inv[32 + r32] = i1; } }
#define M4_OUT(QT, HN) do { bf16* hp = HRAW + (size_t)(b * SEQ + c * 64 + 32 * (QT)) * DM + h * 256 + wave * 32 + r32; f32x4 iv[4];     \
              _Pragma("unroll") for (int g4 = 0; g4 < 4; ++g4) iv[g4] = *(const LAS f32x4*)(s_inv + 32 * (QT) + 8 * g4 + 4 * hi);                                  \
              _Pragma("unroll") for (int r = 0; r < 16; r += 2) { const int row = crow(r, hi); const unsigned w0 = cvtpk(HN[r] * iv[r >> 2][r & 3], HN[r + 1] * iv[r >> 2][(r & 3) + 1]); \
                  if (PROBE == 0) { hp[(size_t)row * DM] = (bf16)w0; hp[(size_t)(row + 1) * DM] = (bf16)(w0 >> 16); } else asm volatile("" :: "v"(w0)); } SBAR(); } while (0)
            M4_OUT(0, hn0); M4_OUT(1, hn1);
#undef M4_OUT
            if (j + 1 < GCH) state_step(cst, ntile, vb0 + bo + T_KT, vb0 + bo + vsl, f_ws + c * 64 + 8 * hi, f_dec[c], wave, r32);
        }
        asm volatile("s_waitcnt vmcnt(0)" ::: "memory");
        __syncthreads();
        if (PROBE == 0) { const bf16* HR = HRAW; bf16* Oo = (bf16*)(A.ws + WS_O); const float* hnw = A.ml_head_norm + (size_t)jl * DM + h * 256;
            int t2 = tid_in; asm volatile("" : "+v"(t2)); const int c8 = t2 & 31, rq = t2 >> 5, col = h * 256 + 8 * c8; const f32x4 ga = *(const f32x4*)(hnw + 8 * c8), gb2 = *(const f32x4*)(hnw + 8 * c8 + 4);
#pragma unroll 1
            for (int r0 = 0; r0 < 256; r0 += 64) {
                v4u hrv[4], ogv[4];
#pragma unroll
                for (int u = 0; u < 4; ++u) { const size_t row = (size_t)(b * SEQ + c0 * 64 + r0 + 16 * u + rq); hrv[u] = *(const v4u*)(HR + row * DM + col); ogv[u] = *(const v4u*)(P + row * ML_NP + MC_OG + col); }
#pragma unroll
                for (int u = 0; u < 4; ++u) { const size_t row = (size_t)(b * SEQ + c0 * 64 + r0 + 16 * u + rq); const v4u hr = hrv[u], og = ogv[u];
                    const f32x4 a = (f32x4){bflo(hr.x), bfhi(hr.x), bflo(hr.y), bfhi(hr.y)}, b2 = (f32x4){bflo(hr.z), bfhi(hr.z), bflo(hr.w), bfhi(hr.w)};
                    float ss = ((a.x * a.x + a.y * a.y) + (a.z * a.z + a.w * a.w)) + ((b2.x * b2.x + b2.y * b2.y) + (b2.z * b2.z + b2.w * b2.w));
#pragma unroll
                    for (int o = 1; o < 32; o <<= 1) ss += __shfl_xor(ss, o);
                    const float rstd = 1.0f / sqrtf(ss * (1.0f / 256.0f) + 1e-6f);
                    v4u o;
                    o.x = pk2(a.x * rstd * ga.x * sigmoidf_(bflo(og.x)), a.y * rstd * ga.y * sigmoidf_(bfhi(og.x)));
                    o.y = pk2(a.z * rstd * ga.z * sigmoidf_(bflo(og.y)), a.w * rstd * ga.w * sigmoidf_(bfhi(og.y)));
                    o.z = pk2(b2.x * rstd * gb2.x * sigmoidf_(bflo(og.z)), b2.y * rstd * gb2.y * sigmoidf_(bfhi(og.z)));
                    o.w = pk2(b2.z * rstd * gb2.z * sigmoidf_(bflo(og.w)), b2.w * rstd * gb2.w * sigmoidf_(bfhi(og.w)));
                    *(v4u*)(Oo + row * DM + col) = o; } }
        }
        NA_BAR();
#undef M4_DMA_VL
#undef M4_DMA2
#undef M4_LANEVARS
#undef M4_DMA_KS
#undef M4_DMA_STATE
#undef M4_DMA_QK
    }
    __builtin_amdgcn_s_setprio(0);
}
__device__ __forceinline__ void phase_compress2(const Ptrs& A, int j_layer, LAS unsigned char* lds, int G, int vcu, int wave, int lane, int tid) {
    typedef short bf16x8 __attribute__((ext_vector_type(8))); typedef float f32x16 __attribute__((ext_vector_type(16)));
    const bf16* P = (const bf16*)(A.ws + WS_P); bf16* KC = (bf16*)(A.ws + WS_KC); bf16* VC = (bf16*)(A.ws + WS_VC);
    const float* pe = A.nsa_pe + (size_t)j_layer * 2 * 32 * 128;
    const bf16* W1T = (const bf16*)(A.ws + WS_W1T) + (size_t)j_layer * 2 * 32 * 128 * 128; const bf16* W2T = (const bf16*)(A.ws + WS_W2T) + (size_t)j_layer * 2 * 128 * 128;
    LAS float* part = (LAS float*)lds;
    LAS bf16* hidb = (LAS bf16*)(lds + RSTD_OFF);
    const int r32 = lane & 31, hi = lane >> 5;
    for (int unit = vcu; unit < 64; unit += G) {
        const int jt = unit & 3, g = (unit >> 2) & 1, b = (unit >> 3) & 3, c = unit >> 5, j0 = 32 * jt;
        const int jc = (j0 + r32 < NCMP) ? j0 + r32 : NCMP - 1;
        f32x16 acc[4];
#pragma unroll
        for (int nt = 0; nt < 4; ++nt) acc[nt] = f32x16{};
        for (int li = 0; li < 4; ++li) { const int l = wave * 4 + li;
            const bf16* arow = P + (size_t)(b * SEQ + 16 * jc + l) * NSA_NP + PC_KVC + c * 256 + g * 128 + hi * 8;
            const float* perow = pe + (size_t)(c * 32 + l) * 128 + hi * 8;
            const bf16* brow = W1T + ((size_t)(c * 32 + l) * 128 + r32) * 128 + hi * 8;
#pragma unroll
            for (int k2 = 0; k2 < 8; k2 += 2) {
                v4u xa[2]; f32x4 p0[2], p1[2]; bf16x8 bfr[2][4];
#pragma unroll
                for (int q = 0; q < 2; ++q) { const int ks = k2 + q; xa[q] = *(const v4u*)(arow + ks * 16); p0[q] = *(const f32x4*)(perow + ks * 16); p1[q] = *(const f32x4*)(perow + ks * 16 + 4);
#pragma unroll
                    for (int nt = 0; nt < 4; ++nt) bfr[q][nt] = *(const bf16x8*)(brow + (size_t)nt * 32 * 128 + ks * 16); }
#pragma unroll
                for (int q = 0; q < 2; ++q) {
                    v4u aw; aw.x = pk2(bflo(xa[q].x) + p0[q].x, bfhi(xa[q].x) + p0[q].y); aw.y = pk2(bflo(xa[q].y) + p0[q].z, bfhi(xa[q].y) + p0[q].w); aw.z = pk2(bflo(xa[q].z) + p1[q].x, bfhi(xa[q].z) + p1[q].y); aw.w = pk2(bflo(xa[q].w) + p1[q].z, bfhi(xa[q].w) + p1[q].w);
                    const bf16x8 af = __builtin_bit_cast(bf16x8, aw);
#pragma unroll
                    for (int nt = 0; nt < 4; ++nt) acc[nt] = __builtin_amdgcn_mfma_f32_32x32x16_bf16(af, bfr[q][nt], acc[nt], 0, 0, 0); } } }
        __syncthreads();
#pragma unroll
        for (int nt = 0; nt < 4; ++nt)
#pragma unroll
            for (int r = 0; r < 16; ++r) part[(wave * 32 + (r & 3) + 8 * (r >> 2) + 4 * hi) * 128 + nt * 32 + r32] = acc[nt][r];
        __syncthreads();
        { const int row = tid >> 4, h8 = (tid & 15) * 8; unsigned ow[4];
#pragma unroll
          for (int q = 0; q < 2; ++q) { f32x4 s = (f32x4){0.f, 0.f, 0.f, 0.f};
#pragma unroll
              for (int w = 0; w < 8; ++w) s += *(const LAS f32x4*)(part + (w * 32 + row) * 128 + h8 + 4 * q);
              float e[4];
#pragma unroll
              for (int i = 0; i < 4; ++i) { const float v = s[i]; e[i] = 0.5f * v * (1.0f + tanhf_(0.7978845608028654f * (v + 0.044715f * v * v * v))); }
              ow[2 * q] = pk2(e[0], e[1]); ow[2 * q + 1] = pk2(e[2], e[3]); }
          *(LAS v4u*)(hidb + row * 136 + h8) = (v4u){ow[0], ow[1], ow[2], ow[3]}; }
        __syncthreads();
        if (wave < 4) { const int nt = wave; f32x16 o = f32x16{};
            const bf16* brow = W2T + ((size_t)c * 128 + nt * 32 + r32) * 128 + hi * 8; bf16x8 bfw[8];
#pragma unroll
            for (int ks = 0; ks < 8; ++ks) bfw[ks] = *(const bf16x8*)(brow + ks * 16);
#pragma unroll
            for (int ks = 0; ks < 8; ++ks) { const bf16x8 af = *(const LAS bf16x8*)(hidb + r32 * 136 + ks * 16 + hi * 8); o = __builtin_amdgcn_mfma_f32_32x32x16_bf16(af, bfw[ks], o, 0, 0, 0); }
            bf16* dst = (c == 0 ? KC : VC) + ((size_t)(b * 2 + g) * 128 + j0) * 128 + nt * 32 + r32;
#pragma unroll
            for (int r = 0; r < 16; ++r) { const int row = (r & 3) + 8 * (r >> 2) + 4 * hi; dst[(size_t)row * 128] = (j0 + row < NCMP) ? (bf16)f2bf(o[r]) : (bf16)0; } }
    }
}
__device__ __forceinline__ Ptrs load_ptrs() {
    const void* const* kp = (const void* const*)__builtin_amdgcn_kernarg_segment_ptr();
    int z = 0; asm volatile("" : "+s"(z));
    Ptrs A;
    A.x = (const float*)kp[z + 0]; A.pos = (const int*)kp[z + 1];
    A.nsa_w_in = (const float*)kp[z + 2]; A.nsa_gate_b = (const float*)kp[z + 3]; A.nsa_pe = (const float*)kp[z + 4]; A.nsa_w1 = (const float*)kp[z + 5]; A.nsa_w2 = (const float*)kp[z + 6]; A.nsa_w_out = (const float*)kp[z + 7];
    A.ml_w_in = (const float*)kp[z + 8]; A.ml_gate_b = (const float*)kp[z + 9]; A.ml_head_norm = (const float*)kp[z + 10]; A.ml_w_out = (const float*)kp[z + 11];
    A.norm_mix = (const float*)kp[z + 12]; A.norm_ffn = (const float*)kp[z + 13]; A.w_up = (const float*)kp[z + 14]; A.conv_w = (const float*)kp[z + 15]; A.conv_b = (const float*)kp[z + 16]; A.w_down = (const float*)kp[z + 17]; A.norm_final = (const float*)kp[z + 18];
    A.out = (float*)kp[z + 19]; A.ws = (unsigned char*)kp[z + 20];
    return A;
}
constexpr int NPHASES = 30;
struct Args { const void* in[19]; float* out; unsigned char* ws; int ph_lo, ph_hi; };
__global__ void __launch_bounds__(NTHREADS, 2) fwd_kernel(Args args) {
    extern __shared__ __attribute__((aligned(16))) unsigned char lds_raw[];
    LAS unsigned char* lds = (LAS unsigned char*)lds_raw;
    volatile LAS unsigned* MISC = (volatile LAS unsigned*)(lds + MISC_OFF);
    const int G = gridDim.x; const int bx = blockIdx.x; const int vcu = (G % 8 == 0) ? (bx % 8) * (G / 8) + bx / 8 : bx;
    const int lo = args.ph_lo, hi = args.ph_hi;
    const int wv0 = __builtin_amdgcn_readfirstlane((int)threadIdx.x >> 6);
#define TIDX() ((wv0 << 6) | hw_lane())
    if (TIDX() < 32) MISC[TIDX()] = 0u;
    __syncthreads();
    XcdBarrier bar; bar.bar = (unsigned*)(args.ws + WS_CTL) + CW_BAR; bar.x = 0; bar.st = nullptr; bar.wv = wv0;
    if (hi - lo > 1) bar = xcd_barrier_post((unsigned*)(args.ws + WS_CTL) + CW_BAR, MISC + 8, wv0);
#ifndef DUP_MASK
#define DUP_MASK 0
#endif
#define DUP(bit) for (int rep_ = 0; rep_ < (((DUP_MASK) >> (bit)) & 1 ? 2 : 1); ++rep_)
#define IN(k) (lo <= (k) && (k) < hi)
#define SEAM(k) do { if (IN(k) && IN((k) + 1)) xcd_barrier(bar); } while (0)
#define SITE() const Ptrs A = load_ptrs(); int tid = TIDX(); asm volatile("" : "+v"(tid)); const int lane = tid & 63, wave = __builtin_amdgcn_readfirstlane(tid >> 6); (void)lane; (void)wave; \
    bf16* XB = (bf16*)(A.ws + WS_XB); float* XR = (float*)(A.ws + WS_XR); float* SSP = (float*)(A.ws + WS_SSP); bf16* P = (bf16*)(A.ws + WS_P); bf16* O = (bf16*)(A.ws + WS_O); (void)XB; (void)XR; (void)SSP; (void)P; (void)O

    if (IN(0)) { SITE(); DUP(0) phase_prologue(A, lds, G, vcu, wave, lane, tid); }
    SEAM(0);
    for (int layer = 0; layer < DEPTH; ++layer) {
        const int pb = 1 + 7 * layer; const bool nsa = (layer & 1) == 0; const int jl = layer >> 1;
        if (IN(pb)) { SITE();
            const int N = nsa ? NSA_NP : ML_NP;
            pg8::Gemm g{XB, (const bf16*)(A.ws + (nsa ? WS_WNSA + jl * SZ_WNSA : WS_WML + jl * SZ_WML)), MROWS, N, DM, wave}; pg8::StaticOrder S; S.init(MROWS, N, G, bx);
            LAS float* rtab = (LAS float*)(lds + RSTD_OFF); pg8::prep_rstd(SSP, S, rtab, tid);
            pg8::EpiProj E{P, N, rtab, nsa ? (const float*)(A.ws + WS_ROPE) : nullptr};
            DUP(1) pg8::gemm_phase<pg8::EpiProj, pg8::StaticOrder, true, true>(lds, g, S, E);
            if (!nsa) DUP(8) phase_ml_gates(A, jl, layer, G, vcu, wave, lane);
            if (nsa && layer + 1 < DEPTH) { const int rem = (32 * (NSA_NP / 256)) % G, n = cv_inslot_items(layer + 1, G);
                if (n > 0 && bx >= rem) { __syncthreads(); const int t0 = cv_tail_items(layer + 1, G); convert_layer(A, layer + 1, t0, t0 + n, (bx - rem) * NWAVES + wave, (G - rem) * NWAVES, (LAS float*)(lds + wave * 16640), lane); } }
        }
        SEAM(pb);
        if (IN(pb + 1)) { SITE();
            if (nsa) { DUP(2) phase_compress2(A, jl, lds, G, vcu, wave, lane, tid);
                if (vcu >= 64 && cv_slot_items(layer, G) > 0) convert_layer(A, layer, cv_layer_items(layer) - cv_slot_items(layer, G), cv_layer_items(layer), (vcu - 64) * NWAVES + wave, (G - 64) * NWAVES, (LAS float*)(lds + wave * 16640), lane); }
            else { for (int rep_ = 0; rep_ < (((DUP_MASK >> 13) & 7) ? 2 : 1); ++rep_) phase_ml_rec4(rep_ ? ((DUP_MASK >> 13) & 7) - 1 : 0, A, jl, lds, G, vcu, wave, lane, tid);
            }
        }
        SEAM(pb + 1);
        if (IN(pb + 2)) { SITE();
            if (nsa) DUP(3) phase_nsa_attn2(A, jl, lds, G, vcu, wave, lane, tid);
        }
        if (nsa) SEAM(pb + 2);
        if (IN(pb + 3)) { SITE();
            pg8::Gemm g{O, (const bf16*)(A.ws + WS_WOUT + layer * SZ_WOUT), MROWS, DM, DM, wave}; pg8::StaticOrder S; S.init(MROWS, DM, G, bx);
            pg8::EpiRes E{nullptr, XB, SSP};
            pg8::gemm_phase<pg8::EpiRes, pg8::StaticOrder, true, true>(lds, g, S, E);
        }
        SEAM(pb + 3);
        if (IN(pb + 4)) { SITE();
            pg8::Gemm g{XB, (const bf16*)(A.ws + WS_WUP + layer * SZ_WUP), MROWS, NUP, DM, wave}; pg8::StaticOrder S; S.init(MROWS, NUP, G, bx);
            LAS float* rtab = (LAS float*)(lds + RSTD_OFF); pg8::prep_rstd(SSP, S, rtab, tid);
            pg8::EpiUp E{(bf16*)(A.ws + WS_ACT), (float*)(A.ws + WS_U), A.conv_w + (size_t)layer * 3 * NUP, A.conv_b + (size_t)layer * NUP, rtab};
            DUP(6) pg8::gemm_phase<pg8::EpiUp, pg8::StaticOrder, true, true>(lds, g, S, E);
            {
              const int nwg = (MROWS / 256) * (NUP / 256), rem = nwg % G;
              if (layer + 1 < DEPTH && rem != 0 && bx >= rem) convert_layer(A, layer + 1, 0, cv_tail_items(layer + 1, G), (bx - rem) * NWAVES + wave, (G - rem) * NWAVES, (LAS float*)(lds + wave * 16640), lane); }
#if (DUP_MASK >> 9) & 1
            { pg8::EpiNull EN{(float*)(A.ws + WS_QR) + (A.pos[0] < 0 ? 0 : 0)}; EN.sink = (A.pos[0] == -12345) ? (float*)(A.ws + WS_QR) : nullptr; pg8::gemm_phase<pg8::EpiNull, pg8::StaticOrder, true, true>(lds, g, S, EN); }
#endif
        }
        SEAM(pb + 4);
        if (IN(pb + 5)) { SITE(); DUP(7) phase_fixup(A, layer, G, vcu, tid); }
        SEAM(pb + 5);
        if (IN(pb + 6)) { SITE();
            pg8::Gemm g{(const bf16*)(A.ws + WS_ACT), (const bf16*)(A.ws + WS_WDN + layer * SZ_WDN), MROWS, DM, DFF, wave}; pg8::StaticOrder S; S.init(MROWS, DM, G, bx);
            const bool lastl = (layer + 1 == DEPTH);
            pg8::EpiRes E{nullptr, XB, SSP, lastl ? (LAS float*)(lds + RSTD_OFF) : (LAS float*)nullptr};
            pg8::gemm_phase<pg8::EpiRes, pg8::StaticOrder, true, true>(lds, g, S, E);
        }
        if (layer + 1 < DEPTH) SEAM(pb + 6);
    }
#if (DUP_MASK >> 12) & 1
    if (hi - lo > 1) { for (int rep_ = 0; rep_ < 20; ++rep_) xcd_barrier(bar); }
#endif
#undef SITE
#undef IN
#undef SEAM
}

extern "C" void kernel_launch(void* const* d_in, const int* in_sizes, int n_in, void* d_out, int out_size, void* d_ws, size_t ws_size, hipStream_t stream) {
    static int grid = 0;
    if (grid == 0) {
        if (n_in != 19 || out_size != MROWS * DM || ws_size < WS_END) { fprintf(stderr, "kernel_launch: unexpected shapes (n_in %d, out %d, ws %zu, need %zu); nothing launched\n", n_in, out_size, ws_size, (size_t)WS_END); grid = -1; return; }
        int dev = 0, cus = 0, per_cu = 0;
        if (hipGetDevice(&dev) != hipSuccess || hipDeviceGetAttribute(&cus, hipDeviceAttributeMultiprocessorCount, dev) != hipSuccess) { fprintf(stderr, "kernel_launch: device query failed\n"); grid = -1; return; }
        if (hipFuncSetAttribute((const void*)fwd_kernel, hipFuncAttributeMaxDynamicSharedMemorySize, LDS_BYTES) != hipSuccess) { fprintf(stderr, "kernel_launch: hipFuncSetAttribute failed\n"); grid = -1; return; }
        if (hipOccupancyMaxActiveBlocksPerMultiprocessor(&per_cu, (const void*)fwd_kernel, NTHREADS, LDS_BYTES) != hipSuccess || per_cu < 1) fprintf(stderr, "kernel_launch: occupancy query reports %d blocks per CU\n", per_cu);
        (void)hipGetLastError();
        grid = cus;
    }
    if (grid < 0) return;
    (void)hipMemsetAsync((char*)d_ws + WS_CTL, 0, CTL_BYTES, stream);
    Args a{};
    for (int i = 0; i < 19; ++i) a.in[i] = d_in[i];
    a.out = (float*)d_out; a.ws = (unsigned char*)d_ws;
#if MK_ONE_LAUNCH
    a.ph_lo = 0; a.ph_hi = NPHASES;
    hipLaunchKernelGGL(fwd_kernel, dim3(grid), dim3(NTHREADS), LDS_BYTES, stream, a);
#else
    for (int p = 0; p < NPHASES; ++p) { a.ph_lo = p; a.ph_hi = p + 1; hipLaunchKernelGGL(fwd_kernel, dim3(grid), dim3(NTHREADS), LDS_BYTES, stream, a); }
#endif
}
```

```cpp
#include <hip/hip_runtime.h>
#include <cstdio>
#include <cstdint>
#define FIN_XCH_OFF 262144
#define FIN_CNT_OFF 196608
namespace pg8 {
#define PG8_LAS __attribute__((address_space(3)))
typedef unsigned short bf16_t;
typedef short bf16x8 __attribute__((ext_vector_type(8)));
typedef float f32x4 __attribute__((ext_vector_type(4)));
typedef unsigned u32x4 __attribute__((ext_vector_type(4)));
constexpr int BM = 256, BK = 64, HALF = 128, HTB = HALF * BK * 2  , STAGE_BYTES = 8 * HTB, NXCD = 8, WGM = 8;

__host__ __device__ __forceinline__ int lds_byte(int r, int c) { const int st = (r >> 4) * 2 + (c >> 5), rr = r & 15, cc = c & 31, ob = rr * 64 + cc * 2; return st * 1024 + (ob ^ (((ob >> 9) & 1) << 5)); }
__host__ __device__ __forceinline__ void stage_rc(int b, int& R, int& C) { const int st = b / 1024, sb = b % 1024, swz = sb ^ (((sb >> 9) & 1) << 5); R = (st >> 1) * 16 + swz / 64; C = (st & 1) * 32 + (swz % 64) / 2; }
__host__ __device__ __forceinline__ int perm32(int rho) { const int n = rho >> 4, i = rho & 15; return 8 * (i >> 2) + 4 * n + (i & 3); }

struct Unit { int pm, pn, idx; };
struct Gemm { const bf16_t* A; const bf16_t* Bt; int M, N, K, wv; };

struct StaticOrder {
    int nM, nN, nwg, G, c;
    __host__ __device__ void init(int M, int N, int G_, int c_) { nM = M / BM; nN = N / BM; nwg = nM * nN; G = G_; c = c_; }
    __host__ __device__ bool next(int i, Unit& u) const {
        const long L = (long)i * G + c; if (L >= nwg) return false;
        int wgid = (int)L; { const int q = nwg / NXCD, r = nwg % NXCD, xcd = wgid % NXCD, off = wgid / NXCD; wgid = (xcd < r ? xcd * (q + 1) : r * (q + 1) + (xcd - r) * q) + off; }
        const int nig = WGM * nN, gid = wgid / nig, fm = gid * WGM, gsz = (nM - fm) < WGM ? (nM - fm) : WGM;
        u.pm = fm + ((wgid % nig) % gsz); u.pn = (wgid % nig) / gsz; u.idx = i; return true;
    }
    __device__ __forceinline__ void a_ready(const Unit&) const {}
    __device__ __forceinline__ void done(const Unit&) const {}
};
__device__ __forceinline__ unsigned cvt_pk_bf16(float lo, float hi) { unsigned r; asm volatile("v_cvt_pk_bf16_f32 %0, %1, %2" : "=v"(r) : "v"(lo), "v"(hi)); return r; }
typedef float f32x2 __attribute__((ext_vector_type(2)));
constexpr int EP_ROWS = 8192;
template <class Sched> __device__ __forceinline__ void prep_rstd(const float* ssp, const Sched& S, PG8_LAS float* tab, int tid) {
    float pv[3][32]; int slot[3];
#pragma unroll
    for (int q = 0; q < 3; ++q) { const int idx = tid + 512 * q, i = idx >> 8, r = idx & 255; Unit u; slot[q] = -1;
        const bool ok = S.next(i, u); if (ok) slot[q] = idx; const float* p = ssp + (ok ? u.pm * BM + r : 0);
#pragma unroll
        for (int j = 0; j < 32; ++j) pv[q][j] = p[(size_t)j * EP_ROWS]; }
#pragma unroll
    for (int q = 0; q < 3; ++q) { float s[4] = {0.f, 0.f, 0.f, 0.f};
#pragma unroll
        for (int j = 0; j < 32; j += 4) { s[0] += pv[q][j]; s[1] += pv[q][j + 1]; s[2] += pv[q][j + 2]; s[3] += pv[q][j + 3]; }
        if (slot[q] >= 0) tab[slot[q]] = 1.0f / sqrtf(((s[0] + s[1]) + (s[2] + s[3])) * (1.0f / 2048.0f) + 1e-6f); }
    __syncthreads();
}
struct EpiProj {
    static constexpr bool PERM = true, AFTER_DRAIN = false, ROWPERM = false, PREFETCH = false;
    bf16_t* O; int ldc; const PG8_LAS float* rtab; const float* ropetab;
    __device__ __forceinline__ void operator()(const f32x4 (&acc)[2][2][4][2], const Unit& u, int wr, int wc, int fr, int fq) const {
        const int row0 = u.pm * BM + wr * 64 + fr, col0 = u.pn * BM + wc * 32 + 8 * fq;
        const bool rk = (ropetab != nullptr) && (wc == 0) && (u.pn == 10 || u.pn == 12);
#pragma unroll
        for (int ai = 0; ai < 2; ++ai) {
#pragma unroll
          for (int mp = 0; mp < 4; mp += 2) {
            f32x4 tt[2][4];
            if (rk) {
#pragma unroll
                for (int m = 0; m < 2; ++m)
#pragma unroll
                    for (int q = 0; q < 4; ++q) tt[m][q] = *(const f32x4*)(ropetab + (size_t)(row0 + ai * HALF + (mp + m) * 16) * 32 + 16 * (fq & 1) + 4 * q); }
#pragma unroll
            for (int m = mp; m < mp + 2; ++m) { const int row = row0 + ai * HALF + m * 16; bf16_t* rowp = O + (size_t)row * ldc + col0; const float s = rtab[u.idx * 256 + ai * HALF + wr * 64 + m * 16 + fr];
                f32x4 c0, s0, c1, s1;
                if (rk) { const f32x4 t0 = tt[m - mp][0], t1 = tt[m - mp][1], t2 = tt[m - mp][2], t3 = tt[m - mp][3];
                    const float sg = (fq < 2) ? -1.0f : 1.0f;
                    c0 = (f32x4){t0[0], t0[2], t1[0], t1[2]}; s0 = (f32x4){t0[1], t0[3], t1[1], t1[3]} * sg; c1 = (f32x4){t2[0], t2[2], t3[0], t3[2]}; s1 = (f32x4){t2[1], t2[3], t3[1], t3[3]} * sg; }
#pragma unroll
                for (int bj = 0; bj < 2; ++bj) { f32x4 v0 = acc[ai][bj][m][0] * s, v1 = acc[ai][bj][m][1] * s;
                    if (rk) { f32x4 p0, p1;
#pragma unroll
                        for (int j = 0; j < 4; ++j) { p0[j] = __shfl_xor(v0[j], 32); p1[j] = __shfl_xor(v1[j], 32); }
                        v0 = v0 * c0 + p0 * s0; v1 = v1 * c1 + p1 * s1; }
                    u32x4 w; w.x = cvt_pk_bf16(v0[0], v0[1]); w.y = cvt_pk_bf16(v0[2], v0[3]); w.z = cvt_pk_bf16(v1[0], v1[1]); w.w = cvt_pk_bf16(v1[2], v1[3]);
                    *(u32x4*)(rowp + bj * HALF) = w; } } } }
    }
};
struct EpiNull { static constexpr bool PERM = true, AFTER_DRAIN = false, ROWPERM = false, PREFETCH = false; float* sink;
    __device__ __forceinline__ void operator()(const f32x4 (&acc)[2][2][4][2], const Unit& u, int wr, int wc, int fr, int fq) const { if (sink) { f32x4 t = acc[0][0][0][0];
#pragma unroll
        for (int ai = 0; ai < 2; ++ai)
#pragma unroll
            for (int bj = 0; bj < 2; ++bj)
#pragma unroll
                for (int m = 0; m < 4; ++m)
#pragma unroll
                    for (int n = 0; n < 2; ++n) t += acc[ai][bj][m][n];
        *(f32x4*)(sink + (size_t)(u.pm * 32 + u.pn) * 4) = t; } } };
__device__ __forceinline__ float dpp_shr1(float x) { return __builtin_bit_cast(float, __builtin_amdgcn_update_dpp(0, __builtin_bit_cast(int, x), 0x111, 0xf, 0xf, false)); }
__device__ __forceinline__ f32x4 dpp_shr1_4(f32x4 x) { f32x4 r; r[0] = dpp_shr1(x[0]); r[1] = dpp_shr1(x[1]); r[2] = dpp_shr1(x[2]); r[3] = dpp_shr1(x[3]); return r; }
__device__ __forceinline__ f32x4 silu_mul4(f32x4 g, f32x4 v) { f32x4 e = g * (-1.4426950408889634f), d;
    d[0] = __builtin_amdgcn_exp2f(e[0]); d[1] = __builtin_amdgcn_exp2f(e[1]); d[2] = __builtin_amdgcn_exp2f(e[2]); d[3] = __builtin_amdgcn_exp2f(e[3]); d = d + 1.0f;
    f32x4 r; r[0] = __builtin_amdgcn_rcpf(d[0]); r[1] = __builtin_amdgcn_rcpf(d[1]); r[2] = __builtin_amdgcn_rcpf(d[2]); r[3] = __builtin_amdgcn_rcpf(d[3]); return (g * v) * r; }
struct EpiUp {
    static constexpr bool PERM = true, AFTER_DRAIN = false, ROWPERM = true, PREFETCH = true;
    bf16_t* ACT; float* USIDE; const float* cw; const float* cb; const PG8_LAS float* rtab;
    static constexpr int TAPS_F = 6 * 256;
    __device__ __forceinline__ void prefetch(const Unit& u, int wid, int lane) const {
        if (wid < 4) { constexpr int DFF_ = 5632, NUP_ = 11264; const int seg = 2 * wid + (lane >> 5), cg = u.pn * HALF + 4 * (lane & 31);
            const float* src = ((seg < 2) ? cb : cw + (size_t)((seg >> 1) - 1) * NUP_) + ((seg & 1) ? DFF_ : 0) + cg;
            __builtin_amdgcn_global_load_lds((const unsigned*)src, (PG8_LAS unsigned*)(rtab + TAPS_F + (u.idx & 1) * 1024 + wid * 256), 16, 0, 0); } }
    __device__ __forceinline__ void operator()(const f32x4 (&acc)[2][2][4][2], const Unit& u, int wr, int wc, int fr, int fq) const {
        constexpr int DFF_ = 5632, NUP_ = 11264;
        typedef unsigned u32x2 __attribute__((ext_vector_type(2)));
        u32x2 st[2][4];
#pragma unroll
        for (int n = 0; n < 2; ++n) {
            const int cg = u.pn * HALF + wc * 32 + 8 * fq + 4 * n;
            const PG8_LAS float* tp = rtab + TAPS_F + (u.idx & 1) * 1024 + wc * 32 + 8 * fq + 4 * n;
            const f32x4 bg = *(const PG8_LAS f32x4*)(tp), bv = *(const PG8_LAS f32x4*)(tp + 128);
            const f32x4 wg0 = *(const PG8_LAS f32x4*)(tp + 256), wg1 = *(const PG8_LAS f32x4*)(tp + 512), wg2 = *(const PG8_LAS f32x4*)(tp + 768);
            const f32x4 wv0 = *(const PG8_LAS f32x4*)(tp + 384), wv1 = *(const PG8_LAS f32x4*)(tp + 640), wv2 = *(const PG8_LAS f32x4*)(tp + 896);
#pragma unroll
            for (int ai = 0; ai < 2; ++ai) {
                const int rl0 = ai * HALF + wr * 64 + 4 * fr, row0 = u.pm * BM + rl0;
                const f32x4 sc = *(const PG8_LAS f32x4*)(rtab + u.idx * 256 + rl0);
                const f32x4 g0 = acc[ai][0][0][n] * sc[0], g1 = acc[ai][0][1][n] * sc[1], g2 = acc[ai][0][2][n] * sc[2], g3 = acc[ai][0][3][n] * sc[3];
                const f32x4 v0 = acc[ai][1][0][n] * sc[0], v1 = acc[ai][1][1][n] * sc[1], v2 = acc[ai][1][2][n] * sc[2], v3 = acc[ai][1][3][n] * sc[3];
                const f32x4 gp3 = dpp_shr1_4(g3), gp2 = dpp_shr1_4(g2), vp3 = dpp_shr1_4(v3), vp2 = dpp_shr1_4(v2);
                if (fr == 15) { float* sp = USIDE + ((size_t)(row0 >> 6) * 4) * NUP_ + cg;
                    *(f32x4*)(sp) = g2; *(f32x4*)(sp + DFF_) = v2; *(f32x4*)(sp + NUP_) = g3; *(f32x4*)(sp + NUP_ + DFF_) = v3; }
                if (fr == 0) { float* sp = USIDE + ((size_t)(row0 >> 6) * 4 + 2) * NUP_ + cg;
                    *(f32x4*)(sp) = g0; *(f32x4*)(sp + DFF_) = v0; *(f32x4*)(sp + NUP_) = g1; *(f32x4*)(sp + NUP_ + DFF_) = v1; }
                const f32x4 a0 = silu_mul4(bg + wg0 * gp2 + wg1 * gp3 + wg2 * g0, bv + wv0 * vp2 + wv1 * vp3 + wv2 * v0);
                const f32x4 a1 = silu_mul4(bg + wg0 * gp3 + wg1 * g0 + wg2 * g1, bv + wv0 * vp3 + wv1 * v0 + wv2 * v1);
                const f32x4 a2 = silu_mul4(bg + wg0 * g0 + wg1 * g1 + wg2 * g2, bv + wv0 * v0 + wv1 * v1 + wv2 * v2);
                const f32x4 a3 = silu_mul4(bg + wg0 * g1 + wg1 * g2 + wg2 * g3, bv + wv0 * v1 + wv1 * v2 + wv2 * v3);
                u32x2 w0_, w1_, w2_, w3_;
                w0_.x = cvt_pk_bf16(a0[0], a0[1]); w0_.y = cvt_pk_bf16(a0[2], a0[3]); w1_.x = cvt_pk_bf16(a1[0], a1[1]); w1_.y = cvt_pk_bf16(a1[2], a1[3]);
                w2_.x = cvt_pk_bf16(a2[0], a2[1]); w2_.y = cvt_pk_bf16(a2[2], a2[3]); w3_.x = cvt_pk_bf16(a3[0], a3[1]); w3_.y = cvt_pk_bf16(a3[2], a3[3]);
                if (n == 0) { st[ai][0] = w0_; st[ai][1] = w1_; st[ai][2] = w2_; st[ai][3] = w3_; }
                else { bf16_t* op = ACT + (size_t)row0 * DFF_ + cg - 4;
                    if (fr != 0) { *(u32x4*)(op) = (u32x4){st[ai][0].x, st[ai][0].y, w0_.x, w0_.y}; *(u32x4*)(op + DFF_) = (u32x4){st[ai][1].x, st[ai][1].y, w1_.x, w1_.y}; }
                    *(u32x4*)(op + 2 * DFF_) = (u32x4){st[ai][2].x, st[ai][2].y, w2_.x, w2_.y}; *(u32x4*)(op + 3 * DFF_) = (u32x4){st[ai][3].x, st[ai][3].y, w3_.x, w3_.y}; }
            }
        }
    }
};
#ifndef FIN_XCH_OFF
#error FIN_XCH_OFF / FIN_CNT_OFF (byte offsets of the final norm's exchange slots and counters in the workspace) must be defined before this point
#endif
struct EpiRes {
    static constexpr bool PERM = true, AFTER_DRAIN = false, ROWPERM = false, PREFETCH = false;
    const float* basef; bf16_t* xb; float* ssp;
    PG8_LAS float* ltab;
    __device__ __forceinline__ void operator()(f32x4 (&acc)[2][2][4][2], const Unit& u, int wr, int wc, int fr, int fq) const {
        const int row0 = u.pm * BM + wr * 64 + fr, col0 = u.pn * BM + wc * 32 + 8 * fq;
        if (ltab) {
            f32x4 (&a)[2][2][4][2] = acc;
            const void* const* kp_ = (const void* const*)__builtin_amdgcn_kernarg_segment_ptr(); int z_ = 0; asm volatile("" : "+s"(z_));
            float* const fout = (float*)kp_[z_ + 19]; const float* const fgain = (const float*)kp_[z_ + 18]; unsigned char* const ws_ = (unsigned char*)kp_[z_ + 20];
            float* const xch = (float*)(ws_ + FIN_XCH_OFF); unsigned* const cnt = (unsigned*)(ws_ + FIN_CNT_OFF);
            PG8_LAS float* Pt = ltab; PG8_LAS float* St = ltab + 1024; PG8_LAS unsigned* fl = (PG8_LAS unsigned*)(ltab + 1280);
            u32x4 pr[2][4][2];
#pragma unroll
            for (int ai = 0; ai < 2; ++ai)
#pragma unroll
                for (int m = 0; m < 4; ++m)
#pragma unroll
                    for (int bj = 0; bj < 2; ++bj) pr[ai][m][bj] = *(const u32x4*)(xb + (size_t)(row0 + ai * HALF + m * 16) * 2048 + col0 + bj * HALF);
#pragma unroll
            for (int ai = 0; ai < 2; ++ai)
#pragma unroll
                for (int m = 0; m < 4; ++m) { float ss = 0.f;
#pragma unroll
                    for (int bj = 0; bj < 2; ++bj) { const u32x4 pb = pr[ai][m][bj];
                        const f32x4 b0 = (f32x4){__builtin_bit_cast(float, pb.x << 16), __builtin_bit_cast(float, pb.x & 0xffff0000u), __builtin_bit_cast(float, pb.y << 16), __builtin_bit_cast(float, pb.y & 0xffff0000u)};
                        const f32x4 b1 = (f32x4){__builtin_bit_cast(float, pb.z << 16), __builtin_bit_cast(float, pb.z & 0xffff0000u), __builtin_bit_cast(float, pb.w << 16), __builtin_bit_cast(float, pb.w & 0xffff0000u)};
                        const f32x4 v0 = a[ai][bj][m][0] + b0, v1 = a[ai][bj][m][1] + b1; a[ai][bj][m][0] = v0; a[ai][bj][m][1] = v1;
                        ss += (v0[0] * v0[0] + v0[1] * v0[1]) + (v0[2] * v0[2] + v0[3] * v0[3]) + (v1[0] * v1[0] + v1[1] * v1[1]) + (v1[2] * v1[2] + v1[3] * v1[3]); }
                    ss += __shfl_xor(ss, 16); ss += __shfl_xor(ss, 32);
                    if (fq == 0) Pt[(ai * HALF + wr * 64 + m * 16 + fr) * 4 + wc] = ss; }
            asm volatile("s_waitcnt lgkmcnt(0)" ::: "memory"); __builtin_amdgcn_s_barrier(); asm volatile("" ::: "memory");
            unsigned z2 = 0u; asm volatile("" : "+v"(z2));
            const int wid = wr * 4 + wc, lane = (int)__builtin_amdgcn_mbcnt_hi(~0u, __builtin_amdgcn_mbcnt_lo(~0u, z2)), row = wid * 32 + (lane & 31);
            if (lane < 32) { const f32x4 p = *(const PG8_LAS f32x4*)(Pt + row * 4);
                __hip_atomic_store(xch + (size_t)(u.pm * BM + row) * 8 + u.pn, (p[0] + p[1]) + (p[2] + p[3]), __ATOMIC_RELAXED, __HIP_MEMORY_SCOPE_AGENT); }
            asm volatile("s_waitcnt vmcnt(0)" ::: "memory");
            if (lane == 0) __hip_atomic_fetch_add(cnt + 64 * u.pm, 1u, __ATOMIC_RELAXED, __HIP_MEMORY_SCOPE_AGENT);
            if (wid == 0) {
                unsigned sp = 0u;
                while ((unsigned)__builtin_amdgcn_readfirstlane(__hip_atomic_load(cnt + 64 * u.pm, __ATOMIC_RELAXED, __HIP_MEMORY_SCOPE_AGENT)) < 64u) { __builtin_amdgcn_s_sleep(2); if (++sp > (1u << 22)) break; }
                __builtin_amdgcn_fence(__ATOMIC_ACQUIRE, "agent");
                if (lane == 0) fl[0] = 0u; }
            asm volatile("s_waitcnt vmcnt(0) lgkmcnt(0)" ::: "memory"); __builtin_amdgcn_s_barrier(); asm volatile("" ::: "memory");
            if (lane < 32) { const float* xp = xch + (size_t)(u.pm * BM + row) * 8; float t = 0.f;
#pragma unroll
                for (int q = 0; q < 8; ++q) t += __hip_atomic_load(xp + q, __ATOMIC_RELAXED, __HIP_MEMORY_SCOPE_AGENT);
                St[row] = 1.0f / sqrtf(t * (1.0f / 2048.0f) + 1e-6f); }
            asm volatile("s_waitcnt lgkmcnt(0)" ::: "memory"); __builtin_amdgcn_s_barrier(); asm volatile("" ::: "memory");
            f32x4 gv[2][2];
#pragma unroll
            for (int bj = 0; bj < 2; ++bj) { gv[bj][0] = *(const f32x4*)(fgain + col0 + bj * HALF); gv[bj][1] = *(const f32x4*)(fgain + col0 + bj * HALF + 4); }
#pragma unroll
            for (int ai = 0; ai < 2; ++ai)
#pragma unroll
                for (int m = 0; m < 4; ++m) { const float r = St[ai * HALF + wr * 64 + m * 16 + fr]; float* op = fout + (size_t)(row0 + ai * HALF + m * 16) * 2048 + col0;
#pragma unroll
                    for (int bj = 0; bj < 2; ++bj) { *(f32x4*)(op + bj * HALF) = a[ai][bj][m][0] * r * gv[bj][0]; *(f32x4*)(op + bj * HALF + 4) = a[ai][bj][m][1] * r * gv[bj][1]; } }
            return;
        }
        u32x4 pbv[2][4][2];
        if (!basef) {
#pragma unroll
            for (int ai = 0; ai < 2; ++ai)
#pragma unroll
                for (int m = 0; m < 4; ++m)
#pragma unroll
                    for (int bj = 0; bj < 2; ++bj) pbv[ai][m][bj] = *(const u32x4*)(xb + (size_t)(row0 + ai * HALF + m * 16) * 2048 + col0 + bj * HALF);
        }
#pragma unroll
        for (int ai = 0; ai < 2; ++ai)
#pragma unroll
            for (int m = 0; m < 4; ++m) { const int row = row0 + ai * HALF + m * 16; const size_t off = (size_t)row * 2048 + col0; float ss = 0.f;
#pragma unroll
                for (int bj = 0; bj < 2; ++bj) { f32x4 b0, b1;
                    if (basef) { b0 = *(const f32x4*)(basef + off + bj * HALF); b1 = *(const f32x4*)(basef + off + bj * HALF + 4); }
                    else { const u32x4 pb = pbv[ai][m][bj];
                        b0 = (f32x4){__builtin_bit_cast(float, pb.x << 16), __builtin_bit_cast(float, pb.x & 0xffff0000u), __builtin_bit_cast(float, pb.y << 16), __builtin_bit_cast(float, pb.y & 0xffff0000u)};
                        b1 = (f32x4){__builtin_bit_cast(float, pb.z << 16), __builtin_bit_cast(float, pb.z & 0xffff0000u), __builtin_bit_cast(float, pb.w << 16), __builtin_bit_cast(float, pb.w & 0xffff0000u)}; }
                    const f32x4 v0 = acc[ai][bj][m][0] + b0, v1 = acc[ai][bj][m][1] + b1;
                    ss += (v0[0] * v0[0] + v0[1] * v0[1]) + (v0[2] * v0[2] + v0[3] * v0[3]) + (v1[0] * v1[0] + v1[1] * v1[1]) + (v1[2] * v1[2] + v1[3] * v1[3]);
                    u32x4 w; w.x = cvt_pk_bf16(v0[0], v0[1]); w.y = cvt_pk_bf16(v0[2], v0[3]); w.z = cvt_pk_bf16(v1[0], v1[1]); w.w = cvt_pk_bf16(v1[2], v1[3]);
                    *(u32x4*)(xb + off + bj * HALF) = w; }
                ss += __shfl_xor(ss, 16); ss += __shfl_xor(ss, 32);
                if (fq == 0) ssp[(size_t)(u.pn * 4 + wc) * EP_ROWS + row] = ss; }
    }
};
template <class Epi, class Sched, bool ALIGN_EPI = false, bool SP2 = false>
__device__ __forceinline__ void gemm_phase(PG8_LAS unsigned char* lds, const Gemm g, const Sched& S, const Epi& E) {
    int tid_; { unsigned z_ = 0u; asm volatile("" : "+v"(z_)); tid_ = (g.wv << 6) | (int)__builtin_amdgcn_mbcnt_hi(~0u, __builtin_amdgcn_mbcnt_lo(~0u, z_)); } asm volatile("" : "+v"(tid_));
    const int tid = tid_, wid = __builtin_amdgcn_readfirstlane(tid >> 6), lane = tid & 63, wr = wid >> 2, wc = wid & 3, fr = lane & 15, fq = lane >> 4;
    const int K = g.K, nt = K / BK;
    unsigned voffA[2], voffB[2];
#pragma unroll
    for (int i = 0; i < 2; ++i) { int R, C; stage_rc(tid * 16 + i * 8192, R, C); const int Rb = Epi::PERM ? ((R & ~31) + perm32(R & 31)) : R;
        const int Ra = Epi::ROWPERM ? ((R & 64) + 4 * (R & 15) + ((R >> 4) & 3)) : R;
        voffA[i] = (unsigned)(Ra * K + C) * 2u; voffB[i] = (unsigned)(Rb * K + C) * 2u; }
    const size_t kstep = (size_t)(BK * 2);
    const size_t hstep = (size_t)HALF * K * 2;
    const size_t tstep = 2 * hstep;
    const unsigned ldsw = (unsigned)wid * 1024u;
    const int aoff = lds_byte(wr * 64 + fr, fq * 8), boff = lds_byte(wc * 32 + fr, fq * 8);
#define PG8_SA(b, h) (((b) * 2 + (h)) * HTB)
#define PG8_SB(b, h) ((4 + (b) * 2 + (h)) * HTB)
#define PG8_STAGE(bufoff, gbase, voff) do { _Pragma("unroll") for (int _i = 0; _i < 2; ++_i) \
        __builtin_amdgcn_global_load_lds((const unsigned*)((const char*)(gbase) + (voff)[_i]), (PG8_LAS unsigned*)(lds + (bufoff) + ldsw + _i * 8192), 16, 0, 0); } while (0)
#define PG8_LDA(dst, b, h) do { _Pragma("unroll") for (int m = 0; m < 4; ++m) _Pragma("unroll") for (int k = 0; k < 2; ++k) dst[m][k] = *(const PG8_LAS bf16x8*)(lds + PG8_SA(b, h) + aoff + m * 2048 + k * 1024); } while (0)
#define PG8_LDB(dst, b, h) do { _Pragma("unroll") for (int n = 0; n < 2; ++n) _Pragma("unroll") for (int k = 0; k < 2; ++k) dst[n][k] = *(const PG8_LAS bf16x8*)(lds + PG8_SB(b, h) + boff + n * 2048 + k * 1024); } while (0)
#define PG8_MMA(ai, bj, At, Bt) do { __builtin_amdgcn_s_setprio(1); _Pragma("unroll") for (int m = 0; m < 4; ++m) _Pragma("unroll") for (int n = 0; n < 2; ++n) _Pragma("unroll") for (int k = 0; k < 2; ++k) \
        acc[ai][bj][m][n] = __builtin_amdgcn_mfma_f32_16x16x32_bf16(Bt[n][k], At[m][k], acc[ai][bj][m][n], 0, 0, 0); __builtin_amdgcn_s_setprio(0); } while (0)
#define PG8_WAIT_V(n) asm volatile("s_waitcnt vmcnt(" #n ")" ::: "memory")
#define PG8_WAIT_L(n) asm volatile("s_waitcnt lgkmcnt(" #n ")" ::: "memory")
#define PG8_BAR __builtin_amdgcn_s_barrier()
#define PG8_SCHED __builtin_amdgcn_sched_barrier(0)
    Unit cur, nxt; int ui = 0;
    if (!S.next(0, cur)) return;
    f32x4 acc[2][2][4][2];
#pragma unroll
    for (int a = 0; a < 2; ++a)
#pragma unroll
        for (int b = 0; b < 2; ++b)
#pragma unroll
            for (int m = 0; m < 4; ++m)
#pragma unroll
                for (int n = 0; n < 2; ++n) acc[a][b][m][n] = (f32x4){0.f, 0.f, 0.f, 0.f};
    bf16x8 At[4][2], B0[2][2], B1[2][2];
    const char* cA = (const char*)g.A + (size_t)cur.pm * tstep; const char* cB = (const char*)g.Bt + (size_t)cur.pn * tstep;
    S.a_ready(cur);
    if constexpr (SP2) {
        PG8_STAGE(PG8_SB(0, 0), cB, voffB); PG8_STAGE(PG8_SB(0, 1), cB + hstep, voffB); PG8_STAGE(PG8_SA(0, 0), cA, voffA); PG8_STAGE(PG8_SA(0, 1), cA + hstep, voffA);
        if (wr == 1) PG8_BAR;
        PG8_WAIT_V(2); PG8_BAR;
        PG8_STAGE(PG8_SB(1, 0), cB + kstep, voffB); PG8_STAGE(PG8_SA(1, 0), cA + kstep, voffA); PG8_STAGE(PG8_SB(1, 1), cB + hstep + kstep, voffB);
        PG8_WAIT_V(6); PG8_BAR;
    } else {
        PG8_STAGE(PG8_SB(0, 0), cB, voffB); PG8_STAGE(PG8_SA(0, 0), cA, voffA); PG8_STAGE(PG8_SB(0, 1), cB + hstep, voffB); PG8_STAGE(PG8_SA(0, 1), cA + hstep, voffA);
        if (wr == 1) PG8_BAR;
        PG8_WAIT_V(4); PG8_BAR;
        PG8_STAGE(PG8_SB(1, 0), cB + kstep, voffB); PG8_STAGE(PG8_SA(1, 0), cA + kstep, voffA); PG8_STAGE(PG8_SB(1, 1), cB + hstep + kstep, voffB);
        PG8_WAIT_V(6); PG8_BAR;
    }
    for (;;) {
        const bool has_next = S.next(ui + 1, nxt);
        const char* nA = has_next ? (const char*)g.A + (size_t)nxt.pm * tstep : cA; const char* nB = has_next ? (const char*)g.Bt + (size_t)nxt.pn * tstep : cB;
        if constexpr (Epi::PREFETCH) E.prefetch(cur, wid, lane);
        for (int t = 0; t < nt; t += 2) {
            const bool last = (t == nt - 2);
            const char* a1 = cA + (size_t)(t + 1) * kstep;
            const char* a2 = last ? nA : cA + (size_t)(t + 2) * kstep; const char* b2 = last ? nB : cB + (size_t)(t + 2) * kstep;
            const char* a3 = a2 + kstep; const char* b3 = b2 + kstep;
            if (last && has_next) S.a_ready(nxt);
            if constexpr (SP2) {
            PG8_LDB(B0, 0, 0); PG8_LDB(B1, 0, 1); PG8_SCHED; PG8_LDA(At, 0, 0); PG8_STAGE(PG8_SA(1, 1), a1 + hstep, voffA);
            PG8_WAIT_V(8); PG8_WAIT_L(0); PG8_BAR; PG8_MMA(0, 0, At, B0); PG8_MMA(0, 1, At, B1); PG8_BAR; PG8_SCHED;
            PG8_LDA(At, 0, 1); PG8_STAGE(PG8_SB(0, 0), b2, voffB); PG8_STAGE(PG8_SB(0, 1), b2 + hstep, voffB); PG8_STAGE(PG8_SA(0, 0), a2, voffA);
            PG8_WAIT_V(8); PG8_WAIT_L(0); PG8_BAR; PG8_MMA(1, 0, At, B0); PG8_MMA(1, 1, At, B1); PG8_BAR; PG8_SCHED;
            PG8_LDB(B0, 1, 0); PG8_LDB(B1, 1, 1); PG8_SCHED; PG8_LDA(At, 1, 0); PG8_STAGE(PG8_SA(0, 1), a2 + hstep, voffA);
            PG8_WAIT_V(8); PG8_WAIT_L(0); PG8_BAR; PG8_MMA(0, 0, At, B0); PG8_MMA(0, 1, At, B1); PG8_BAR; PG8_SCHED;
            PG8_LDA(At, 1, 1); PG8_STAGE(PG8_SB(1, 0), b3, voffB); PG8_STAGE(PG8_SB(1, 1), b3 + hstep, voffB); PG8_STAGE(PG8_SA(1, 0), a3, voffA);
            PG8_WAIT_V(8); PG8_WAIT_L(0); PG8_BAR; PG8_MMA(1, 0, At, B0); PG8_MMA(1, 1, At, B1); PG8_BAR; PG8_SCHED;
            } else {
            PG8_LDB(B0, 0, 0); PG8_SCHED; PG8_LDA(At, 0, 0); PG8_STAGE(PG8_SA(1, 1), a1 + hstep, voffA);
            PG8_WAIT_L(8); PG8_BAR; PG8_WAIT_L(0); PG8_MMA(0, 0, At, B0); PG8_BAR; PG8_SCHED;
            PG8_LDB(B1, 0, 1); PG8_STAGE(PG8_SB(0, 0), b2, voffB);
            PG8_BAR; PG8_WAIT_L(0); PG8_MMA(0, 1, At, B1); PG8_BAR;
            PG8_LDA(At, 0, 1); PG8_STAGE(PG8_SA(0, 0), a2, voffA);
            PG8_BAR; PG8_WAIT_L(0); PG8_MMA(1, 0, At, B0); PG8_BAR; PG8_SCHED;
            PG8_STAGE(PG8_SB(0, 1), b2 + hstep, voffB);
            PG8_WAIT_V(6); PG8_BAR; PG8_MMA(1, 1, At, B1); PG8_BAR;
            PG8_LDB(B0, 1, 0); PG8_SCHED; PG8_LDA(At, 1, 0); PG8_STAGE(PG8_SA(0, 1), a2 + hstep, voffA);
            PG8_WAIT_L(8); PG8_BAR; PG8_WAIT_L(0); PG8_MMA(0, 0, At, B0); PG8_BAR; PG8_SCHED;
            PG8_LDB(B1, 1, 1); PG8_STAGE(PG8_SB(1, 0), b3, voffB);
            PG8_BAR; PG8_WAIT_L(0); PG8_MMA(0, 1, At, B1); PG8_BAR;
            PG8_LDA(At, 1, 1); PG8_STAGE(PG8_SA(1, 0), a3, voffA);
            PG8_BAR; PG8_WAIT_L(0); PG8_MMA(1, 0, At, B0); PG8_BAR; PG8_SCHED;
            PG8_STAGE(PG8_SB(1, 1), b3 + hstep, voffB);
            PG8_WAIT_V(6); PG8_BAR; PG8_MMA(1, 1, At, B1); PG8_BAR;
            }
        }
        if constexpr (ALIGN_EPI) { if (wr == 0) PG8_BAR; }
        if constexpr (!Epi::AFTER_DRAIN) { E(acc, cur, wr, wc, fr, fq); S.done(cur); }
        if (!has_next) break;
#pragma unroll
        for (int a = 0; a < 2; ++a)
#pragma unroll
            for (int b = 0; b < 2; ++b)
#pragma unroll
                for (int m = 0; m < 4; ++m)
#pragma unroll
                    for (int n = 0; n < 2; ++n) acc[a][b][m][n] = (f32x4){0.f, 0.f, 0.f, 0.f};
        cur = nxt; cA = nA; cB = nB; ++ui;
        if constexpr (ALIGN_EPI) { if (wr == 1) PG8_BAR; }
    }
    PG8_WAIT_V(0);
    if constexpr (!ALIGN_EPI) { if (wr == 0) PG8_BAR; }
    PG8_BAR;
    if constexpr (Epi::AFTER_DRAIN) { E.fused(acc, cur, wr, wc, fr, fq, lds, wid, lane); S.done(cur); }
#undef PG8_SA
#undef PG8_SB
#undef PG8_STAGE
#undef PG8_LDA
#undef PG8_LDB
#undef PG8_MMA
#undef PG8_WAIT_V
#undef PG8_WAIT_L
#undef PG8_BAR
#undef PG8_SCHED
}
}
#ifndef MK_ONE_LAUNCH
#define MK_ONE_LAUNCH 1
#endif
constexpr int NWAVES = 8, NTHREADS = 512;
constexpr int NB = 4, SEQ = 2048, DM = 2048, MROWS = NB * SEQ, DEPTH = 4;
constexpr int NSA_N = 3632, NSA_NP = 3840;
constexpr int PC_Q = 0, PC_KVC = 2048, PC_KVS = 2560, PC_KVW = 3072, PC_GATE = 3584;
constexpr int ML_N = 6160, ML_NP = 6144;
constexpr int MC_Q = 0, MC_K = 1024, MC_V = 2048, MC_OG = 4096;
constexpr int DFF = 5632, NUP = 2 * DFF;
constexpr int NCMP = 127;
constexpr float ATT_SCALE = 0.08838834764831845f;
constexpr size_t al256(size_t x) { return (x + 255) & ~(size_t)255; }
constexpr size_t WS_CTL = 0, CTL_BYTES = 1u << 20;
constexpr size_t SZ_WNSA = (size_t)NSA_NP * DM * 2, SZ_WML = (size_t)ML_NP * DM * 2, SZ_WOUT = (size_t)DM * DM * 2, SZ_WUP = (size_t)NUP * DM * 2, SZ_WDN = (size_t)DM * DFF * 2;
constexpr size_t WS_WNSA = WS_CTL + CTL_BYTES;
constexpr size_t WS_WML = WS_WNSA + 2 * SZ_WNSA;
constexpr size_t WS_WOUT = WS_WML + 2 * SZ_WML;
constexpr size_t WS_WUP = WS_WOUT + 4 * SZ_WOUT;
constexpr size_t WS_WDN = WS_WUP + 4 * SZ_WUP;
constexpr size_t WS_XR = WS_WDN + 4 * SZ_WDN;
constexpr size_t WS_XB = WS_XR + (size_t)MROWS * DM * 4;
constexpr size_t WS_SSP = WS_XB + (size_t)MROWS * DM * 2;
constexpr size_t WS_P = WS_SSP + (size_t)32 * MROWS * 4;
constexpr size_t WS_QR = WS_P + (size_t)MROWS * ML_NP * 2;
constexpr size_t WS_KC = WS_QR + (size_t)MROWS * DM * 2;
constexpr size_t WS_VC = WS_KC + (size_t)NB * 2 * 128 * 128 * 4;
constexpr size_t WS_O = WS_VC + (size_t)NB * 2 * 128 * 128 * 4;
constexpr size_t WS_U = WS_O + (size_t)MROWS * DM * 2;
constexpr size_t WS_ACT = WS_U + (size_t)MROWS * NUP * 2;
constexpr size_t WS_ROPE = WS_ACT + (size_t)MROWS * DFF * 2;
constexpr size_t WS_GATES = WS_ROPE + (size_t)MROWS * 32 * 4;
constexpr size_t WS_HRAW = WS_GATES + (size_t)MROWS * 16 * 4;
constexpr size_t WS_HSS = WS_HRAW + (size_t)MROWS * DM * 4;
constexpr size_t WS_W1T = WS_HSS + (size_t)MROWS * 64 * 4;
constexpr size_t WS_W2T = WS_W1T + (size_t)2 * 2 * 32 * 128 * 128 * 2;
constexpr size_t WS_WGT = WS_W2T + (size_t)2 * 2 * 128 * 128 * 2;
constexpr size_t WS_END = WS_WGT + (size_t)2 * 16 * DM * 2;
constexpr int CW_BAR = 4096;
constexpr int RING_BYTES = 131072, LDS_BYTES = 163840, MISC_OFF = LDS_BYTES - 256, RSTD_OFF = 135168;

#define GAS __attribute__((address_space(1)))
#define LAS __attribute__((address_space(3)))
typedef unsigned short bf16;
typedef unsigned v4u __attribute__((ext_vector_type(4)));
typedef unsigned v2u __attribute__((ext_vector_type(2)));
typedef float f32x4 __attribute__((ext_vector_type(4)));
typedef float f32x2 __attribute__((ext_vector_type(2)));
#define LDS_WAIT() asm volatile("s_waitcnt lgkmcnt(0)" ::: "memory")
__device__ __forceinline__ unsigned f2bf(float f) { unsigned u = __builtin_bit_cast(unsigned, f); return (u + 0x7fffu + ((u >> 16) & 1u)) >> 16; }
__device__ __forceinline__ unsigned pk2(float lo, float hi) { return f2bf(lo) | (f2bf(hi) << 16); }
__device__ __forceinline__ float bf2f(unsigned short b) { return __builtin_bit_cast(float, (unsigned)b << 16); }
__device__ __forceinline__ float bflo(unsigned w) { return __builtin_bit_cast(float, w << 16); }
__device__ __forceinline__ float bfhi(unsigned w) { return __builtin_bit_cast(float, w & 0xffff0000u); }
__device__ __forceinline__ int hw_lane() { unsigned z = 0u; asm volatile("" : "+v"(z)); return (int)__builtin_amdgcn_mbcnt_hi(~0u, __builtin_amdgcn_mbcnt_lo(~0u, z)); }
__device__ __forceinline__ float wave_sum(float v) {
#pragma unroll
    for (int o = 1; o < 64; o <<= 1) v += __shfl_xor(v, o);
    return v;
}
__device__ __forceinline__ float wave_max(float v) {
#pragma unroll
    for (int o = 1; o < 64; o <<= 1) v = fmaxf(v, __shfl_xor(v, o));
    return v;
}
__device__ __forceinline__ float sigmoidf_(float x) { return 1.0f / (1.0f + __expf(-x)); }
__device__ __forceinline__ float tanhf_(float y) { return 1.0f - 2.0f / (__expf(2.0f * y) + 1.0f); }
#define XB_TMO      128
#define XB_XCNT(j)  (256  + 64 * (j))
#define XB_XSUB(j)  (1280 + 64 * (j))
#define XB_XGEN(j)  (2304 + 64 * (j))
#define XB_TOP      3328
#define XB_TOPGEN   3392
#define XCD_BAR_WORDS 3456
#define XB_SPIN_CAP (1u << 18)

__device__ __forceinline__ unsigned xb_ld(unsigned* p)              { return __hip_atomic_load(p, __ATOMIC_RELAXED, __HIP_MEMORY_SCOPE_AGENT); }
__device__ __forceinline__ unsigned xb_add(unsigned* p, unsigned v) { return __hip_atomic_fetch_add(p, v, __ATOMIC_RELAXED, __HIP_MEMORY_SCOPE_AGENT); }
__device__ __forceinline__ unsigned xb_xcc_id() { return (unsigned)__builtin_amdgcn_s_getreg((3 << 11) | 20) & 0xFu; }
#define XB_SPIN(cond, bar) do { unsigned _sp = 0; while (cond) { __builtin_amdgcn_s_sleep(1); \
    if ((++_sp & 255u) == 0u) { if (xb_ld(&(bar)[XB_TMO])) break; if (_sp > XB_SPIN_CAP) { atomicAdd(&(bar)[XB_TMO], 1u); break; } } } } while (0)

struct XcdBarrier {
    unsigned* bar; unsigned x; int wv;
    volatile LAS unsigned* st;
};

__device__ __forceinline__ bool xb_thread0(int wv) { return wv == 0 && hw_lane() == 0; }
__device__ __forceinline__ XcdBarrier xcd_barrier_post(unsigned* bar, volatile LAS unsigned* st, int wv) {
    XcdBarrier b; b.bar = bar; b.x = xb_xcc_id(); b.st = st; b.wv = wv;
    if (xb_thread0(wv)) (void)xb_add(&bar[XB_XCNT(b.x)], 1u);
    return b;
}
__device__ __forceinline__ void xcd_barrier_complete(unsigned* bar, unsigned x, unsigned& nloc, unsigned& nx) {
    const unsigned G = gridDim.x * gridDim.y * gridDim.z;
    unsigned sum, cnt, mine, sp = 0u;
    for (;;) {
        sum = 0u; cnt = 0u; mine = 0u;
#pragma unroll
        for (unsigned j = 0; j < 16; ++j) { const unsigned c = xb_ld(&bar[XB_XCNT(j)]); sum += c; cnt += (c > 0u) ? 1u : 0u; mine = (j == x) ? c : mine; }
        if (sum == G) break;
        __builtin_amdgcn_s_sleep(1);
        if ((++sp & 255u) == 0u) { if (xb_ld(&bar[XB_TMO])) break; if (sp > XB_SPIN_CAP) { atomicAdd(&bar[XB_TMO], 1u); break; } }
    }
    nloc = mine > 0u ? mine : 1u; nx = cnt > 0u ? cnt : 1u;
}

__device__ __forceinline__ void xcd_barrier(const XcdBarrier& b) {
    asm volatile("s_waitcnt vmcnt(0)" ::: "memory");
    __syncthreads();
    if (xb_thread0(b.wv)) {
        unsigned* bar = b.bar;
        __builtin_amdgcn_s_waitcnt(0);
        unsigned nloc = b.st[0], nx = b.st[1];
        if (nloc == 0u) { xcd_barrier_complete(bar, b.x, nloc, nx); b.st[0] = nloc; b.st[1] = nx; }
        const unsigned old = xb_add(&bar[XB_XSUB(b.x)], 1u);
        const unsigned gen = old / nloc;
        if (old + 1u == (gen + 1u) * nloc) {
            __builtin_amdgcn_fence(__ATOMIC_RELEASE, "agent");
            asm volatile("s_waitcnt vmcnt(0)" ::: "memory");
            const unsigned og = xb_add(&bar[XB_TOP], 1u);
            const unsigned tg = og / nx;
            if (og + 1u == (tg + 1u) * nx) xb_add(&bar[XB_TOPGEN], 1u);
            else XB_SPIN(xb_ld(&bar[XB_TOPGEN]) == tg, bar);
            __builtin_amdgcn_fence(__ATOMIC_ACQUIRE, "agent");
            xb_add(&bar[XB_XGEN(b.x)], 1u);
            asm volatile("s_waitcnt vmcnt(0)" ::: "memory");
        } else {
            XB_SPIN(xb_ld(&bar[XB_XGEN(b.x)]) == gen, bar);
            __builtin_amdgcn_fence(__ATOMIC_ACQUIRE, "agent");
            asm volatile("s_waitcnt vmcnt(0)" ::: "memory");
        }
    }
    __syncthreads();
}
__constant__ double c_rope_inv[16] = {1.0, 0.44036660267178046, 0.19392274474868576, 0.08539710028576561, 0.03760603093086393, 0.016560440080994446, 0.007292664737217109, 0.003211445994752591,
    0.001414213562373095, 0.000622772421914596, 0.0002742481756762073, 0.00012076973741146504, 5.318295896944988e-05, 2.341999896140934e-05, 1.031338537721246e-05, 4.5416704806078695e-06};

__device__ __forceinline__ void cvt_item(const float* W, int ldw, int nvalid, const float* gain, bf16* WT, int K, int npad, int mode, LAS float* scr, int item, int lane) {
    const int nblk = npad / 64, kb = item / nblk, nb = item - kb * nblk, k0 = 64 * kb, n0 = 64 * nb;
    const int kl = lane >> 4, nl = (lane & 15) * 4; const bool ok = (n0 + nl) < nvalid;
    f32x4 v[16]; const int c = lane & 7;
    const int ncol = ok ? n0 + nl : 0;
#pragma unroll
    for (int i = 0; i < 16; ++i) v[i] = __builtin_nontemporal_load((const GAS f32x4*)(W + (size_t)(k0 + kl + 4 * i) * ldw + ncol));
    if (!ok) {
#pragma unroll
        for (int i = 0; i < 16; ++i) v[i] = (f32x4){0.f, 0.f, 0.f, 0.f}; }
#pragma unroll
    for (int i = 0; i < 16; ++i) { const int kk = kl + 4 * i; LAS float* d = scr + kk * 65 + nl; d[0] = v[i].x; d[1] = v[i].y; d[2] = v[i].z; d[3] = v[i].w; }
    f32x4 g0 = (f32x4){1.f, 1.f, 1.f, 1.f}, g1 = g0;
    if (gain) { g0 = *(const f32x4*)(gain + k0 + 8 * c); g1 = *(const f32x4*)(gain + k0 + 8 * c + 4); }
    LDS_WAIT(); asm volatile("" ::: "memory");
#pragma unroll
    for (int j = 0; j < 8; ++j) { const int n = (lane >> 3) + 8 * j; const LAS float* sp = scr + (8 * c) * 65 + n;
        v4u o; o.x = pk2(sp[0 * 65] * g0.x, sp[1 * 65] * g0.y); o.y = pk2(sp[2 * 65] * g0.z, sp[3 * 65] * g0.w); o.z = pk2(sp[4 * 65] * g1.x, sp[5 * 65] * g1.y); o.w = pk2(sp[6 * 65] * g1.z, sp[7 * 65] * g1.w);
        const int nn = n0 + n; int row = nn;
        if (mode == 1) { row = (nn < DFF) ? (256 * (nn >> 7) + (nn & 127)) : (256 * ((nn - DFF) >> 7) + 128 + ((nn - DFF) & 127)); }
        *(GAS v4u*)(WT + (size_t)row * K + k0 + 8 * c) = o; }
    LDS_WAIT(); asm volatile("" ::: "memory");
}

struct Ptrs {
    const float *x; const int* pos;
    const float *nsa_w_in, *nsa_gate_b, *nsa_pe, *nsa_w1, *nsa_w2, *nsa_w_out;
    const float *ml_w_in, *ml_gate_b, *ml_head_norm, *ml_w_out;
    const float *norm_mix, *norm_ffn, *w_up, *conv_w, *conv_b, *w_down, *norm_final;
    float* out; unsigned char* ws;
};

constexpr int CV_NSA_IN = 32 * (NSA_NP / 64), CV_ML_IN = 32 * (ML_NP / 64), CV_OUT = 32 * 32, CV_UP = 32 * (NUP / 64), CV_DN = (DFF / 64) * 32;
__device__ __forceinline__ int cv_layer_items(int layer) { return ((layer & 1) ? CV_ML_IN : CV_NSA_IN) + CV_OUT + CV_UP + CV_DN; }
__device__ __forceinline__ void convert_layer(const Ptrs& A, int layer, int it_lo, int it_hi, int rank, int nranks, LAS float* scr, int lane) {
    const bool ml = layer & 1; const int jl = layer >> 1; const int n_in = ml ? CV_ML_IN : CV_NSA_IN;
    for (int it = it_lo + rank; it < it_hi; it += nranks) {
        if (it < n_in) {
            if (ml) cvt_item(A.ml_w_in + (size_t)jl * DM * ML_N, ML_N, ML_NP, A.norm_mix + (size_t)layer * DM, (bf16*)(A.ws + WS_WML + jl * SZ_WML), DM, ML_NP, 0, scr, it, lane);
            else cvt_item(A.nsa_w_in + (size_t)jl * DM * NSA_N, NSA_N, NSA_N, A.norm_mix + (size_t)layer * DM, (bf16*)(A.ws + WS_WNSA + jl * SZ_WNSA), DM, NSA_NP, 0, scr, it, lane);
        } else if (it < n_in + CV_OUT) cvt_item((ml ? A.ml_w_out : A.nsa_w_out) + (size_t)jl * DM * DM, DM, DM, nullptr, (bf16*)(A.ws + WS_WOUT + layer * SZ_WOUT), DM, DM, 0, scr, it - n_in, lane);
        else if (it < n_in + CV_OUT + CV_UP) cvt_item(A.w_up + (size_t)layer * DM * NUP, NUP, NUP, A.norm_ffn + (size_t)layer * DM, (bf16*)(A.ws + WS_WUP + layer * SZ_WUP), DM, NUP, 1, scr, it - n_in - CV_OUT, lane);
        else cvt_item(A.w_down + (size_t)layer * DFF * DM, DM, DM, nullptr, (bf16*)(A.ws + WS_WDN + layer * SZ_WDN), DFF, DM, 0, scr, it - n_in - CV_OUT - CV_UP, lane);
    }
}
#ifndef CV_TAIL_PCT
#define CV_TAIL_PCT 35
#endif
__device__ __forceinline__ int cv_tail_items(int layer, int G) { const int nwg = (MROWS / 256) * (NUP / 256); const int idle = (nwg % G) ? G - nwg % G : 0; return (layer >= 1 && idle >= 64) ? (int)((long)cv_layer_items(layer) * CV_TAIL_PCT / 100) : 0; }

#ifndef CV_SLOT_ITEMS
#define CV_SLOT_ITEMS 2800
#endif
__device__ __forceinline__ int cv_slot_items(int layer, int G) { return (!(layer & 1) && G >= 128) ? CV_SLOT_ITEMS : 0; }
#ifndef CV_INSLOT_ITEMS
#define CV_INSLOT_ITEMS 2048
#endif
__device__ __forceinline__ int cv_inslot_items(int layer, int G) { return ((layer & 1) && G == 256) ? CV_INSLOT_ITEMS : 0; }

__device__ __forceinline__ void phase_prologue(const Ptrs& A, LAS unsigned char* lds, int G, int vcu, int wave, int lane, int tid) {
    LAS float* scr = (LAS float*)(lds + wave * 16640);
    const int gw = vcu * NWAVES + wave, NGW = G * NWAVES;
    for (int layer = 0; layer < DEPTH; ++layer) convert_layer(A, layer, cv_tail_items(layer, G) + cv_inslot_items(layer, G), cv_layer_items(layer) - cv_slot_items(layer, G), gw, NGW, scr, lane);
    for (int it = gw; it < 132 * 4; it += NGW) { const int m = it >> 2;
        if (m < 128) cvt_item(A.nsa_w1 + (size_t)m * 128 * 128, 128, 128, nullptr, (bf16*)(A.ws + WS_W1T) + (size_t)m * 128 * 128, 128, 128, 0, scr, it & 3, lane);
        else cvt_item(A.nsa_w2 + (size_t)(m - 128) * 128 * 128, 128, 128, nullptr, (bf16*)(A.ws + WS_W2T) + (size_t)(m - 128) * 128 * 128, 128, 128, 0, scr, it & 3, lane); }
    for (int idx = vcu * NTHREADS + tid; idx < 2 * 16 * DM; idx += G * NTHREADS) { const int k = idx & (DM - 1), c = (idx >> 11) & 15, j = idx >> 15;
        ((bf16*)(A.ws + WS_WGT))[idx] = (bf16)f2bf(A.ml_w_in[((size_t)j * DM + k) * ML_N + ML_NP + c] * A.norm_mix[(size_t)(2 * j + 1) * DM + k]); }
    bf16* XB = (bf16*)(A.ws + WS_XB); float* SSP = (float*)(A.ws + WS_SSP);
    for (int m = gw; m < MROWS; m += NGW) {
        const GAS f32x4* xr = (const GAS f32x4*)(A.x + (size_t)m * DM) + lane; float s = 0.f; f32x4 xv[8];
        GAS v2u* o8 = (GAS v2u*)(XB + (size_t)m * DM) + lane;
#pragma unroll
        for (int j = 0; j < 8; ++j) xv[j] = __builtin_nontemporal_load(xr + 64 * j);
#pragma unroll
        for (int j = 0; j < 8; ++j) { const f32x4 v = xv[j]; s += (v.x * v.x + v.y * v.y) + (v.z * v.z + v.w * v.w); v2u w; w.x = pk2(v.x, v.y); w.y = pk2(v.z, v.w); o8[64 * j] = w; }
        s = wave_sum(s);
        if (lane < 32) SSP[(size_t)lane * MROWS + m] = (lane == 0) ? s : 0.f;
    }
    float* ROPE = (float*)(A.ws + WS_ROPE);
    for (int idx = (vcu * NTHREADS + tid); idx < MROWS * 16; idx += G * NTHREADS) {
        const int row = idx >> 4, i = idx & 15; const double rev = (double)A.pos[row] * c_rope_inv[i] * 0.15915494309189535; const float fr = (float)(rev - floor(rev));
        ROPE[2 * idx] = __builtin_amdgcn_cosf(fr); ROPE[2 * idx + 1] = __builtin_amdgcn_sinf(fr);
    }
}

__device__ __forceinline__ void phase_ml_gates(const Ptrs& A, int j, int layer, LAS unsigned char* lds, int G, int vcu, int wave, int lane) {
    typedef short bf16x8 __attribute__((ext_vector_type(8)));
    const bf16* WG = (const bf16*)(A.ws + WS_WGT) + (size_t)j * 16 * DM; const float* gb = A.ml_gate_b + (size_t)j * 16;
    const bf16* XB = (const bf16*)(A.ws + WS_XB); const float* SSP = (const float*)(A.ws + WS_SSP); float* GT = (float*)(A.ws + WS_GATES);
    LAS f32x4* part = (LAS f32x4*)lds;
    const int tq = wave >> 2, kq4 = wave & 3, r16 = lane & 15, kq = lane >> 4;
    for (int tp = vcu; tp < MROWS / 32; tp += G) { const int r0 = (2 * tp + tq) * 16;
        float sp[8];
        if (kq4 == 0) {
#pragma unroll
            for (int q = 0; q < 8; ++q) sp[q] = SSP[(size_t)(8 * kq + q) * MROWS + r0 + r16]; }
        f32x4 acc = (f32x4){0.f, 0.f, 0.f, 0.f};
        const bf16* ap = XB + (size_t)(r0 + r16) * DM + 512 * kq4 + 8 * kq; const bf16* bp = WG + (size_t)r16 * DM + 512 * kq4 + 8 * kq;
        { bf16x8 af[16], bfv[16];
#pragma unroll
            for (int i = 0; i < 16; ++i) { af[i] = *(const bf16x8*)(ap + 32 * i); bfv[i] = *(const bf16x8*)(bp + 32 * i); }
#pragma unroll
            for (int i = 0; i < 16; ++i) acc = __builtin_amdgcn_mfma_f32_16x16x32_bf16(af[i], bfv[i], acc, 0, 0, 0); }
        part[(tq * 4 + kq4) * 64 + lane] = acc;
        __syncthreads();
        if (kq4 == 0) {
            const f32x4 a0 = part[(tq * 4 + 0) * 64 + lane], a1 = part[(tq * 4 + 1) * 64 + lane], a2 = part[(tq * 4 + 2) * 64 + lane], a3 = part[(tq * 4 + 3) * 64 + lane];
            acc = (a0 + a1) + (a2 + a3);
            float ss = ((sp[0] + sp[1]) + (sp[2] + sp[3])) + ((sp[4] + sp[5]) + (sp[6] + sp[7]));
            ss += __shfl_xor(ss, 16); ss += __shfl_xor(ss, 32);
            const float rstd = 1.0f / sqrtf(ss * (1.0f / 2048.0f) + 1e-6f);
            const float bias = gb[r16];
#pragma unroll
            for (int e = 0; e < 4; ++e) { const int row = 4 * kq + e; const float rs = __shfl(rstd, row);
                const float pre = acc[e] * rs + bias; const float z = 15.0f * tanhf_(pre * (1.0f / 15.0f));
                float o;
                if (r16 < 8) o = z; else o = (z > 0.f) ? -__logf(1.0f + __expf(-z)) : (z - __logf(1.0f + __expf(z)));
                GT[(size_t)(r0 + row) * 16 + r16] = o; }
        }
        __syncthreads();
    }
}

__device__ __forceinline__ void rope_pair(v4u a, v4u b, const float* cs, v4u& oa, v4u& ob) {
    const unsigned aw[4] = {a.x, a.y, a.z, a.w}, bw[4] = {b.x, b.y, b.z, b.w}; unsigned ra[4], rb[4];
#pragma unroll
    for (int q = 0; q < 4; ++q) {
        const float x1l = bflo(aw[q]), x1h = bfhi(aw[q]), x2l = bflo(bw[q]), x2h = bfhi(bw[q]);
        const float cl = cs[4 * q], sl = cs[4 * q + 1], ch = cs[4 * q + 2], sh = cs[4 * q + 3];
        ra[q] = pk2(x1l * cl - x2l * sl, x1h * ch - x2h * sh); rb[q] = pk2(x2l * cl + x1l * sl, x2h * ch + x1h * sh); }
    oa = (v4u){ra[0], ra[1], ra[2], ra[3]}; ob = (v4u){rb[0], rb[1], rb[2], rb[3]};
}
__device__ __forceinline__ void phase_rope(const Ptrs& A, int G, int vcu, int tid) {
    bf16* P = (bf16*)(A.ws + WS_P); bf16* QR = (bf16*)(A.ws + WS_QR); const float* ROPE = (const float*)(A.ws + WS_ROPE);
    const int gt = vcu * NTHREADS + tid, NGT = G * NTHREADS;
    for (int idx = gt; idx < MROWS * 16 * 8; idx += NGT) {
        const int pc = idx & 7, h = (idx >> 3) & 15, row = idx >> 7;
        const bf16* src = P + (size_t)row * NSA_NP + PC_Q + h * 128; bf16* dst = QR + (size_t)row * DM + h * 128;
        if (pc < 2) { const v4u a = *(const v4u*)(src + 8 * pc), b = *(const v4u*)(src + 16 + 8 * pc); float cs[16];
#pragma unroll
            for (int e = 0; e < 4; ++e) { const f32x4 t = *(const f32x4*)(ROPE + (size_t)row * 32 + pc * 16 + 4 * e); cs[4 * e] = t.x; cs[4 * e + 1] = t.y; cs[4 * e + 2] = t.z; cs[4 * e + 3] = t.w; }
            v4u oa, ob; rope_pair(a, b, cs, oa, ob); *(v4u*)(dst + 8 * pc) = oa; *(v4u*)(dst + 16 + 8 * pc) = ob; }
        else { const int c0 = 32 + (pc - 2) * 16; *(v4u*)(dst + c0) = *(const v4u*)(src + c0); *(v4u*)(dst + c0 + 8) = *(const v4u*)(src + c0 + 8); }
    }
    for (int idx = gt; idx < MROWS * 8; idx += NGT) {
        const int pc = idx & 1, g = (idx >> 1) & 1, wh = (idx >> 2) & 1, row = idx >> 3;
        bf16* p = P + (size_t)row * NSA_NP + (wh ? PC_KVW : PC_KVS) + g * 128;
        const v4u a = *(const v4u*)(p + 8 * pc), b = *(const v4u*)(p + 16 + 8 * pc); float cs[16];
#pragma unroll
        for (int e = 0; e < 4; ++e) { const f32x4 t = *(const f32x4*)(ROPE + (size_t)row * 32 + pc * 16 + 4 * e); cs[4 * e] = t.x; cs[4 * e + 1] = t.y; cs[4 * e + 2] = t.z; cs[4 * e + 3] = t.w; }
        v4u oa, ob; rope_pair(a, b, cs, oa, ob); *(v4u*)(p + 8 * pc) = oa; *(v4u*)(p + 16 + 8 * pc) = ob;
    }
}

__device__ __forceinline__ void phase_compress(const Ptrs& A, int j_layer, LAS unsigned char* lds, int G, int vcu, int tid) {
    const bf16* P = (const bf16*)(A.ws + WS_P); bf16* KC = (bf16*)(A.ws + WS_KC); bf16* VC = (bf16*)(A.ws + WS_VC);
    const float* pe = A.nsa_pe + (size_t)j_layer * 2 * 32 * 128; const float* w1 = A.nsa_w1 + (size_t)j_layer * 2 * 32 * 128 * 128; const float* w2 = A.nsa_w2 + (size_t)j_layer * 2 * 128 * 128;
    LAS float* blk = (LAS float*)lds; LAS float* part = blk + 4096; LAS float* hid = part + 512;
    for (int item = vcu; item < NB * NCMP * 4; item += G) {
        const int g = item & 1, c = (item >> 1) & 1, bj = item >> 2, j = bj % NCMP, b = bj / NCMP;
        __syncthreads();
        for (int idx = tid; idx < 4096; idx += NTHREADS) { const int l = idx >> 7, d = idx & 127; const int row = b * SEQ + 16 * j + l;
            blk[idx] = bf2f(P[(size_t)row * NSA_NP + PC_KVC + c * 256 + g * 128 + d]) + pe[(c * 32 + l) * 128 + d]; }
        __syncthreads();
        { const int h = tid & 127, pt = tid >> 7; float acc = 0.f;
          for (int l = pt * 8; l < pt * 8 + 8; ++l) { const float* wp = w1 + ((size_t)(c * 32 + l) * 128) * 128 + h; const LAS float* bp = blk + l * 128;
#pragma unroll 8
              for (int d = 0; d < 128; ++d) acc += bp[d] * wp[(size_t)d * 128]; }
          part[pt * 128 + h] = acc; }
        __syncthreads();
        if (tid < 128) { const float v = (part[tid] + part[128 + tid]) + (part[256 + tid] + part[384 + tid]);
            hid[tid] = 0.5f * v * (1.0f + tanhf_(0.7978845608028654f * (v + 0.044715f * v * v * v))); }
        __syncthreads();
        if (tid < 128) { float o = 0.f; const float* wp = w2 + (size_t)c * 128 * 128 + tid;
#pragma unroll 8
            for (int h = 0; h < 128; ++h) o += hid[h] * wp[(size_t)h * 128];
            bf16* dstp = (c == 0 ? KC : VC) + ((size_t)(b * 2 + g) * 128 + j) * 128 + tid; *dstp = (bf16)f2bf(o);
            if (j == NCMP - 1) dstp[128] = 0; }
    }
}

__device__ __forceinline__ void key_dots(const bf16* krow, const LAS float* q, float (&acc)[8]) {
#pragma unroll
    for (int r = 0; r < 8; ++r) acc[r] = 0.f;
#pragma unroll 4
    for (int c = 0; c < 16; ++c) { const v4u kv = *(const v4u*)(krow + 8 * c);
        const float k0 = bflo(kv.x), k1 = bfhi(kv.x), k2 = bflo(kv.y), k3 = bfhi(kv.y), k4 = bflo(kv.z), k5 = bfhi(kv.z), k6 = bflo(kv.w), k7 = bfhi(kv.w);
#pragma unroll
        for (int r = 0; r < 8; ++r) { const f32x4 qa = *(const LAS f32x4*)(q + r * 128 + 8 * c), qb = *(const LAS f32x4*)(q + r * 128 + 8 * c + 4);
            acc[r] += (k0 * qa.x + k1 * qa.y) + (k2 * qa.z + k3 * qa.w) + (k4 * qb.x + k5 * qb.y) + (k6 * qb.z + k7 * qb.w); } }
}
__device__ __forceinline__ void softmax512(LAS float* scr, int lane) {
    float v[8]; float m = -3.0e38f;
#pragma unroll
    for (int i = 0; i < 8; ++i) { v[i] = scr[lane + 64 * i]; m = fmaxf(m, v[i]); }
    m = wave_max(m); float s = 0.f;
#pragma unroll
    for (int i = 0; i < 8; ++i) { v[i] = __expf(v[i] - m); s += v[i]; }
    s = 1.0f / wave_sum(s);
#pragma unroll
    for (int i = 0; i < 8; ++i) scr[lane + 64 * i] = v[i] * s;
}
__device__ __forceinline__ void phase_nsa_attn(const Ptrs& A, int j_layer, LAS unsigned char* lds, int G, int vcu, int wave, int lane, int tid) {
    const bf16* P = (const bf16*)(A.ws + WS_P); const bf16* QR = (const bf16*)(A.ws + WS_QR); const float* KC = (const float*)(A.ws + WS_KC); const float* VC = (const float*)(A.ws + WS_VC);
    bf16* O = (bf16*)(A.ws + WS_O); const float* gb = A.nsa_gate_b + (size_t)j_layer * 48;
    LAS float* qs = (LAS float*)lds; LAS float* qrs = qs + 1024; LAS float* sc = qrs + 1024; LAS float* pc = sc + 4096; LAS float* imp = pc + 1024; LAS int* sel = (LAS int*)(imp + 32);
    for (int item = vcu; item < NB * 2 * SEQ; item += G) {
        const int b = item >> 12, g = (item >> 11) & 1, s = item & 2047, row = b * SEQ + s, r = wave;
        __syncthreads();
        for (int idx = tid; idx < 1024; idx += NTHREADS) { qs[idx] = bf2f(P[(size_t)row * NSA_NP + PC_Q + g * 1024 + idx]); qrs[idx] = bf2f(QR[(size_t)row * DM + g * 1024 + idx]); }
        __syncthreads();
        const int nvis = (s < 31) ? 0 : (((s - 31) >> 4) + 1 > NCMP ? NCMP : ((s - 31) >> 4) + 1);
        const float* kcb = KC + (size_t)(b * 2 + g) * 128 * 128; const float* vcb = VC + (size_t)(b * 2 + g) * 128 * 128;
        { float v[2];
#pragma unroll
          for (int jr = 0; jr < 2; ++jr) { const int j = lane + 64 * jr; float d = 0.f;
              if (j < nvis) { const float* kp = kcb + (size_t)j * 128;
#pragma unroll 8
                  for (int e = 0; e < 128; e += 4) { const f32x4 kk = *(const f32x4*)(kp + e); const f32x4 qq = *(const LAS f32x4*)(qs + r * 128 + e); d += (kk.x * qq.x + kk.y * qq.y) + (kk.z * qq.z + kk.w * qq.w); }
                  v[jr] = d * ATT_SCALE; } else v[jr] = -1e30f; }
          const float m = wave_max(fmaxf(v[0], v[1]));
          const float e0 = (lane < nvis) ? __expf(v[0] - m) : 0.f, e1 = (lane + 64 < nvis) ? __expf(v[1] - m) : 0.f;
          const float ssum = wave_sum(e0 + e1); const float inv = (nvis > 0) ? 1.0f / ssum : 0.f;
          pc[r * 128 + lane] = e0 * inv; pc[r * 128 + 64 + lane] = e1 * inv; }
        __syncthreads();
        float oc0 = 0.f, oc1 = 0.f;
        for (int j = 0; j < nvis; ++j) { const float p = pc[r * 128 + j]; const f32x2 vv = *(const f32x2*)(vcb + (size_t)j * 128 + 2 * lane); oc0 += p * vv.x; oc1 += p * vv.y; }
        if (tid < 32) { const int n = tid; float a = 0.f;
            for (int rr = 0; rr < 8; ++rr) { const LAS float* pp = pc + rr * 128 + 4 * n; a += pp[0] + pp[1] + pp[2] + 0.5f * pp[3] + ((n > 0) ? 0.5f * pp[-1] : 0.f); }
            imp[n] = a; }
        __syncthreads();
        const int qb = s >> 6;
        if (wave == 0) {
            if (qb < 8) { if (lane < 8) sel[lane] = lane; if (lane == 8) sel[8] = qb + 1; }
            else { float scv = (lane >= 1 && lane < qb) ? imp[lane & 31] : -3.0e38f;
                if (lane == 0) { sel[0] = 0; sel[1] = qb; sel[8] = 8; }
                for (int t = 0; t < 6; ++t) { const float best = wave_max(scv); const unsigned long long bal = __ballot(scv == best); const int idx = __ffsll((long long)bal) - 1;
                    if (lane == idx) { sel[2 + t] = idx; scv = -3.0e38f; } } }
        }
        __syncthreads();
        const int nsel = sel[8];
        { const int kb = tid >> 6; float acc[8]; bool valid = false;
          if (kb < nsel) { const int kpos = sel[kb] * 64 + (tid & 63); valid = (kpos <= s);
              if (valid) key_dots(P + (size_t)(b * SEQ + kpos) * NSA_NP + PC_KVS + g * 128, qrs, acc); }
#pragma unroll
          for (int rr = 0; rr < 8; ++rr) sc[rr * 512 + tid] = valid ? acc[rr] * ATT_SCALE : -1e30f; }
        __syncthreads();
        softmax512(sc + r * 512, lane);
        float os0 = 0.f, os1 = 0.f;
        for (int k = 0; k < nsel * 64; ++k) { const float p = sc[r * 512 + k]; const int kpos = sel[k >> 6] * 64 + (k & 63);
            const unsigned vv = *(const unsigned*)(P + (size_t)(b * SEQ + kpos) * NSA_NP + PC_KVS + 256 + g * 128 + 2 * lane); os0 += p * bflo(vv); os1 += p * bfhi(vv); }
        __syncthreads();
        const int nk = (s + 1 < 512) ? s + 1 : 512;
        { float acc[8]; const bool valid = tid < nk;
          if (valid) key_dots(P + (size_t)(row - tid) * NSA_NP + PC_KVW + g * 128, qrs, acc);
#pragma unroll
          for (int rr = 0; rr < 8; ++rr) sc[rr * 512 + tid] = valid ? acc[rr] * ATT_SCALE : -1e30f; }
        __syncthreads();
        softmax512(sc + r * 512, lane);
        float ow0 = 0.f, ow1 = 0.f;
        for (int k = 0; k < nk; ++k) { const float p = sc[r * 512 + k];
            const unsigned vv = *(const unsigned*)(P + (size_t)(row - k) * NSA_NP + PC_KVW + 256 + g * 128 + 2 * lane); ow0 += p * bflo(vv); ow1 += p * bfhi(vv); }
        const int h = g * 8 + r; const bf16* gp = P + (size_t)row * NSA_NP + PC_GATE + h;
        const float g0 = sigmoidf_(bf2f(gp[0]) + gb[h]), g1 = sigmoidf_(bf2f(gp[16]) + gb[16 + h]), g2 = sigmoidf_(bf2f(gp[32]) + gb[32 + h]);
        *(unsigned*)(O + (size_t)row * DM + h * 128 + 2 * lane) = pk2(g0 * oc0 + g1 * os0 + g2 * ow0, g0 * oc1 + g1 * os1 + g2 * ow1);
    }
}

__device__ __forceinline__ void phase_ml_rec(const Ptrs& A, LAS unsigned char* lds, int G, int vcu, int wave, int lane, int tid) {
    const bf16* P = (const bf16*)(A.ws + WS_P); const float* GT = (const float*)(A.ws + WS_GATES); float* HRAW = (float*)(A.ws + WS_HRAW); float* HSS = (float*)(A.ws + WS_HSS);
    LAS float* qf = (LAS float*)lds; LAS float* kf = qf + 64 * 129; LAS float* vf = kf + 64 * 129; LAS float* Cs = vf + 64 * 32; LAS float* Sq = Cs + 128 * 32;
    LAS float* Fs = Sq + 64 * 65; LAS float* lis = Fs + 64; LAS float* ws_ = lis + 64; LAS float* mts = ws_ + 64; LAS float* gis = mts + 64; LAS float* dns = gis + 64; LAS float* qns = dns + 64; LAS float* nv = qns + 64; LAS float* scal = nv + 128;
    for (int unit = vcu; unit < 256; unit += G) {
        const int b = unit >> 6, h = (unit >> 3) & 7, sl = unit & 7;
        float Creg[8];
#pragma unroll
        for (int v = 0; v < 8; ++v) Creg[v] = 0.f;
        float nreg = 0.f, mrun = 0.f;
        const int kC = tid >> 2, vg = tid & 3;
        __syncthreads();
        for (int idx = tid; idx < 128 * 32; idx += NTHREADS) Cs[idx] = 0.f;
        if (tid < 128) nv[tid] = 0.f;
        for (int c = 0; c < 32; ++c) {
            const int t0 = b * SEQ + c * 64;
            __syncthreads();
            for (int idx = tid; idx < 64 * 128; idx += NTHREADS) { const int l = idx >> 7, d = idx & 127; const bf16* pr = P + (size_t)(t0 + l) * ML_NP;
                qf[l * 129 + d] = bf2f(pr[MC_Q + h * 128 + d]) * ATT_SCALE; kf[l * 129 + d] = bf2f(pr[MC_K + h * 128 + d]); }
            for (int idx = tid; idx < 64 * 32; idx += NTHREADS) { const int l = idx >> 5, v = idx & 31; vf[idx] = bf2f(P[(size_t)(t0 + l) * ML_NP + MC_V + h * 256 + sl * 32 + v]); }
            if (wave == 0) {
                const float li = GT[(size_t)(t0 + lane) * 16 + h], lf = GT[(size_t)(t0 + lane) * 16 + 8 + h];
                float F = lf;
#pragma unroll
                for (int o = 1; o < 64; o <<= 1) { const float t = __shfl_up(F, o); if (lane >= o) F += t; }
                const float Fend = __shfl(F, 63);
                const float a = Fend - F + li; const float amax = wave_max(a);
                float dm = li - F;
#pragma unroll
                for (int o = 1; o < 64; o <<= 1) { const float t = __shfl_up(dm, o); if (lane >= o) dm = fmaxf(dm, t); }
                const float inter = F + mrun, mt = fmaxf(inter, F + dm);
                Fs[lane] = F; lis[lane] = li; ws_[lane] = __expf(a - amax); mts[lane] = mt; gis[lane] = __expf(inter - mt);
                if (lane == 0) { scal[0] = Fend; scal[1] = amax; }
            }
            __syncthreads();
            const float Fend = scal[0], amax = scal[1];
            { const int l = tid >> 3, s0 = (tid & 7) * 8; const float Fl = Fs[l], mtl = mts[l];
#pragma unroll
              for (int e = 0; e < 8; ++e) { const int s = s0 + e; float val = 0.f;
                  if (s <= l) { float d = 0.f;
#pragma unroll 8
                      for (int k = 0; k < 128; ++k) d += qf[l * 129 + k] * kf[s * 129 + k];
                      val = d * __expf(Fl - Fs[s] + lis[s] - mtl); }
                  Sq[l * 65 + s] = val; }
              if ((tid & 7) == 0) { float d = 0.f;
#pragma unroll 8
                  for (int k = 0; k < 128; ++k) d += qf[l * 129 + k] * nv[k];
                  qns[l] = d; } }
            __syncthreads();
            if (tid < 64) { float rs = 0.f;
#pragma unroll 8
                for (int s = 0; s < 64; ++s) rs += Sq[tid * 65 + s];
                const float den = rs + gis[tid] * qns[tid]; dns[tid] = fmaxf(fabsf(den), __expf(-mts[tid])); }
            f32x4 num = (f32x4){0.f, 0.f, 0.f, 0.f};
            { const int l = tid >> 3, v4 = (tid & 7) * 4; f32x4 inter4 = (f32x4){0.f, 0.f, 0.f, 0.f};
              for (int s = 0; s <= l; ++s) num += Sq[l * 65 + s] * *(const LAS f32x4*)(vf + s * 32 + v4);
#pragma unroll 8
              for (int k = 0; k < 128; ++k) inter4 += qf[l * 129 + k] * *(const LAS f32x4*)(Cs + k * 32 + v4);
              num += gis[l] * inter4; }
            __syncthreads();
            { const int l = tid >> 3, v4 = (tid & 7) * 4; const float inv = 1.0f / dns[l]; const f32x4 hv = num * inv;
              *(f32x4*)(HRAW + (size_t)(t0 + l) * DM + h * 256 + sl * 32 + v4) = hv;
              float ss = (hv.x * hv.x + hv.y * hv.y) + (hv.z * hv.z + hv.w * hv.w);
              ss += __shfl_xor(ss, 1); ss += __shfl_xor(ss, 2); ss += __shfl_xor(ss, 4);
              if ((tid & 7) == 0) HSS[((size_t)(t0 + l) * 8 + h) * 8 + sl] = ss; }
            const float mnew = fmaxf(Fend + mrun, amax), decay = __expf(Fend + mrun - mnew), inject = __expf(amax - mnew);
            { float dC[8];
#pragma unroll
              for (int v = 0; v < 8; ++v) dC[v] = 0.f;
              float dn = 0.f;
              for (int l = 0; l < 64; ++l) { const float wk = ws_[l] * kf[l * 129 + kC]; dn += wk; const f32x4 va = *(const LAS f32x4*)(vf + l * 32 + vg * 8), vb = *(const LAS f32x4*)(vf + l * 32 + vg * 8 + 4);
                  dC[0] += wk * va.x; dC[1] += wk * va.y; dC[2] += wk * va.z; dC[3] += wk * va.w; dC[4] += wk * vb.x; dC[5] += wk * vb.y; dC[6] += wk * vb.z; dC[7] += wk * vb.w; }
#pragma unroll
              for (int v = 0; v < 8; ++v) { Creg[v] = decay * Creg[v] + inject * dC[v]; Cs[kC * 32 + vg * 8 + v] = Creg[v]; }
              nreg = decay * nreg + inject * dn; if (vg == 0) nv[kC] = nreg; }
            mrun = mnew;
        }
    }
}

__device__ __forceinline__ void phase_ml_norm(const Ptrs& A, int j_layer, int G, int vcu, int tid) {
    const bf16* P = (const bf16*)(A.ws + WS_P); const bf16* HRAW = (const bf16*)(A.ws + WS_HRAW); bf16* O = (bf16*)(A.ws + WS_O);
    const float* hn = A.ml_head_norm + (size_t)j_layer * DM;
    const int t0 = vcu * NTHREADS + tid, c8 = t0 & 255, col = c8 * 8, rstep = (G * NTHREADS) >> 8;
    const f32x4 ga = *(const f32x4*)(hn + col), gb2 = *(const f32x4*)(hn + col + 4);
    for (int r0 = t0 >> 8; r0 < MROWS; r0 += 4 * rstep) {
        v4u hrv[4], ogv[4];
#pragma unroll
        for (int u = 0; u < 4; ++u) { const int row = r0 + u * rstep; const bool ok = row < MROWS; const int rr = ok ? row : r0;
            hrv[u] = *(const v4u*)(HRAW + (size_t)rr * DM + col); ogv[u] = *(const v4u*)(P + (size_t)rr * ML_NP + MC_OG + col); }
#pragma unroll
        for (int u = 0; u < 4; ++u) { const int row = r0 + u * rstep; const v4u hr = hrv[u], og = ogv[u];
            const f32x4 a = (f32x4){bflo(hr.x), bfhi(hr.x), bflo(hr.y), bfhi(hr.y)}, b2 = (f32x4){bflo(hr.z), bfhi(hr.z), bflo(hr.w), bfhi(hr.w)};
            float ss = ((a.x * a.x + a.y * a.y) + (a.z * a.z + a.w * a.w)) + ((b2.x * b2.x + b2.y * b2.y) + (b2.z * b2.z + b2.w * b2.w));
#pragma unroll
            for (int o = 1; o < 32; o <<= 1) ss += __shfl_xor(ss, o);
            const float rstd = 1.0f / sqrtf(ss * (1.0f / 256.0f) + 1e-6f);
            v4u o;
            o.x = pk2(a.x * rstd * ga.x * sigmoidf_(bflo(og.x)), a.y * rstd * ga.y * sigmoidf_(bfhi(og.x)));
            o.y = pk2(a.z * rstd * ga.z * sigmoidf_(bflo(og.y)), a.w * rstd * ga.w * sigmoidf_(bfhi(og.y)));
            o.z = pk2(b2.x * rstd * gb2.x * sigmoidf_(bflo(og.z)), b2.y * rstd * gb2.y * sigmoidf_(bfhi(og.z)));
            o.w = pk2(b2.z * rstd * gb2.z * sigmoidf_(bflo(og.w)), b2.w * rstd * gb2.w * sigmoidf_(bfhi(og.w)));
            if (row < MROWS) *(v4u*)(O + (size_t)row * DM + col) = o; }
    }
}

__device__ __forceinline__ void phase_fixup(const Ptrs& A, int layer, int G, int vcu, int tid) {
    const float* US = (const float*)(A.ws + WS_U); bf16* ACT = (bf16*)(A.ws + WS_ACT);
    const float* cw = A.conv_w + (size_t)layer * 3 * NUP; const float* cb = A.conv_b + (size_t)layer * NUP;
    for (int idx = vcu * NTHREADS + tid; idx < 128 * 2 * (DFF / 8); idx += G * NTHREADS) {
        const int c8 = idx % (DFF / 8), rr = (idx / (DFF / 8)) & 1, ch = idx / (2 * (DFF / 8)), cg = c8 * 8; const bool bs = (ch & 31) == 0;
        const int chp = bs ? ch : ch - 1;
        const float* u2p = US + ((size_t)ch * 4 + 2 + rr) * NUP + cg;
        const float* u1p = rr ? US + ((size_t)ch * 4 + 2) * NUP + cg : US + ((size_t)chp * 4 + 1) * NUP + cg; const bool z1 = (rr == 0) && bs;
        const float* u0p = rr ? US + ((size_t)chp * 4 + 1) * NUP + cg : US + ((size_t)chp * 4 + 0) * NUP + cg; const bool z0 = bs;
        f32x4 g2[2], v2[2], g1[2], v1[2], g0[2], v0[2], bg[2], bv[2], wg[3][2], wv[3][2];
#pragma unroll
        for (int q = 0; q < 2; ++q) { g2[q] = *(const f32x4*)(u2p + 4 * q); v2[q] = *(const f32x4*)(u2p + DFF + 4 * q); g1[q] = *(const f32x4*)(u1p + 4 * q); v1[q] = *(const f32x4*)(u1p + DFF + 4 * q);
            g0[q] = *(const f32x4*)(u0p + 4 * q); v0[q] = *(const f32x4*)(u0p + DFF + 4 * q); bg[q] = *(const f32x4*)(cb + cg + 4 * q); bv[q] = *(const f32x4*)(cb + DFF + cg + 4 * q);
#pragma unroll
            for (int t = 0; t < 3; ++t) { wg[t][q] = *(const f32x4*)(cw + (size_t)t * NUP + cg + 4 * q); wv[t][q] = *(const f32x4*)(cw + (size_t)t * NUP + DFF + cg + 4 * q); } }
        unsigned ow[4];
#pragma unroll
        for (int q = 0; q < 2; ++q) {
            const f32x4 zero = (f32x4){0.f, 0.f, 0.f, 0.f};
            const f32x4 a1 = z1 ? zero : g1[q], b1 = z1 ? zero : v1[q], a0 = z0 ? zero : g0[q], b0 = z0 ? zero : v0[q];
            const f32x4 cgv = bg[q] + wg[0][q] * a0 + wg[1][q] * a1 + wg[2][q] * g2[q];
            const f32x4 cvv = bv[q] + wv[0][q] * b0 + wv[1][q] * b1 + wv[2][q] * v2[q];
            ow[2 * q] = pk2(cgv.x * sigmoidf_(cgv.x) * cvv.x, cgv.y * sigmoidf_(cgv.y) * cvv.y); ow[2 * q + 1] = pk2(cgv.z * sigmoidf_(cgv.z) * cvv.z, cgv.w * sigmoidf_(cgv.w) * cvv.w); }
        *(v4u*)(ACT + (size_t)(ch * 64 + rr) * DFF + cg) = (v4u){ow[0], ow[1], ow[2], ow[3]};
    }
}

__device__ __forceinline__ void phase_final(const Ptrs& A, int G, int vcu, int wave, int lane) {
    const bf16* XB = (const bf16*)(A.ws + WS_XB); const float* SSP = (const float*)(A.ws + WS_SSP);
    const int gw = vcu * NWAVES + wave, NGW = G * NWAVES;
    const f32x4* gr = (const f32x4*)A.norm_final + 2 * lane; f32x4 gv[8];
#pragma unroll
    for (int j = 0; j < 4; ++j) { gv[2 * j] = gr[128 * j]; gv[2 * j + 1] = gr[128 * j + 1]; }
    for (int m0 = gw; m0 < MROWS; m0 += 2 * NGW) {
        float ssv[2]; v4u xv[2][4];
#pragma unroll
        for (int u = 0; u < 2; ++u) { const int m = (m0 + u * NGW < MROWS) ? m0 + u * NGW : m0; ssv[u] = (lane < 32) ? SSP[(size_t)lane * MROWS + m] : 0.f;
            const v4u* xr = (const v4u*)(XB + (size_t)m * DM) + lane;
#pragma unroll
            for (int j = 0; j < 4; ++j) xv[u][j] = xr[64 * j]; }
#pragma unroll
        for (int u = 0; u < 2; ++u) { const int m = m0 + u * NGW; const float rstd = 1.0f / sqrtf(wave_sum(ssv[u]) * (1.0f / 2048.0f) + 1e-6f);
            if (m < MROWS) { f32x4* o = (f32x4*)(A.out + (size_t)m * DM) + 2 * lane;
#pragma unroll
                for (int j = 0; j < 4; ++j) { const v4u x = xv[u][j];
                    o[128 * j] = (f32x4){bflo(x.x), bfhi(x.x), bflo(x.y), bfhi(x.y)} * rstd * gv[2 * j]; o[128 * j + 1] = (f32x4){bflo(x.z), bfhi(x.z), bflo(x.w), bfhi(x.w)} * rstd * gv[2 * j + 1]; } } }
    }
}
namespace na {
typedef short bf16x8 __attribute__((ext_vector_type(8)));
typedef short s16x4 __attribute__((ext_vector_type(4)));
typedef float f32x16 __attribute__((ext_vector_type(16)));
typedef unsigned u32x4 __attribute__((ext_vector_type(4)));
constexpr int KVBLK = 64, SHM_K = 16384, SHM_V = 16384;
constexpr float THR = 8.f, SCALE = 0.08838834764831845f;
#define KSWZ(row, colB) ((row) * 256 + ((colB) ^ (((row) & 7) << 4)))
#define SBAR() __builtin_amdgcn_sched_barrier(0)
__device__ __forceinline__ int v_st(int k, int c) { const int kk = (k & ~0xC) | ((k & 4) << 1) | ((k & 8) >> 1); return ((kk >> 3) * 4 + (c >> 5)) * 512 + ((kk & 7) * 32 + (c & 31)) * 2; }
__device__ __forceinline__ int v_rd_base(int lane) { return ((lane & 3) << 3) | (((lane >> 2) & 3) << 6) | (((lane >> 4) & 1) << 5) | (((lane >> 5) & 1) << 8); }
constexpr int v_rd_off(int d0, int ks, int half) { return d0 * 512 + ks * 4096 + half * 2048; }
__device__ __forceinline__ int crow(int r, int hi) { return (r & 3) + 8 * (r >> 2) + 4 * hi; }
__device__ __forceinline__ unsigned cvtpk(float lo, float hi) { unsigned r; asm volatile("v_cvt_pk_bf16_f32 %0, %1, %2" : "=v"(r) : "v"(lo), "v"(hi)); return r; }
__device__ __forceinline__ void mask_tile(f32x16& p0, f32x16& p1, int dq, unsigned W) {
    const float NEG = -__builtin_inff();
#pragma unroll
    for (int r = 0; r < 16; ++r) { const int c = (r & 3) + 8 * (r >> 2);
        if ((unsigned)(dq - c) >= W) p0[r] = NEG;
        if ((unsigned)(dq - c - 32) >= W) p1[r] = NEG; }
}
__device__ __forceinline__ void partialSM(f32x16& p0, f32x16& p1, float& m_reg, float& mn, float& alpha) {
    float pmax = p0[0];
#pragma unroll
    for (int r = 1; r < 16; ++r) pmax = fmaxf(pmax, p0[r]);
#pragma unroll
    for (int r = 0; r < 16; ++r) pmax = fmaxf(pmax, p1[r]);
    { auto rr = __builtin_amdgcn_permlane32_swap(__float_as_uint(pmax), __float_as_uint(pmax), false, false);
      pmax = fmaxf(__uint_as_float(rr[0]), __uint_as_float(rr[1])); }
    constexpr float C2 = 1.4426950408889634f * SCALE;
    if (__builtin_expect(__all((pmax - m_reg) * SCALE <= THR), 1)) { mn = m_reg; alpha = 1.f; }
    else { mn = fmaxf(m_reg, pmax); alpha = __builtin_amdgcn_exp2f((m_reg - mn) * C2); m_reg = mn; }
    const float mnL = -mn * C2;
#pragma unroll
    for (int r = 0; r < 16; ++r) p0[r] = fmaf(p0[r], C2, mnL);
#pragma unroll
    for (int r = 0; r < 16; ++r) p1[r] = fmaf(p1[r], C2, mnL);
#pragma unroll
    for (int r = 0; r < 16; ++r) p0[r] = __builtin_amdgcn_exp2f(p0[r]);
}
#define NA_PK4(P, B_, OUT) do { unsigned a0 = cvtpk(P[B_+0], P[B_+1]), a1 = cvtpk(P[B_+2], P[B_+3]);                          \
        unsigned b0 = cvtpk(P[B_+4], P[B_+5]), b1 = cvtpk(P[B_+6], P[B_+7]);                                             \
        auto r0 = __builtin_amdgcn_permlane32_swap(a0, b0, false, false); auto r1 = __builtin_amdgcn_permlane32_swap(a1, b1, false, false); \
        u32x4 w = {r0[0], r1[0], r0[1], r1[1]}; OUT = *reinterpret_cast<bf16x8*>(&w); } while (0)
__device__ __forceinline__ void pack_p(const f32x16& p0, const f32x16& p1, bf16x8& pa0, bf16x8& pa1, bf16x8& pa2, bf16x8& pa3) {
    NA_PK4(p0, 0, pa0); NA_PK4(p0, 8, pa1); NA_PK4(p1, 0, pa2); NA_PK4(p1, 8, pa3);
}
__device__ __forceinline__ void finishSM(f32x16& p0, f32x16& p1, float alpha, float& l_reg, bf16x8& pa0, bf16x8& pa1, bf16x8& pa2, bf16x8& pa3) {
#pragma unroll
    for (int r = 0; r < 16; ++r) p1[r] = __builtin_amdgcn_exp2f(p1[r]);
    float ps = 0;
#pragma unroll
    for (int r = 0; r < 16; ++r) ps += p0[r];
#pragma unroll
    for (int r = 0; r < 16; ++r) ps += p1[r];
    { auto rr = __builtin_amdgcn_permlane32_swap(__float_as_uint(ps), __float_as_uint(ps), false, false);
      ps = __uint_as_float(rr[0]) + __uint_as_float(rr[1]); }
    l_reg = l_reg * alpha + ps;
    pack_p(p0, p1, pa0, pa1, pa2, pa3);
}
template <int KOFF>
__device__ __forceinline__ void qkt(f32x16& p0, f32x16& p1, const LAS char* K_lds, int r32, int hi, const bf16x8* qr) {
    p0 = f32x16{}; p1 = f32x16{};
    const LAS char* kb[4];
#pragma unroll
    for (int dd = 0; dd < 4; ++dd) kb[dd] = K_lds + KOFF + KSWZ(r32, (dd * 16 + hi * 8) * 2);
#define NA_KLD(d0, t) (*reinterpret_cast<const LAS bf16x8*>(kb[(d0) & 3] + ((d0) >> 2) * 128 + (t) * 32 * 256))
    bf16x8 f[2][4];
    f[0][0] = NA_KLD(0, 0); f[0][1] = NA_KLD(0, 1); f[0][2] = NA_KLD(1, 0); f[0][3] = NA_KLD(1, 1);
#pragma unroll
    for (int g = 0; g < 4; ++g) { SBAR();
        if (g + 1 < 4) { f[(g + 1) & 1][0] = NA_KLD(2 * g + 2, 0); f[(g + 1) & 1][1] = NA_KLD(2 * g + 2, 1); f[(g + 1) & 1][2] = NA_KLD(2 * g + 3, 0); f[(g + 1) & 1][3] = NA_KLD(2 * g + 3, 1); }
        p0 = __builtin_amdgcn_mfma_f32_32x32x16_bf16(f[g & 1][0], qr[2 * g], p0, 0, 0, 0);
        p1 = __builtin_amdgcn_mfma_f32_32x32x16_bf16(f[g & 1][1], qr[2 * g], p1, 0, 0, 0);
        p0 = __builtin_amdgcn_mfma_f32_32x32x16_bf16(f[g & 1][2], qr[2 * g + 1], p0, 0, 0, 0);
        p1 = __builtin_amdgcn_mfma_f32_32x32x16_bf16(f[g & 1][3], qr[2 * g + 1], p1, 0, 0, 0); }
#undef NA_KLD
}
template <int VOFF>
__device__ __forceinline__ void pv_tile(f32x16* o, int vb0, bf16x8 pa0, bf16x8 pa1, bf16x8 pa2, bf16x8 pa3) {
#define NA_TRRD(dst, off) asm volatile("ds_read_b64_tr_b16 %0, %1 offset:%2" : "=&v"(dst) : "v"(vb0), "i"(off) : "memory")
#define NA_PV_D0(d0) do { s16x4 l0, l1, l2, l3, h0, h1, h2, h3; constexpr int b_ = VOFF + v_rd_off(d0, 0, 0); \
        NA_TRRD(l0, b_); NA_TRRD(h0, b_ + 2048); NA_TRRD(l1, b_ + 4096); NA_TRRD(h1, b_ + 6144); NA_TRRD(l2, b_ + 8192); NA_TRRD(h2, b_ + 10240); NA_TRRD(l3, b_ + 12288); NA_TRRD(h3, b_ + 14336); \
        asm volatile("s_waitcnt lgkmcnt(0)" ::: "memory"); SBAR();   \
        o[d0] = __builtin_amdgcn_mfma_f32_32x32x16_bf16(pa0, (bf16x8){l0[0], l0[1], l0[2], l0[3], h0[0], h0[1], h0[2], h0[3]}, o[d0], 0, 0, 0);   \
        o[d0] = __builtin_amdgcn_mfma_f32_32x32x16_bf16(pa1, (bf16x8){l1[0], l1[1], l1[2], l1[3], h1[0], h1[1], h1[2], h1[3]}, o[d0], 0, 0, 0);   \
        o[d0] = __builtin_amdgcn_mfma_f32_32x32x16_bf16(pa2, (bf16x8){l2[0], l2[1], l2[2], l2[3], h2[0], h2[1], h2[2], h2[3]}, o[d0], 0, 0, 0);   \
        o[d0] = __builtin_amdgcn_mfma_f32_32x32x16_bf16(pa3, (bf16x8){l3[0], l3[1], l3[2], l3[3], h3[0], h3[1], h3[2], h3[3]}, o[d0], 0, 0, 0); } while (0)
    NA_PV_D0(0); NA_PV_D0(1); NA_PV_D0(2); NA_PV_D0(3);
#undef NA_PV_D0
#undef NA_TRRD
}
constexpr int VOFF0 = 0, VOFF1 = 16384, VOFF2 = 32768, KOFF0 = 49152, KOFF1 = 65536, KOFF2 = 81920, IMPW_OFF = 98304, IMPW_P = 33  , WSC_OFF = IMPW_OFF + 8 * 32 * IMPW_P * 4, SELB_OFF = WSC_OFF + 2048;
struct Ctx {
    LAS char* lds; LAS float* li_l; LAS float* al_l; int vb0, r32, hi, wave;
    int krow[2], kcolb[2], vkey[2], vcol[2];
};
__device__ __forceinline__ void dma_coords(Ctx& C, int lane) {
#pragma unroll
    for (int i = 0; i < 2; ++i) { const int L = (C.wave * 2 + i) * 1024 + lane * 16;
        const int row = L >> 8; C.krow[i] = row; C.kcolb[i] = (L & 255) ^ ((row & 7) << 4);
        const int st = L >> 9, within = L & 511, kk = (st >> 2) * 8 + (within >> 6); C.vkey[i] = (kk & ~0xC) | ((kk & 4) << 1) | ((kk & 8) >> 1); C.vcol[i] = (st & 3) * 32 + ((within & 63) >> 1); }
}
#define NA_VMWAIT(n) asm volatile("s_waitcnt vmcnt(" #n ")" ::: "memory")
#define NA_BAR() do { asm volatile("s_waitcnt lgkmcnt(0)" ::: "memory"); __builtin_amdgcn_s_barrier(); asm volatile("" ::: "memory"); } while (0)
#define NA_DMA(Kp, Vp, ld, k0, koff, voff) do { const bf16* kp_ = (Kp) + (size_t)(k0) * (ld); const bf16* vp_ = (Vp) + (size_t)(k0) * (ld); _Pragma("unroll") for (int i_ = 0; i_ < 2; ++i_) { \
        unsigned ok_ = (unsigned)(C.krow[i_] * (ld) + (C.kcolb[i_] >> 1)), ov_ = (unsigned)(C.vkey[i_] * (ld) + C.vcol[i_]); asm volatile("" : "+v"(ok_), "+v"(ov_));     \
        __builtin_amdgcn_global_load_lds((const unsigned*)(kp_ + ok_), (LAS unsigned*)(C.lds + (koff) + (C.wave * 2 + i_) * 1024), 16, 0, 0); \
        __builtin_amdgcn_global_load_lds((const unsigned*)(vp_ + ov_), (LAS unsigned*)(C.lds + (voff) + (C.wave * 2 + i_) * 1024), 16, 0, 0); } } while (0)
#define NA_RESC(a) do { if (__any((a) < 1.f)) { if (C.hi == 0) C.al_l[C.r32] = (a); asm volatile("s_waitcnt lgkmcnt(0)" ::: "memory");              \
                     _Pragma("unroll") for (int d_ = 0; d_ < 4; ++d_) _Pragma("unroll") for (int r = 0; r < 16; ++r) o[d_][r] *= C.al_l[crow(r, C.hi)]; } } while (0)
template <int MODE, bool PRE = false>
__device__ __forceinline__ void tile_loop(f32x16 (&o)[4], float& l_reg, const bf16x8 (&qr)[8], const bf16* Kg, const bf16* Vg, int ld, int NT, int j_lo, const LAS int* TL, unsigned myb, int qb, int pos, int t0, const Ctx& C) {
    float m_reg = -1e30f; l_reg = 0.f;
#pragma unroll
    for (int d = 0; d < 4; ++d) o[d] = f32x16{};
#define NA_KBASE(t) ((MODE == 0 ? TL[t] : (j_lo + (t))) * KVBLK)
    if (!PRE) {
    NA_VMWAIT(0);
    { const int kb = NA_KBASE(0); NA_DMA(Kg, Vg, ld, kb, KOFF0, VOFF0); }
    if (NT > 1) { const int kb = NA_KBASE(1); NA_DMA(Kg, Vg, ld, kb, KOFF1, VOFF1); } }
#define NA_STEP(t, KO, VO, KO2, VO2) do { const int kb = NA_KBASE(t);                                                                              \
        if ((t) + 1 < NT) NA_VMWAIT(4); else NA_VMWAIT(0);                       \
        NA_BAR();                                                              \
        if ((t) + 2 < NT) { const int kn = NA_KBASE((t) + 2); NA_DMA(Kg, Vg, ld, kn, KO2, VO2); }                                                  \
        f32x16 p0, p1; float mn, alpha; bf16x8 pa0, pa1, pa2, pa3;                                                                                 \
        SBAR(); qkt<KO>(p0, p1, C.lds, C.r32, C.hi, qr);                                                                                           \
        if (MODE == 0) { const int n = kb >> 6; const bool ok = (myb >> n) & 1u;                                                                   \
            if (n == qb) mask_tile(p0, p1, pos - kb - 4 * C.hi, 0x7fffffffu);                                                                      \
            if (!__all(ok)) { const float NEG = -__builtin_inff(); _Pragma("unroll") for (int r = 0; r < 16; ++r) { p0[r] = ok ? p0[r] : NEG; p1[r] = ok ? p1[r] : NEG; } } } \
        else { if (kb + KVBLK - 1 > t0 || kb <= t0 + 31 - 512) mask_tile(p0, p1, pos - kb - 4 * C.hi, 512u); }                                     \
        partialSM(p0, p1, m_reg, mn, alpha); NA_RESC(alpha); finishSM(p0, p1, alpha, l_reg, pa0, pa1, pa2, pa3); SBAR();                           \
        pv_tile<VO>(o, C.vb0, pa0, pa1, pa2, pa3); } while (0)
    for (int t = 0; t < NT; t += 3) { NA_STEP(t, KOFF0, VOFF0, KOFF2, VOFF2); if (t + 1 < NT) NA_STEP(t + 1, KOFF1, VOFF1, KOFF0, VOFF0); if (t + 2 < NT) NA_STEP(t + 2, KOFF2, VOFF2, KOFF1, VOFF1); }
    NA_BAR();
#undef NA_STEP
#undef NA_KBASE
}
}

__device__ __forceinline__ void phase_nsa_attn2(const Ptrs& A, int j_layer, LAS unsigned char* lds, int G, int vcu, int wave, int lane, int tid) {
    using namespace na;
    const bf16* P = (const bf16*)(A.ws + WS_P); const float* ROPE = (const float*)(A.ws + WS_ROPE); const bf16* KCb = (const bf16*)(A.ws + WS_KC); const bf16* VCb = (const bf16*)(A.ws + WS_VC);
    bf16* O = (bf16*)(A.ws + WS_O); const float* gb = A.nsa_gate_b + (size_t)j_layer * 48;
    Ctx C; C.lds = (LAS char*)lds; C.li_l = (LAS float*)(lds + WSC_OFF) + wave * 64; C.al_l = C.li_l + 32; C.wave = wave;
    LAS float* IMPW = (LAS float*)(lds + IMPW_OFF);
    LAS unsigned* SELB = (LAS unsigned*)(lds + SELB_OFF);
    LAS int* TL = (LAS int*)(SELB + 32);
    C.r32 = lane & 31; C.hi = lane >> 5; dma_coords(C, lane);
    C.vb0 = (int)(unsigned long long)C.lds + v_rd_base(lane);
    const int r32 = C.r32, hi = C.hi;
    constexpr float C2 = 1.4426950408889634f * SCALE;
    if (wave >= 4) __builtin_amdgcn_s_setprio(1);
    for (int u = vcu; u < 512; u += G) {
        const int w8 = u & 255, rnd = u >> 8, tbase = w8 & 63, tb = rnd ? 63 - tbase : tbase, bg = (w8 >> 6) + 4 * rnd, b = bg >> 1, g = bg & 1;
        const int t0 = tb * 32, qb = t0 >> 6, row0 = b * SEQ + t0, h = g * 8 + wave, pos = t0 + r32;
        const bf16* Prow = P + (size_t)(row0 + r32) * NSA_NP;
        f32x16 o[4]; unsigned otot[4][8];
        bf16x8 qr[8];
        NA_BAR();
#pragma unroll
        for (int d0 = 0; d0 < 8; ++d0) qr[d0] = *(const bf16x8*)(Prow + PC_Q + h * 128 + d0 * 16 + hi * 8);
        const float gz0 = bf2f(Prow[PC_GATE + h]) + gb[h], gz1 = bf2f(Prow[PC_GATE + 16 + h]) + gb[16 + h], gz2 = bf2f(Prow[PC_GATE + 32 + h]) + gb[32 + h];
        f32x4 ropev[4];
        { const float* cs = ROPE + (size_t)(row0 + r32) * 32 + hi * 16;
#pragma unroll
          for (int q2 = 0; q2 < 4; ++q2) ropev[q2] = *(const f32x4*)(cs + 4 * q2); }
        { const bf16* Kc = KCb + (size_t)(b * 2 + g) * 128 * 128; const bf16* Vc = VCb + (size_t)(b * 2 + g) * 128 * 128;
          NA_DMA(Kc, Vc, 128, 0, KOFF0, VOFF0); NA_DMA(Kc, Vc, 128, 64, KOFF1, VOFF1); }
        NA_VMWAIT(0); __syncthreads();
        {
            f32x16 pA0, pA1, pB0, pB1;
            qkt<KOFF0>(pA0, pA1, C.lds, r32, hi, qr); qkt<KOFF1>(pB0, pB1, C.lds, r32, hi, qr);
            const int lim = (pos - 31) >> 4;
            mask_tile(pA0, pA1, lim - 4 * hi, 0x7fffffffu); mask_tile(pB0, pB1, lim - 64 - 4 * hi, 0x7fffffffu);
            float mx = -1e30f;
#pragma unroll
            for (int r = 0; r < 16; ++r) mx = fmaxf(fmaxf(mx, fmaxf(pA0[r], pA1[r])), fmaxf(pB0[r], pB1[r]));
            { auto rr = __builtin_amdgcn_permlane32_swap(__float_as_uint(mx), __float_as_uint(mx), false, false); mx = fmaxf(__uint_as_float(rr[0]), __uint_as_float(rr[1])); }
            float ls = 0.f;
#pragma unroll
            for (int r = 0; r < 16; ++r) { pA0[r] = __builtin_amdgcn_exp2f((pA0[r] - mx) * C2); pA1[r] = __builtin_amdgcn_exp2f((pA1[r] - mx) * C2);
                pB0[r] = __builtin_amdgcn_exp2f((pB0[r] - mx) * C2); pB1[r] = __builtin_amdgcn_exp2f((pB1[r] - mx) * C2); ls += (pA0[r] + pA1[r]) + (pB0[r] + pB1[r]); }
            { auto rr = __builtin_amdgcn_permlane32_swap(__float_as_uint(ls), __float_as_uint(ls), false, false); ls = __uint_as_float(rr[0]) + __uint_as_float(rr[1]); }
            const float inv = (ls > 0.f) ? 1.0f / ls : 0.f;
            float recv[4][4], own[4][4];
#pragma unroll
            for (int ti = 0; ti < 4; ++ti)
#pragma unroll
                for (int gq = 0; gq < 4; ++gq) { const f32x16& pt = (ti == 0) ? pA0 : (ti == 1) ? pA1 : (ti == 2) ? pB0 : pB1;
                    const float hh = 0.5f * pt[4 * gq + 3] * inv; own[ti][gq] = (pt[4 * gq] + pt[4 * gq + 1] + pt[4 * gq + 2]) * inv + hh; recv[ti][gq] = __shfl_xor(hh, 32); }
#pragma unroll
            for (int ti = 0; ti < 4; ++ti)
#pragma unroll
                for (int gq = 0; gq < 4; ++gq) { const float pl = (gq > 0) ? recv[ti][gq > 0 ? gq - 1 : 0] : ((ti > 0) ? recv[ti > 0 ? ti - 1 : 0][3] : 0.f);
                    const float prev = hi ? recv[ti][gq] : pl;
                    IMPW[(wave * 32 + r32) * IMPW_P + 8 * ti + 2 * gq + hi] = own[ti][gq] + prev; }
            bf16x8 pa0, pa1, pa2, pa3;
#pragma unroll
            for (int d = 0; d < 4; ++d) o[d] = f32x16{};
            pack_p(pA0, pA1, pa0, pa1, pa2, pa3); SBAR(); pv_tile<VOFF0>(o, C.vb0, pa0, pa1, pa2, pa3);
            pack_p(pB0, pB1, pa0, pa1, pa2, pa3); SBAR(); pv_tile<VOFF1>(o, C.vb0, pa0, pa1, pa2, pa3);
            if (hi == 0) C.li_l[r32] = sigmoidf_(gz0) * inv;
            asm volatile("s_waitcnt lgkmcnt(0)" ::: "memory");
#pragma unroll
            for (int q2 = 0; q2 < 8; ++q2) { const float w0 = C.li_l[crow(2 * q2, hi)], w1 = C.li_l[crow(2 * q2 + 1, hi)];
#pragma unroll
                for (int d = 0; d < 4; ++d) otot[d][q2] = cvtpk(o[d][2 * q2] * w0, o[d][2 * q2 + 1] * w1); }
        }
        __syncthreads();
        const int w_lowk = t0 - 511, w_jlo = w_lowk > 0 ? w_lowk / KVBLK : 0, w_NT = qb + 1 - w_jlo;
        const bf16* KgW = P + (size_t)b * SEQ * NSA_NP + PC_KVW + g * 128;
        { NA_VMWAIT(0); NA_DMA(KgW, KgW + 256, NSA_NP, w_jlo * KVBLK, KOFF0, VOFF0); if (w_NT > 1) NA_DMA(KgW, KgW + 256, NSA_NP, (w_jlo + 1) * KVBLK, KOFF1, VOFF1); }
        if (wave == 0) {
            float imp[32];
#pragma unroll
            for (int n = 0; n < 32; ++n) { float s = 0.f;
#pragma unroll
                for (int w = 0; w < 8; ++w) s += IMPW[(w * 32 + r32) * IMPW_P + n];
                imp[n] = s; }
            unsigned selbits;
            if (qb < 8) selbits = (2u << qb) - 1u;
            else { selbits = 1u | (1u << qb);
                for (int t = 0; t < 6; ++t) { float best = -3.0e38f; int bi = 0;
#pragma unroll
                    for (int n = 1; n < 32; ++n) { const bool c = (n < qb) && !((selbits >> n) & 1u) && (imp[n] > best); best = c ? imp[n] : best; bi = c ? n : bi; }
                    selbits |= 1u << bi; } }
            if (hi == 0) SELB[r32] = selbits;
            unsigned un = selbits;
#pragma unroll
            for (int o_ = 1; o_ < 32; o_ <<= 1) un |= (unsigned)__shfl_xor((int)un, o_);
            if (lane == 0) { int cnt = 0; for (int n = 0; n < 32; ++n) if ((un >> n) & 1u) { TL[cnt] = n; ++cnt; } TL[32] = cnt; }
        }
        __syncthreads();
        { u32x4 w0, w1; unsigned a0[4], a1[4];
#pragma unroll
          for (int q2 = 0; q2 < 4; ++q2) { const f32x4 t = ropev[q2];
              const float x1a = bf2f((unsigned short)qr[0][2 * q2]), x1b = bf2f((unsigned short)qr[0][2 * q2 + 1]), x2a = bf2f((unsigned short)qr[1][2 * q2]), x2b = bf2f((unsigned short)qr[1][2 * q2 + 1]);
              a0[q2] = pk2(x1a * t[0] - x2a * t[1], x1b * t[2] - x2b * t[3]); a1[q2] = pk2(x2a * t[0] + x1a * t[1], x2b * t[2] + x1b * t[3]); }
          w0 = (u32x4){a0[0], a0[1], a0[2], a0[3]}; w1 = (u32x4){a1[0], a1[1], a1[2], a1[3]};
          qr[0] = __builtin_bit_cast(bf16x8, w0); qr[1] = __builtin_bit_cast(bf16x8, w1); }
        float l_reg;
        { tile_loop<1, true>(o, l_reg, qr, KgW, KgW + 256, NSA_NP, w_NT, w_jlo, TL, 0u, qb, pos, t0, C);
          if (hi == 0) C.li_l[r32] = sigmoidf_(gz2) / l_reg;
          asm volatile("s_waitcnt lgkmcnt(0)" ::: "memory");
#pragma unroll
          for (int q2 = 0; q2 < 8; ++q2) { const float w0 = C.li_l[crow(2 * q2, hi)], w1 = C.li_l[crow(2 * q2 + 1, hi)];
#pragma unroll
              for (int d = 0; d < 4; ++d) otot[d][q2] = cvtpk(bflo(otot[d][q2]) + o[d][2 * q2] * w0, bfhi(otot[d][q2]) + o[d][2 * q2 + 1] * w1); } }
        { const unsigned myb = SELB[r32]; const int NT = TL[32];
          const bf16* Kg = P + (size_t)b * SEQ * NSA_NP + PC_KVS + g * 128;
          tile_loop<0>(o, l_reg, qr, Kg, Kg + 256, NSA_NP, NT, 0, TL, myb, qb, pos, t0, C);
          if (hi == 0) C.li_l[r32] = sigmoidf_(gz1) / l_reg;
          asm volatile("s_waitcnt lgkmcnt(0)" ::: "memory");
#pragma unroll
          for (int q2 = 0; q2 < 8; ++q2) { const float w0 = C.li_l[crow(2 * q2, hi)], w1 = C.li_l[crow(2 * q2 + 1, hi)];
#pragma unroll
              for (int d = 0; d < 4; ++d) otot[d][q2] = cvtpk(bflo(otot[d][q2]) + o[d][2 * q2] * w0, bfhi(otot[d][q2]) + o[d][2 * q2 + 1] * w1); } }
#pragma unroll
        for (int q2 = 0; q2 < 8; ++q2) { bf16* orow = O + (size_t)(row0 + crow(2 * q2, hi)) * DM + h * 128;
#pragma unroll
            for (int d = 0; d < 4; ++d) { const unsigned mine = otot[d][q2]; const unsigned nb = (unsigned)__shfl_xor((int)mine, 1);
                if ((r32 & 1) == 0) { *(unsigned*)(orow + d * 32 + r32) = (mine & 0xffffu) | (nb << 16); *(unsigned*)(orow + DM + d * 32 + r32) = (mine >> 16) | (nb & 0xffff0000u); } } }
    }
    __builtin_amdgcn_s_setprio(0);
}
namespace ml4 {
using na::bf16x8; using na::s16x4; using na::f32x16; using na::u32x4;
constexpr int NGRP = 8, GCH = 4;
constexpr int BUF = 49152, T_KT = 0, T_V0 = 16384, T_V1 = 32768;
constexpr int B2_K = 2 * BUF, B2_Q = 2 * BUF + 16384;
constexpr int OFF_WS = 3 * BUF, OFF_AQ = OFF_WS + 8192, OFF_BQ = OFF_AQ + 1024, OFF_GI = OFF_BQ + 1024, OFF_EM = OFF_GI + 1024, OFF_DEC = OFF_EM + 1024, OFF_INV = OFF_DEC + 128, OFF_QN = OFF_INV + 2048,
              OFF_END = OFF_QN + 1024;
constexpr int TMP_F = 0, TMP_B = 8192, TMP_DMX = 16384, TMP_W = 24576, TMP_CH = 32768;
static_assert(OFF_END <= MISC_OFF, "mlstm4 LDS map");
#define M4_TRRD(dst, addr, off) asm volatile("ds_read_b64_tr_b16 %0, %1 offset:%2" : "=&v"(dst) : "v"(addr), "i"(off) : "memory")
#define M4_LDSWAIT() do { asm volatile("s_waitcnt lgkmcnt(0)" ::: "memory"); __builtin_amdgcn_sched_barrier(0); } while (0)
#define M4_FRAG(l_, h_) ((bf16x8){l_[0], l_[1], l_[2], l_[3], h_[0], h_[1], h_[2], h_[3]})
__device__ __forceinline__ void state_step(f32x16 (&cst)[4], f32x16& ntile, int vbK, int vbV, const LAS float* wsp, float dec, int wave, int r32) {
#pragma unroll
    for (int kt = 0; kt < 4; ++kt)
#pragma unroll
        for (int r = 0; r < 16; ++r) cst[kt][r] *= dec;
    if (wave < 4) {
#pragma unroll
        for (int r = 0; r < 16; ++r) ntile[r] *= dec; }
#pragma unroll
    for (int ks = 0; ks < 4; ++ks) {
        s16x4 vl, vh, kl0, kh0, kl1, kh1, kl2, kh2, kl3, kh3;
        M4_TRRD(vl, vbV, ks * 4096); M4_TRRD(vh, vbV, ks * 4096 + 2048);
        M4_TRRD(kl0, vbK, ks * 4096); M4_TRRD(kh0, vbK, ks * 4096 + 2048); M4_TRRD(kl1, vbK, 512 + ks * 4096); M4_TRRD(kh1, vbK, 512 + ks * 4096 + 2048);
        M4_TRRD(kl2, vbK, 1024 + ks * 4096); M4_TRRD(kh2, vbK, 1024 + ks * 4096 + 2048); M4_TRRD(kl3, vbK, 1536 + ks * 4096); M4_TRRD(kh3, vbK, 1536 + ks * 4096 + 2048);
        const f32x4 w0 = *(const LAS f32x4*)(wsp + 16 * ks), w1 = *(const LAS f32x4*)(wsp + 16 * ks + 4);
        M4_LDSWAIT();
        u32x4 sv;
        sv.x = na::cvtpk(bf2f((unsigned short)vl[0]) * w0.x, bf2f((unsigned short)vl[1]) * w0.y); sv.y = na::cvtpk(bf2f((unsigned short)vl[2]) * w0.z, bf2f((unsigned short)vl[3]) * w0.w);
        sv.z = na::cvtpk(bf2f((unsigned short)vh[0]) * w1.x, bf2f((unsigned short)vh[1]) * w1.y); sv.w = na::cvtpk(bf2f((unsigned short)vh[2]) * w1.z, bf2f((unsigned short)vh[3]) * w1.w);
        const bf16x8 vs = __builtin_bit_cast(bf16x8, sv);
        const bf16x8 ka0 = M4_FRAG(kl0, kh0), ka1 = M4_FRAG(kl1, kh1), ka2 = M4_FRAG(kl2, kh2), ka3 = M4_FRAG(kl3, kh3);
        cst[0] = __builtin_amdgcn_mfma_f32_32x32x16_bf16(ka0, vs, cst[0], 0, 0, 0);
        cst[1] = __builtin_amdgcn_mfma_f32_32x32x16_bf16(ka1, vs, cst[1], 0, 0, 0);
        cst[2] = __builtin_amdgcn_mfma_f32_32x32x16_bf16(ka2, vs, cst[2], 0, 0, 0);
        cst[3] = __builtin_amdgcn_mfma_f32_32x32x16_bf16(ka3, vs, cst[3], 0, 0, 0);
        if (wave < 4) {
            u32x4 nw; nw.x = na::cvtpk(w0.x, w0.y); nw.y = na::cvtpk(w0.z, w0.w); nw.z = na::cvtpk(w1.x, w1.y); nw.w = na::cvtpk(w1.z, w1.w);
            if (r32 != 0) nw = (u32x4){0u, 0u, 0u, 0u};
            const bf16x8 nb = __builtin_bit_cast(bf16x8, nw);
            if (wave == 0) ntile = __builtin_amdgcn_mfma_f32_32x32x16_bf16(ka0, nb, ntile, 0, 0, 0);
            else if (wave == 1) ntile = __builtin_amdgcn_mfma_f32_32x32x16_bf16(ka1, nb, ntile, 0, 0, 0);
            else if (wave == 2) ntile = __builtin_amdgcn_mfma_f32_32x32x16_bf16(ka2, nb, ntile, 0, 0, 0);
            else ntile = __builtin_amdgcn_mfma_f32_32x32x16_bf16(ka3, nb, ntile, 0, 0, 0);
        }
    }
}
}

__device__ __forceinline__ void phase_ml_rec4(const int PROBE, const Ptrs& A, int jl, LAS unsigned char* lds, int G, int vcu, int wave, int lane_in, int tid_in) {
    using namespace na; using namespace ml4;
    const bf16* P = (const bf16*)(A.ws + WS_P); const float* GT = (const float*)(A.ws + WS_GATES); bf16* HRAW = (bf16*)(A.ws + WS_HRAW);
    LAS float* t_f = (LAS float*)(lds + TMP_F); LAS float* t_b = (LAS float*)(lds + TMP_B); LAS float* t_dmx = (LAS float*)(lds + TMP_DMX); LAS float* t_w = (LAS float*)(lds + TMP_W);
    LAS float* c_fe = (LAS float*)(lds + TMP_CH); LAS float* c_am = c_fe + 32; LAS float* c_m0 = c_am + 32; LAS float* c_inj = c_m0 + 32;
    LAS float* f_ws = (LAS float*)(lds + OFF_WS); LAS float* f_aq = (LAS float*)(lds + OFF_AQ); LAS float* f_bq = (LAS float*)(lds + OFF_BQ); LAS float* f_gi = (LAS float*)(lds + OFF_GI);
    LAS float* f_em = (LAS float*)(lds + OFF_EM); LAS float* f_dec = (LAS float*)(lds + OFF_DEC); LAS float* s_inv = (LAS float*)(lds + OFF_INV) + wave * 64; LAS float* s_qn = (LAS float*)(lds + OFF_QN);
    LAS char* const ldsc = (LAS char*)lds;
#define M4_LANEVARS() int ln_ = lane_in; asm volatile("" : "+v"(ln_)); const int r32 = ln_ & 31, hi = ln_ >> 5; const int vb0 = (int)(unsigned long long)ldsc + v_rd_base(ln_); (void)r32; (void)hi; (void)vb0; \
        Ctx Cc; Cc.wave = wave; dma_coords(Cc, ln_); const unsigned vo0 = (unsigned)(Cc.vkey[0] * ML_NP + Cc.vcol[0]), vo1 = (unsigned)(Cc.vkey[1] * ML_NP + Cc.vcol[1]), \
        ko0 = (unsigned)(Cc.krow[0] * ML_NP + (Cc.kcolb[0] >> 1)), ko1 = (unsigned)(Cc.krow[1] * ML_NP + (Cc.kcolb[1] >> 1)); (void)vo0; (void)vo1; (void)ko0; (void)ko1
    if (wave >= 4) __builtin_amdgcn_s_setprio(1);
    for (int unit = vcu; unit < 32 * NGRP; unit += G) {
        const int bh = unit / NGRP, g = unit % NGRP, b = bh >> 3, h = bh & 7, c0 = g * GCH;
        int lane = lane_in, tid = tid_in; asm volatile("" : "+v"(lane), "+v"(tid));
        __syncthreads();
        const bf16* Pb = P + (size_t)(b * SEQ) * ML_NP; const bf16* Kg = Pb + MC_K + h * 128; const bf16* Qg = Pb + MC_Q + h * 128; const bf16* Vg = Pb + MC_V + h * 256;
#define M4_DMA2(src, row0, ldsoff, o0_, o1_) do { const bf16* s_ = (src) + (size_t)(row0) * ML_NP; LAS char* d_ = ldsc + (ldsoff) + wave * 2048; unsigned o0 = (o0_), o1 = (o1_); asm volatile("" : "+v"(o0), "+v"(o1));     \
            __builtin_amdgcn_global_load_lds((const unsigned*)(s_ + o0), (LAS unsigned*)d_, 16, 0, 0); __builtin_amdgcn_global_load_lds((const unsigned*)(s_ + o1), (LAS unsigned*)(d_ + 1024), 16, 0, 0); } while (0)
#define M4_DMA_VL(src, row0, ldsoff) M4_DMA2(src, row0, ldsoff, vo0, vo1)
#define M4_DMA_KS(src, row0, ldsoff) M4_DMA2(src, row0, ldsoff, ko0, ko1)
#define M4_DMA_STATE(c_, bo_) do { M4_DMA_VL(Kg, (c_) * 64, (bo_) + T_KT); M4_DMA_VL(Vg, (c_) * 64, (bo_) + T_V0); M4_DMA_VL(Vg + 128, (c_) * 64, (bo_) + T_V1); } while (0)
#define M4_DMA_QK(c_) do { M4_DMA_KS(Kg, (c_) * 64, B2_K); M4_DMA_KS(Qg, (c_) * 64, B2_Q); } while (0)
#ifndef M4_XCH
#define M4_XCH 1
#endif
        const bool xch = M4_XCH && (G >= 32 * NGRP);
        const int cs = xch ? c0 : 0, ns = xch ? ((g + 1 < NGRP) ? GCH : 0) : c0;
        const bool early_full = xch && ns == 0;
        NA_VMWAIT(0);
        { M4_LANEVARS();
          if (ns > 0) { M4_DMA_STATE(cs, BUF); if (ns > 1) M4_DMA_STATE(cs + 1, 2 * BUF); }
          else if (early_full) { M4_DMA_STATE(c0, BUF); M4_DMA_QK(c0); } }
        { float li[4], F[4], dm[4], Fend[4], amax[4];
#pragma unroll
          for (int cc = 0; cc < 4; ++cc) { const size_t grow = (size_t)(b * SEQ + (wave * 4 + cc) * 64 + lane) * 16; li[cc] = GT[grow + h]; F[cc] = GT[grow + 8 + h]; }
#pragma unroll
          for (int o = 1; o < 64; o <<= 1) {
#pragma unroll
              for (int cc = 0; cc < 4; ++cc) { const float t = __shfl_up(F[cc], o); if (lane >= o) F[cc] += t; } }
#pragma unroll
          for (int cc = 0; cc < 4; ++cc) { Fend[cc] = __shfl(F[cc], 63); amax[cc] = Fend[cc] - F[cc] + li[cc]; dm[cc] = li[cc] - F[cc]; }
#pragma unroll
          for (int o = 1; o < 64; o <<= 1) {
#pragma unroll
              for (int cc = 0; cc < 4; ++cc) { amax[cc] = fmaxf(amax[cc], __shfl_xor(amax[cc], o)); const float t = __shfl_up(dm[cc], o); if (lane >= o) dm[cc] = fmaxf(dm[cc], t); } }
#pragma unroll
          for (int cc = 0; cc < 4; ++cc) { const int c = wave * 4 + cc, tk = c * 64 + lane; const float a = Fend[cc] - F[cc] + li[cc];
              t_f[tk] = F[cc]; t_b[tk] = li[cc] - F[cc]; t_w[tk] = __expf(a - amax[cc]); t_dmx[tk] = F[cc] + dm[cc];
              if (lane == 0) { c_fe[c] = Fend[cc]; c_am[c] = amax[cc]; } } }
        __syncthreads();
        if (wave == 0) {
            const int c = lane & 31; const float fe = c_fe[c], am = c_am[c]; float sa = fe, sb = am;
#pragma unroll
            for (int o = 1; o < 32; o <<= 1) { const float pa = __shfl_up(sa, o), pb = __shfl_up(sb, o); if (c >= o) { sb = fmaxf(pb + sa, sb); sa = pa + sa; } }
            const float mn = fmaxf(sa, sb);
            float m = __shfl_up(mn, 1); if (c == 0) m = 0.f;
            if (lane < 32) { c_m0[c] = m; f_dec[c] = __expf(fe + m - mn); c_inj[c] = __expf(am - mn); } }
        __syncthreads();
        for (int tk = tid; tk < 2048; tk += NTHREADS) { const int c = tk >> 6; const float F = t_f[tk]; const float inter = F + c_m0[c]; const float mt = fmaxf(inter, t_dmx[tk]);
            f_ws[tk] = t_w[tk] * c_inj[c];
            const int lc = c - c0;
            if ((unsigned)lc < (unsigned)GCH) { const int i = lc * 64 + (tk & 63);
                f_aq[i] = (F - mt) * 1.4426950408889634f - 3.5f  ; f_bq[i] = t_b[tk] * 1.4426950408889634f; f_gi[i] = __expf(inter - mt) * ATT_SCALE; f_em[i] = __expf(-mt); } }
        __syncthreads();
        f32x16 cst[4]; f32x16 ntile = f32x16{};
#pragma unroll
        for (int kt = 0; kt < 4; ++kt) cst[kt] = f32x16{};
        const int vsl = ((wave >> 2) ? T_V1 : T_V0) + (wave & 3) * 512;
        if (ns > 0) {
#pragma unroll 1
            for (int t = 0, bo = BUF; t < ns; ++t) {
                M4_LANEVARS();
                if (t + 1 < ns) NA_VMWAIT(6); else NA_VMWAIT(0);
                NA_BAR();
                if (t + 2 < ns) { const int bn = (bo >= BUF) ? bo - BUF : bo + 2 * BUF; M4_DMA_STATE(cs + t + 2, bn); }
                state_step(cst, ntile, vb0 + bo + T_KT, vb0 + bo + vsl, f_ws + (cs + t) * 64 + 8 * hi, f_dec[cs + t], wave, r32);
                bo = (bo == 2 * BUF) ? 0 : bo + BUF;
            }
            NA_BAR();
        }
        if (xch) {
            unsigned* flags = (unsigned*)(A.ws + WS_CTL + 131072 + jl * 2048);
            float* LX = (float*)(A.ws + WS_U + ((size_t)64 << 20));
            constexpr size_t LX_UNIT = 8 * 20 * 256, LX_WAVE = 20 * 256;
            int lane2 = lane; asm volatile("" : "+v"(lane2));
            if (ns > 0) {
                float* lx = LX + (size_t)unit * LX_UNIT + wave * LX_WAVE + lane2 * 4;
#pragma unroll
                for (int kt = 0; kt < 4; ++kt)
#pragma unroll
                    for (int q = 0; q < 4; ++q) *(f32x4*)(lx + (kt * 4 + q) * 256) = (f32x4){cst[kt][4 * q], cst[kt][4 * q + 1], cst[kt][4 * q + 2], cst[kt][4 * q + 3]};
                if (wave < 4) {
#pragma unroll
                    for (int q = 0; q < 4; ++q) *(f32x4*)(lx + (16 + q) * 256) = (f32x4){ntile[4 * q], ntile[4 * q + 1], ntile[4 * q + 2], ntile[4 * q + 3]}; }
                asm volatile("s_waitcnt vmcnt(0)" ::: "memory");
                __syncthreads();
                if (tid == 0) { __builtin_amdgcn_fence(__ATOMIC_RELEASE, "agent"); asm volatile("s_waitcnt vmcnt(0)" ::: "memory"); __hip_atomic_store(&flags[unit], 1u, __ATOMIC_RELAXED, __HIP_MEMORY_SCOPE_AGENT); }
            }
            if (!early_full) { M4_LANEVARS(); M4_DMA_STATE(c0, BUF); M4_DMA_QK(c0); }
#pragma unroll
            for (int kt = 0; kt < 4; ++kt) cst[kt] = f32x16{};
            ntile = f32x16{};
            if (g > 0) {
                if (tid == 0) {
                    for (int gp = 0; gp < g; ++gp) { unsigned sp = 0u;
                        while (__hip_atomic_load(&flags[unit - g + gp], __ATOMIC_RELAXED, __HIP_MEMORY_SCOPE_AGENT) == 0u) { __builtin_amdgcn_s_sleep(1); if (++sp > (1u << 22)) break; } }
                    __builtin_amdgcn_fence(__ATOMIC_ACQUIRE, "agent"); asm volatile("s_waitcnt vmcnt(0)" ::: "memory"); }
                __syncthreads();
                float coef = 1.f;
#pragma unroll 1
                for (int gp = g - 1; gp >= 0; --gp) { const float* lp = LX + (size_t)(unit - g + gp) * LX_UNIT + wave * LX_WAVE + lane2 * 4;
#pragma unroll
                    for (int kt = 0; kt < 4; ++kt)
#pragma unroll
                        for (int q = 0; q < 4; ++q) { const f32x4 v = *(const f32x4*)(lp + (kt * 4 + q) * 256);
                            cst[kt][4 * q] += coef * v.x; cst[kt][4 * q + 1] += coef * v.y; cst[kt][4 * q + 2] += coef * v.z; cst[kt][4 * q + 3] += coef * v.w; }
                    if (wave < 4) {
#pragma unroll
                        for (int q = 0; q < 4; ++q) { const f32x4 v = *(const f32x4*)(lp + (16 + q) * 256);
                            ntile[4 * q] += coef * v.x; ntile[4 * q + 1] += coef * v.y; ntile[4 * q + 2] += coef * v.z; ntile[4 * q + 3] += coef * v.w; } }
                    coef *= (f_dec[4 * gp] * f_dec[4 * gp + 1]) * (f_dec[4 * gp + 2] * f_dec[4 * gp + 3]); }
            }
        }
        if (!xch) { NA_VMWAIT(0); M4_LANEVARS(); M4_DMA_STATE(c0, BUF); M4_DMA_QK(c0); }
#pragma unroll 1
        for (int j = 0; j < (PROBE == 2 ? 0 : GCH); ++j) { const int c = c0 + j, bo = ((j & 1) ^ 1) * BUF, lt = j * 64;
            NA_VMWAIT(0);
            NA_BAR();
            if (j + 1 < GCH) { M4_LANEVARS(); M4_DMA_STATE(c + 1, BUF - bo); }
            int ln_ = lane_in; asm volatile("" : "+v"(ln_)); const int r32 = ln_ & 31, hi = ln_ >> 5; const int vb0 = (int)(unsigned long long)ldsc + v_rd_base(ln_);
            f32x16 hn0, hn1; float rs0, rs1;
#define M4_KADDR(T, d) (kb4[(d) & 3] + ((d) >> 2) * 128 + (T) * 8192)
#define M4_QADDR(QT, d) (kb4[(d) & 3] + (B2_Q - B2_K) + ((d) >> 2) * 128 + (QT) * 8192)
#define M4_STILE(QT, T, PA0, PA1) do { f32x16 pt = f32x16{}; bf16x8 kf0[4], kf1[4];                                                                              \
                _Pragma("unroll") for (int i = 0; i < 4; ++i) kf0[i] = *(const LAS bf16x8*)M4_KADDR(T, i);                                                        \
                SBAR();                                                                                                                                           \
                _Pragma("unroll") for (int i = 0; i < 4; ++i) kf1[i] = *(const LAS bf16x8*)M4_KADDR(T, 4 + i);                                                    \
                f32x4 bq[4];                                                                                                                                      \
                _Pragma("unroll") for (int g4 = 0; g4 < 4; ++g4) bq[g4] = *(const LAS f32x4*)(f_bq + lt + 32 * (T) + 8 * g4 + 4 * hi);     \
                _Pragma("unroll") for (int i = 0; i < 4; ++i) pt = __builtin_amdgcn_mfma_f32_32x32x16_bf16(kf0[i], qr[i], pt, 0, 0, 0);                           \
                SBAR();                                                                                                                                           \
                _Pragma("unroll") for (int i = 0; i < 4; ++i) pt = __builtin_amdgcn_mfma_f32_32x32x16_bf16(kf1[i], qr[4 + i], pt, 0, 0, 0);                       \
                SBAR();                                                                                                                                           \
                _Pragma("unroll") for (int r = 0; r < 16; ++r) { const float e_ = __builtin_amdgcn_exp2f(aql + bq[r >> 2][r & 3]);                                \
                    const float wgt = ((T) != (QT) || crow(r, hi) <= r32) ? e_ : 0.f; pt[r] *= wgt; rs += pt[r]; }                                                \
                NA_PK4(pt, 0, PA0); NA_PK4(pt, 8, PA1); SBAR(); } while (0)
#define M4_QT(QT, HN, RS) do { const int l = 32 * (QT) + r32; bf16x8 qr[8];                                                                                     \
                _Pragma("unroll") for (int d = 0; d < 8; ++d) qr[d] = *(const LAS bf16x8*)M4_QADDR(QT, d);                                                        \
                const float aql = f_aq[lt + l];                                                                                                                   \
                if (wave < 4) { const bf16x8 qa = *(const LAS bf16x8*)(ldsc + B2_Q + KSWZ(l, 64 * wave + 16 * hi)), qb = *(const LAS bf16x8*)(ldsc + B2_Q + KSWZ(l, 64 * wave + 32 + 16 * hi)); \
                    bf16x8 n0, n1; NA_PK4(ntile, 0, n0); NA_PK4(ntile, 8, n1); f32x16 qn = f32x16{};                                                              \
                    qn = __builtin_amdgcn_mfma_f32_32x32x16_bf16(qa, n0, qn, 0, 0, 0); qn = __builtin_amdgcn_mfma_f32_32x32x16_bf16(qb, n1, qn, 0, 0, 0);        \
                    if (r32 == 0) { _Pragma("unroll") for (int r = 0; r < 16; ++r) s_qn[wave * 64 + 32 * (QT) + crow(r, hi)] = qn[r]; } }                         \
                SBAR(); float rs = 0.f; bf16x8 pa0, pa1, pa2, pa3;                                                                                                \
                M4_STILE(QT, 0, pa0, pa1);                                                                                                                        \
                if ((QT) == 1) M4_STILE(QT, 1, pa2, pa3);                                                                                                         \
                { auto rr = __builtin_amdgcn_permlane32_swap(__float_as_uint(rs), __float_as_uint(rs), false, false); rs = __uint_as_float(rr[0]) + __uint_as_float(rr[1]); } \
                RS = rs;                                                                                                                                          \
                f32x16 o = f32x16{}; const int vbV = vb0 + bo + vsl; s16x4 l0, h0, l1, h1, l2, h2, l3, h3;                                                         \
                M4_TRRD(l0, vbV, 0); M4_TRRD(h0, vbV, 2048); M4_TRRD(l1, vbV, 4096); M4_TRRD(h1, vbV, 6144);                                                      \
                if ((QT) == 1) { M4_TRRD(l2, vbV, 8192); M4_TRRD(h2, vbV, 10240); M4_TRRD(l3, vbV, 12288); M4_TRRD(h3, vbV, 14336); }                             \
                M4_LDSWAIT();                                                                                                                                     \
                o = __builtin_amdgcn_mfma_f32_32x32x16_bf16(pa0, M4_FRAG(l0, h0), o, 0, 0, 0); o = __builtin_amdgcn_mfma_f32_32x32x16_bf16(pa1, M4_FRAG(l1, h1), o, 0, 0, 0); \
                if ((QT) == 1) { o = __builtin_amdgcn_mfma_f32_32x32x16_bf16(pa2, M4_FRAG(l2, h2), o, 0, 0, 0); o = __builtin_amdgcn_mfma_f32_32x32x16_bf16(pa3, M4_FRAG(l3, h3), o, 0, 0, 0); } \
                f32x16 oc = f32x16{}; f32x4 giv[4];                                                                                                               \
                _Pragma("unroll") for (int g4 = 0; g4 < 4; ++g4) giv[g4] = *(const LAS f32x4*)(f_gi + lt + 32 * (QT) + 8 * g4 + 4 * hi);                          \
                _Pragma("unroll") for (int kt = 0; kt < 4; ++kt) { bf16x8 cb0, cb1; NA_PK4(cst[kt], 0, cb0); NA_PK4(cst[kt], 8, cb1);                              \
                    oc = __builtin_amdgcn_mfma_f32_32x32x16_bf16(qr[2 * kt], cb0, oc, 0, 0, 0); oc = __builtin_amdgcn_mfma_f32_32x32x16_bf16(qr[2 * kt + 1], cb1, oc, 0, 0, 0); } \
                SBAR();                                                                                                                                           \
                _Pragma("unroll") for (int r = 0; r < 16; ++r) HN[r] = o[r] + giv[r >> 2][r & 3] * oc[r]; SBAR(); } while (0)
            const LAS char* kb4[4];
#pragma unroll
            for (int dd = 0; dd < 4; ++dd) kb4[dd] = ldsc + B2_K + KSWZ(r32, 32 * dd + 16 * hi);
            asm volatile("s_nop 7\n\ts_nop 7\n\ts_nop 7" ::: "memory");
            M4_QT(0, hn0, rs0);
            M4_QT(1, hn1, rs1);
#undef M4_QT
#undef M4_STILE
#undef M4_KADDR
#undef M4_QADDR
            NA_BAR();
            if (j + 1 < GCH) { M4_LANEVARS(); M4_DMA_QK(c + 1); }
            { const float qn0 = (s_qn[r32] + s_qn[64 + r32]) + (s_qn[128 + r32] + s_qn[192 + r32]), qn1 = (s_qn[32 + r32] + s_qn[96 + r32]) + (s_qn[160 + r32] + s_qn[224 + r32]);
              const float d0 = rs0 + f_gi[lt + r32] * qn0, d1 = rs1 + f_gi[lt + 32 + r32] * qn1;
              const float i0 = 1.0f / fmaxf(fabsf(d0), f_em[lt + r32]), i1 = 1.0f / fmaxf(fabsf(d1), f_em[lt + 32 + r32]);
              if (hi == 0) { s_inv[r32] = i0; s_inv[32 + r32] = i1; } }
#define M4_OUT(QT, HN) do { bf16* hp = HRAW + (size_t)(b * SEQ + c * 64 + 32 * (QT)) * DM + h * 256 + wave * 32 + r32; f32x4 iv[4];     \
              _Pragma("unroll") for (int g4 = 0; g4 < 4; ++g4) iv[g4] = *(const LAS f32x4*)(s_inv + 32 * (QT) + 8 * g4 + 4 * hi);                                  \
              _Pragma("unroll") for (int r = 0; r < 16; r += 2) { const int row = crow(r, hi); const unsigned w0 = cvtpk(HN[r] * iv[r >> 2][r & 3], HN[r + 1] * iv[r >> 2][(r & 3) + 1]); \
                  if (PROBE == 0) { hp[(size_t)row * DM] = (bf16)w0; hp[(size_t)(row + 1) * DM] = (bf16)(w0 >> 16); } else asm volatile("" :: "v"(w0)); } SBAR(); } while (0)
            M4_OUT(0, hn0); M4_OUT(1, hn1);
#undef M4_OUT
            if (j + 1 < GCH) state_step(cst, ntile, vb0 + bo + T_KT, vb0 + bo + vsl, f_ws + c * 64 + 8 * hi, f_dec[c], wave, r32);
        }
        asm volatile("s_waitcnt vmcnt(0)" ::: "memory");
        __syncthreads();
        if (PROBE == 0) { const bf16* HR = HRAW; bf16* Oo = (bf16*)(A.ws + WS_O); const float* hnw = A.ml_head_norm + (size_t)jl * DM + h * 256;
            int t2 = tid_in; asm volatile("" : "+v"(t2)); const int c8 = t2 & 31, rq = t2 >> 5, col = h * 256 + 8 * c8;
#pragma unroll 1
            for (int r0 = 0; r0 < 256; r0 += 128) {
                v4u hrv[8], ogv[8];
#pragma unroll
                for (int u = 0; u < 8; ++u) { const size_t row = (size_t)(b * SEQ + c0 * 64 + r0 + 16 * u + rq); hrv[u] = *(const v4u*)(HR + row * DM + col); ogv[u] = *(const v4u*)(P + row * ML_NP + MC_OG + col); }
                const f32x4 ga = *(const f32x4*)(hnw + 8 * c8), gb2 = *(const f32x4*)(hnw + 8 * c8 + 4);
#pragma unroll
                for (int u = 0; u < 8; ++u) { const size_t row = (size_t)(b * SEQ + c0 * 64 + r0 + 16 * u + rq); const v4u hr = hrv[u], og = ogv[u];
                    const f32x4 a = (f32x4){bflo(hr.x), bfhi(hr.x), bflo(hr.y), bfhi(hr.y)}, b2 = (f32x4){bflo(hr.z), bfhi(hr.z), bflo(hr.w), bfhi(hr.w)};
                    float ss = ((a.x * a.x + a.y * a.y) + (a.z * a.z + a.w * a.w)) + ((b2.x * b2.x + b2.y * b2.y) + (b2.z * b2.z + b2.w * b2.w));
#pragma unroll
                    for (int o = 1; o < 32; o <<= 1) ss += __shfl_xor(ss, o);
                    const float rstd = 1.0f / sqrtf(ss * (1.0f / 256.0f) + 1e-6f);
                    v4u o;
                    o.x = pk2(a.x * rstd * ga.x * sigmoidf_(bflo(og.x)), a.y * rstd * ga.y * sigmoidf_(bfhi(og.x)));
                    o.y = pk2(a.z * rstd * ga.z * sigmoidf_(bflo(og.y)), a.w * rstd * ga.w * sigmoidf_(bfhi(og.y)));
                    o.z = pk2(b2.x * rstd * gb2.x * sigmoidf_(bflo(og.z)), b2.y * rstd * gb2.y * sigmoidf_(bfhi(og.z)));
                    o.w = pk2(b2.z * rstd * gb2.z * sigmoidf_(bflo(og.w)), b2.w * rstd * gb2.w * sigmoidf_(bfhi(og.w)));
                    *(v4u*)(Oo + row * DM + col) = o; } }
        }
        NA_BAR();
#undef M4_DMA_VL
#undef M4_DMA2
#undef M4_LANEVARS
#undef M4_DMA_KS
#undef M4_DMA_STATE
#undef M4_DMA_QK
    }
    __builtin_amdgcn_s_setprio(0);
}
__device__ __forceinline__ void phase_compress2(const Ptrs& A, int j_layer, LAS unsigned char* lds, int G, int vcu, int wave, int lane, int tid) {
    typedef short bf16x8 __attribute__((ext_vector_type(8))); typedef float f32x16 __attribute__((ext_vector_type(16)));
    const bf16* P = (const bf16*)(A.ws + WS_P); bf16* KC = (bf16*)(A.ws + WS_KC); bf16* VC = (bf16*)(A.ws + WS_VC);
    const float* pe = A.nsa_pe + (size_t)j_layer * 2 * 32 * 128;
    const bf16* W1T = (const bf16*)(A.ws + WS_W1T) + (size_t)j_layer * 2 * 32 * 128 * 128; const bf16* W2T = (const bf16*)(A.ws + WS_W2T) + (size_t)j_layer * 2 * 128 * 128;
    LAS float* part = (LAS float*)lds;
    LAS bf16* hidb = (LAS bf16*)(lds + RSTD_OFF);
    const int r32 = lane & 31, hi = lane >> 5;
    for (int unit = vcu; unit < 64; unit += G) {
        const int jt = unit & 3, g = (unit >> 2) & 1, b = (unit >> 3) & 3, c = unit >> 5, j0 = 32 * jt;
        const int jc = (j0 + r32 < NCMP) ? j0 + r32 : NCMP - 1;
        f32x16 acc[4];
#pragma unroll
        for (int nt = 0; nt < 4; ++nt) acc[nt] = f32x16{};
#define CP_LOAD(S, s_) do { const int l_ = wave * 4 + ((s_) >> 2), k2_ = ((s_) & 3) * 2;                                                                      \
            const bf16* arow = P + (size_t)(b * SEQ + 16 * jc + l_) * NSA_NP + PC_KVC + c * 256 + g * 128 + hi * 8;                                             \
            const float* perow = pe + (size_t)(c * 32 + l_) * 128 + hi * 8; const bf16* brow = W1T + ((size_t)(c * 32 + l_) * 128 + r32) * 128 + hi * 8;        \
            _Pragma("unroll") for (int q = 0; q < 2; ++q) { const int ks = k2_ + q; xa##S[q] = *(const v4u*)(arow + ks * 16); p0##S[q] = *(const f32x4*)(perow + ks * 16); p1##S[q] = *(const f32x4*)(perow + ks * 16 + 4); \
                _Pragma("unroll") for (int nt = 0; nt < 4; ++nt) bf##S[q][nt] = *(const bf16x8*)(brow + (size_t)nt * 32 * 128 + ks * 16); } } while (0)
#define CP_COMP(S) do { _Pragma("unroll") for (int q = 0; q < 2; ++q) {                                                                                        \
            v4u aw; aw.x = pk2(bflo(xa##S[q].x) + p0##S[q].x, bfhi(xa##S[q].x) + p0##S[q].y); aw.y = pk2(bflo(xa##S[q].y) + p0##S[q].z, bfhi(xa##S[q].y) + p0##S[q].w);      \
            aw.z = pk2(bflo(xa##S[q].z) + p1##S[q].x, bfhi(xa##S[q].z) + p1##S[q].y); aw.w = pk2(bflo(xa##S[q].w) + p1##S[q].z, bfhi(xa##S[q].w) + p1##S[q].w);              \
            const bf16x8 af = __builtin_bit_cast(bf16x8, aw);                                                                                                   \
            _Pragma("unroll") for (int nt = 0; nt < 4; ++nt) acc[nt] = __builtin_amdgcn_mfma_f32_32x32x16_bf16(af, bf##S[q][nt], acc[nt], 0, 0, 0); } } while (0)
        { v4u xaA[2], xaB[2]; f32x4 p0A[2], p1A[2], p0B[2], p1B[2]; bf16x8 bfA[2][4], bfB[2][4];
          CP_LOAD(A, 0);
#pragma unroll 1
          for (int s = 0; s < 16; s += 2) { CP_LOAD(B, s + 1); CP_COMP(A); if (s + 2 < 16) CP_LOAD(A, s + 2); CP_COMP(B); } }
#undef CP_LOAD
#undef CP_COMP
        __syncthreads();
#pragma unroll
        for (int nt = 0; nt < 4; ++nt)
#pragma unroll
            for (int r = 0; r < 16; ++r) part[(wave * 32 + (r & 3) + 8 * (r >> 2) + 4 * hi) * 128 + nt * 32 + r32] = acc[nt][r];
        __syncthreads();
        { const int row = tid >> 4, h8 = (tid & 15) * 8; unsigned ow[4];
#pragma unroll
          for (int q = 0; q < 2; ++q) { f32x4 s = (f32x4){0.f, 0.f, 0.f, 0.f};
#pragma unroll
              for (int w = 0; w < 8; ++w) s += *(const LAS f32x4*)(part + (w * 32 + row) * 128 + h8 + 4 * q);
              float e[4];
#pragma unroll
              for (int i = 0; i < 4; ++i) { const float v = s[i]; e[i] = 0.5f * v * (1.0f + tanhf_(0.7978845608028654f * (v + 0.044715f * v * v * v))); }
              ow[2 * q] = pk2(e[0], e[1]); ow[2 * q + 1] = pk2(e[2], e[3]); }
          *(LAS v4u*)(hidb + row * 136 + h8) = (v4u){ow[0], ow[1], ow[2], ow[3]}; }
        __syncthreads();
        if (wave < 4) { const int nt = wave; f32x16 o = f32x16{};
            const bf16* brow = W2T + ((size_t)c * 128 + nt * 32 + r32) * 128 + hi * 8; bf16x8 bfw[8];
#pragma unroll
            for (int ks = 0; ks < 8; ++ks) bfw[ks] = *(const bf16x8*)(brow + ks * 16);
#pragma unroll
            for (int ks = 0; ks < 8; ++ks) { const bf16x8 af = *(const LAS bf16x8*)(hidb + r32 * 136 + ks * 16 + hi * 8); o = __builtin_amdgcn_mfma_f32_32x32x16_bf16(af, bfw[ks], o, 0, 0, 0); }
            bf16* dst = (c == 0 ? KC : VC) + ((size_t)(b * 2 + g) * 128 + j0) * 128 + nt * 32 + r32;
#pragma unroll
            for (int r = 0; r < 16; ++r) { const int row = (r & 3) + 8 * (r >> 2) + 4 * hi; dst[(size_t)row * 128] = (j0 + row < NCMP) ? (bf16)f2bf(o[r]) : (bf16)0; } }
    }
}
__device__ __forceinline__ Ptrs load_ptrs() {
    const void* const* kp = (const void* const*)__builtin_amdgcn_kernarg_segment_ptr();
    int z = 0; asm volatile("" : "+s"(z));
    Ptrs A;
    A.x = (const float*)kp[z + 0]; A.pos = (const int*)kp[z + 1];
    A.nsa_w_in = (const float*)kp[z + 2]; A.nsa_gate_b = (const float*)kp[z + 3]; A.nsa_pe = (const float*)kp[z + 4]; A.nsa_w1 = (const float*)kp[z + 5]; A.nsa_w2 = (const float*)kp[z + 6]; A.nsa_w_out = (const float*)kp[z + 7];
    A.ml_w_in = (const float*)kp[z + 8]; A.ml_gate_b = (const float*)kp[z + 9]; A.ml_head_norm = (const float*)kp[z + 10]; A.ml_w_out = (const float*)kp[z + 11];
    A.norm_mix = (const float*)kp[z + 12]; A.norm_ffn = (const float*)kp[z + 13]; A.w_up = (const float*)kp[z + 14]; A.conv_w = (const float*)kp[z + 15]; A.conv_b = (const float*)kp[z + 16]; A.w_down = (const float*)kp[z + 17]; A.norm_final = (const float*)kp[z + 18];
    A.out = (float*)kp[z + 19]; A.ws = (unsigned char*)kp[z + 20];
    return A;
}
constexpr int NPHASES = 30;
struct Args { const void* in[19]; float* out; unsigned char* ws; int ph_lo, ph_hi; };
__global__ void __launch_bounds__(NTHREADS, 2) fwd_kernel(Args args) {
    extern __shared__ __attribute__((aligned(16))) unsigned char lds_raw[];
    LAS unsigned char* lds = (LAS unsigned char*)lds_raw;
    asm volatile("s_nop 0\n s_nop 0\n s_nop 0\n s_nop 0\n s_nop 0\n s_nop 0\n s_nop 0\n s_nop 0\n s_nop 0\n s_nop 0\n s_nop 0\n s_nop 0\n s_nop 0\n s_nop 0\n s_nop 0\n s_nop 0");
    volatile LAS unsigned* MISC = (volatile LAS unsigned*)(lds + MISC_OFF);
    const int G = gridDim.x; const int bx = blockIdx.x; const int vcu = (G % 8 == 0) ? (bx % 8) * (G / 8) + bx / 8 : bx;
    const int lo = args.ph_lo, hi = args.ph_hi;
    const int wv0 = __builtin_amdgcn_readfirstlane((int)threadIdx.x >> 6);
#define TIDX() ((wv0 << 6) | hw_lane())
    if (TIDX() < 32) MISC[TIDX()] = 0u;
    __syncthreads();
    XcdBarrier bar; bar.bar = (unsigned*)(args.ws + WS_CTL) + CW_BAR; bar.x = 0; bar.st = nullptr; bar.wv = wv0;
    if (hi - lo > 1) bar = xcd_barrier_post((unsigned*)(args.ws + WS_CTL) + CW_BAR, MISC + 8, wv0);
#ifndef DUP_MASK
#define DUP_MASK 0
#endif
#define DUP(bit) for (int rep_ = 0; rep_ < (((DUP_MASK) >> (bit)) & 1 ? 2 : 1); ++rep_)
#define IN(k) (lo <= (k) && (k) < hi)
#define SEAM(k) do { if (IN(k) && IN((k) + 1)) xcd_barrier(bar); } while (0)
#define SITE() const Ptrs A = load_ptrs(); int tid = TIDX(); asm volatile("" : "+v"(tid)); const int lane = tid & 63, wave = __builtin_amdgcn_readfirstlane(tid >> 6); (void)lane; (void)wave; \
    bf16* XB = (bf16*)(A.ws + WS_XB); float* XR = (float*)(A.ws + WS_XR); float* SSP = (float*)(A.ws + WS_SSP); bf16* P = (bf16*)(A.ws + WS_P); bf16* O = (bf16*)(A.ws + WS_O); (void)XB; (void)XR; (void)SSP; (void)P; (void)O

    if (IN(0)) { SITE(); DUP(0) phase_prologue(A, lds, G, vcu, wave, lane, tid); }
    SEAM(0);
    for (int layer = 0; layer < DEPTH; ++layer) {
        const int pb = 1 + 7 * layer; const bool nsa = (layer & 1) == 0; const int jl = layer >> 1;
        if (IN(pb)) { SITE();
            const int N = nsa ? NSA_NP : ML_NP;
            pg8::Gemm g{XB, (const bf16*)(A.ws + (nsa ? WS_WNSA + jl * SZ_WNSA : WS_WML + jl * SZ_WML)), MROWS, N, DM, wave}; pg8::StaticOrder S; S.init(MROWS, N, G, bx);
            LAS float* rtab = (LAS float*)(lds + RSTD_OFF); pg8::prep_rstd(SSP, S, rtab, tid);
            pg8::EpiProj E{P, N, rtab, nsa ? (const float*)(A.ws + WS_ROPE) : nullptr};
            DUP(1) pg8::gemm_phase<pg8::EpiProj, pg8::StaticOrder, true, true>(lds, g, S, E);
            if (!nsa) DUP(8) phase_ml_gates(A, jl, layer, lds, G, vcu, wave, lane);
            if (nsa && layer + 1 < DEPTH) { const int rem = (32 * (NSA_NP / 256)) % G, n = cv_inslot_items(layer + 1, G);
                if (n > 0 && bx >= rem) { __syncthreads(); const int t0 = cv_tail_items(layer + 1, G); convert_layer(A, layer + 1, t0, t0 + n, (bx - rem) * NWAVES + wave, (G - rem) * NWAVES, (LAS float*)(lds + wave * 16640), lane); } }
        }
        SEAM(pb);
        if (IN(pb + 1)) { SITE();
            if (nsa) { DUP(2) phase_compress2(A, jl, lds, G, vcu, wave, lane, tid);
                if (vcu >= 64 && cv_slot_items(layer, G) > 0) convert_layer(A, layer, cv_layer_items(layer) - cv_slot_items(layer, G), cv_layer_items(layer), (vcu - 64) * NWAVES + wave, (G - 64) * NWAVES, (LAS float*)(lds + wave * 16640), lane); }
            else { for (int rep_ = 0; rep_ < (((DUP_MASK >> 13) & 7) ? 2 : 1); ++rep_) phase_ml_rec4(rep_ ? ((DUP_MASK >> 13) & 7) - 1 : 0, A, jl, lds, G, vcu, wave, lane, tid);
            }
        }
        SEAM(pb + 1);
        if (IN(pb + 2)) { SITE();
            if (nsa) DUP(3) phase_nsa_attn2(A, jl, lds, G, vcu, wave, lane, tid);
        }
        if (nsa) SEAM(pb + 2);
        if (IN(pb + 3)) { SITE();
            pg8::Gemm g{O, (const bf16*)(A.ws + WS_WOUT + layer * SZ_WOUT), MROWS, DM, DM, wave}; pg8::StaticOrder S; S.init(MROWS, DM, G, bx);
            pg8::EpiRes E{nullptr, XB, SSP};
            pg8::gemm_phase<pg8::EpiRes, pg8::StaticOrder, true, true>(lds, g, S, E);
        }
        SEAM(pb + 3);
        if (IN(pb + 4)) { SITE();
            pg8::Gemm g{XB, (const bf16*)(A.ws + WS_WUP + layer * SZ_WUP), MROWS, NUP, DM, wave}; pg8::StaticOrder S; S.init(MROWS, NUP, G, bx);
            LAS float* rtab = (LAS float*)(lds + RSTD_OFF); pg8::prep_rstd(SSP, S, rtab, tid);
            pg8::EpiUp E{(bf16*)(A.ws + WS_ACT), (float*)(A.ws + WS_U), A.conv_w + (size_t)layer * 3 * NUP, A.conv_b + (size_t)layer * NUP, rtab};
            DUP(6) pg8::gemm_phase<pg8::EpiUp, pg8::StaticOrder, true, true>(lds, g, S, E);
            {
              const int nwg = (MROWS / 256) * (NUP / 256), rem = nwg % G;
              if (layer + 1 < DEPTH && rem != 0 && bx >= rem) convert_layer(A, layer + 1, 0, cv_tail_items(layer + 1, G), (bx - rem) * NWAVES + wave, (G - rem) * NWAVES, (LAS float*)(lds + wave * 16640), lane); }
#if (DUP_MASK >> 9) & 1
            { pg8::EpiNull EN{(float*)(A.ws + WS_QR) + (A.pos[0] < 0 ? 0 : 0)}; EN.sink = (A.pos[0] == -12345) ? (float*)(A.ws + WS_QR) : nullptr; pg8::gemm_phase<pg8::EpiNull, pg8::StaticOrder, true, true>(lds, g, S, EN); }
#endif
        }
        SEAM(pb + 4);
        if (IN(pb + 5)) { SITE(); DUP(7) phase_fixup(A, layer, G, vcu, tid); }
        SEAM(pb + 5);
        if (IN(pb + 6)) { SITE();
            pg8::Gemm g{(const bf16*)(A.ws + WS_ACT), (const bf16*)(A.ws + WS_WDN + layer * SZ_WDN), MROWS, DM, DFF, wave}; pg8::StaticOrder S; S.init(MROWS, DM, G, bx);
            const bool lastl = (layer + 1 == DEPTH);
            pg8::EpiRes E{nullptr, XB, SSP, lastl ? (LAS float*)(lds + RSTD_OFF) : (LAS float*)nullptr};
            pg8::gemm_phase<pg8::EpiRes, pg8::StaticOrder, true, true>(lds, g, S, E);
        }
        if (layer + 1 < DEPTH) SEAM(pb + 6);
    }
#if (DUP_MASK >> 12) & 1
    if (hi - lo > 1) { for (int rep_ = 0; rep_ < 20; ++rep_) xcd_barrier(bar); }
#endif
#undef SITE
#undef IN
#undef SEAM
}

extern "C" void kernel_launch(void* const* d_in, const int* in_sizes, int n_in, void* d_out, int out_size, void* d_ws, size_t ws_size, hipStream_t stream) {
    static int grid = 0;
    if (grid == 0) {
        if (n_in != 19 || out_size != MROWS * DM || ws_size < WS_END) { fprintf(stderr, "kernel_launch: unexpected shapes (n_in %d, out %d, ws %zu, need %zu); nothing launched\n", n_in, out_size, ws_size, (size_t)WS_END); grid = -1; return; }
        int dev = 0, cus = 0, per_cu = 0;
        if (hipGetDevice(&dev) != hipSuccess || hipDeviceGetAttribute(&cus, hipDeviceAttributeMultiprocessorCount, dev) != hipSuccess) { fprintf(stderr, "kernel_launch: device query failed\n"); grid = -1; return; }
        if (hipFuncSetAttribute((const void*)fwd_kernel, hipFuncAttributeMaxDynamicSharedMemorySize, LDS_BYTES) != hipSuccess) { fprintf(stderr, "kernel_launch: hipFuncSetAttribute failed\n"); grid = -1; return; }
        if (hipOccupancyMaxActiveBlocksPerMultiprocessor(&per_cu, (const void*)fwd_kernel, NTHREADS, LDS_BYTES) != hipSuccess || per_cu < 1) fprintf(stderr, "kernel_launch: occupancy query reports %d blocks per CU\n", per_cu);
        (void)hipGetLastError();
        grid = cus;
    }
    if (grid < 0) return;
    (void)hipMemsetAsync((char*)d_ws + WS_CTL, 0, CTL_BYTES, stream);
    Args a{};
    for (int i = 0; i < 19; ++i) a.in[i] = d_in[i];
    a.out = (float*)d_out; a.ws = (unsigned char*)d_ws;
#if MK_ONE_LAUNCH
    a.ph_lo = 0; a.ph_hi = NPHASES;
    hipLaunchKernelGGL(fwd_kernel, dim3(grid), dim3(NTHREADS), LDS_BYTES, stream, a);
#else
    for (int p = 0; p < NPHASES; ++p) { a.ph_lo = p; a.ph_hi = p + 1; hipLaunchKernelGGL(fwd_kernel, dim3(grid), dim3(NTHREADS), LDS_BYTES, stream, a); }
#endif
}
```
